# Optimizing an MI355X kernel written in HIP

```python
import math
import jax, jax.numpy as jnp
from jax import lax
import numpy as np

D_MODEL = 1024
BATCH = 4
SEQ = 4096
DEPTH = 2

HEAD_DIM = 64
N_EVEN = (DEPTH + 1) // 2
N_ODD = DEPTH // 2
A_HEADS = D_MODEL // (4 * HEAD_DIM)
B_HEADS = D_MODEL // (2 * HEAD_DIM)
IDX_HEADS = 8
IDX_DIM = 64
TOPK_MAX = 256
C_HEADS = D_MODEL // HEAD_DIM
C_KV_HEADS = C_HEADS // 4
WINDOW = 128
FFN_HIDDEN = ((8 * D_MODEL // 3 + 255) // 256) * 256
Q_BLOCK = 128
NORM_EPS = 1e-6

EVEN_SIZES = (A_HEADS * 2 * HEAD_DIM,
              A_HEADS * 2 * HEAD_DIM,
              A_HEADS * 2 * HEAD_DIM,
              B_HEADS * HEAD_DIM,
              HEAD_DIM,
              HEAD_DIM,
              IDX_HEADS * IDX_DIM,
              IDX_DIM,
              IDX_HEADS)
EVEN_COLS = sum(EVEN_SIZES)
ODD_SIZES = (C_HEADS * HEAD_DIM, C_KV_HEADS * HEAD_DIM, C_KV_HEADS * HEAD_DIM)
ODD_COLS = sum(ODD_SIZES)

kernel_name = 'hybrid_diffattn_dsa_swa_sink_adaln'


def _rms_norm(x, g):
    xf = x.astype(jnp.float32)
    y = xf * lax.rsqrt(jnp.mean(xf * xf, axis=-1, keepdims=True) + NORM_EPS)
    return (y * g.astype(jnp.float32)).astype(x.dtype)


def _split_cols(t, sizes):
    offs = np.cumsum(np.asarray(sizes))[:-1].tolist()
    return jnp.split(t, offs, axis=-1)


def _alibi_slopes(n):
    return jnp.asarray(2.0 ** (-8.0 * np.arange(1, n + 1) / n), dtype=jnp.float32)


def _diff_attention(q, k, v, lam, slopes):
    b, s, h = q.shape[:3]
    nb = s // Q_BLOCK
    qb = jnp.moveaxis(q.reshape(b, nb, Q_BLOCK, h, 2, HEAD_DIM), 1, 0)
    key_pos = jnp.arange(s)
    scale = HEAD_DIM ** -0.5

    def block(args):
        qi, i = args
        dist = (i * Q_BLOCK + jnp.arange(Q_BLOCK))[:, None] - key_pos[None, :]
        logits = jnp.einsum('bqhmd,bshmd->bhmqs', qi, k).astype(jnp.float32) * scale
        logits = logits - slopes[None, :, None, None, None] * dist.astype(jnp.float32)
        logits = jnp.where(dist >= 0, logits, -jnp.inf)
        p = jax.nn.softmax(logits, axis=-1)
        a = p[:, :, 0] - lam * p[:, :, 1]
        return jnp.einsum('bhqs,bshe->bqhe', a.astype(v.dtype), v)

    out = lax.map(block, (qb, jnp.arange(nb)))
    return jnp.moveaxis(out, 0, 1).reshape(b, s, h, 2 * HEAD_DIM)


def _dsa_attention(q, k, v, iq, ik, iw, slopes, topk):
    b, s, h = q.shape[:3]
    nb = s // Q_BLOCK
    key_pos = jnp.arange(s)
    scale = HEAD_DIM ** -0.5
    gather = jax.vmap(lambda t, idx: t[idx])

    def blocks(t):
        return jnp.moveaxis(t.reshape((b, nb, Q_BLOCK) + t.shape[2:]), 1, 0)

    def block(args):
        qi, iqi, iwi, i = args
        q_pos = i * Q_BLOCK + jnp.arange(Q_BLOCK)
        causal = key_pos[None, :] <= q_pos[:, None]
        idx_logits = jnp.einsum('bqhd,bsd->bqhs', iqi, ik).astype(jnp.float32) * IDX_DIM ** -0.5
        score = jnp.einsum('bqhs,bqh->bqs', jax.nn.relu(idx_logits), iwi.astype(jnp.float32))
        score = jnp.where(causal[None], score, -jnp.inf)
        _, sel = lax.top_k(score, topk)
        k_sel = gather(k, sel)
        v_sel = gather(v, sel)
        dist = (q_pos[None, :, None] - sel)[:, None]
        logits = jnp.einsum('bqhd,bqkd->bhqk', qi, k_sel).astype(jnp.float32) * scale
        logits = logits - slopes[None, :, None, None] * dist.astype(jnp.float32)
        logits = jnp.where(dist >= 0, logits, -jnp.inf)
        p = jax.nn.softmax(logits, axis=-1)
        return jnp.einsum('bhqk,bqkd->bqhd', p.astype(v.dtype), v_sel)

    out = lax.map(block, (blocks(q), blocks(iq), blocks(iw), jnp.arange(nb)))
    return jnp.moveaxis(out, 0, 1).reshape(b, s, h, HEAD_DIM)


def _swa_sink_attention(q, k, v, sinks, slopes):
    b, s = q.shape[:2]
    nb = s // WINDOW
    g = C_HEADS // C_KV_HEADS
    qb = q.reshape(b, nb, WINDOW, C_KV_HEADS, g, HEAD_DIM)

    def band(t):
        tb = t.reshape(b, nb, WINDOW, C_KV_HEADS, HEAD_DIM)
        prev = jnp.pad(tb, ((0, 0), (1, 0), (0, 0), (0, 0), (0, 0)))[:, :-1]
        return jnp.concatenate([prev, tb], axis=2)

    kk, vv = band(k), band(v)
    i = jnp.arange(WINDOW)
    j = jnp.arange(2 * WINDOW)
    dist = WINDOW + i[:, None] - j[None, :]
    key_pos = jnp.arange(nb)[:, None] * WINDOW - WINDOW + j[None, :]
    valid = ((dist >= 0) & (dist < WINDOW))[None] & (key_pos >= 0)[:, None, :]
    logits = jnp.einsum('bnqhgd,bnkhd->bnhgqk', qb, kk).astype(jnp.float32) * HEAD_DIM ** -0.5
    sl = slopes.reshape(C_KV_HEADS, g)
    logits = logits - sl[None, None, :, :, None, None] * dist.astype(jnp.float32)
    logits = jnp.where(valid[None, :, None, None], logits, -jnp.inf)
    sink = jnp.broadcast_to(sinks.astype(jnp.float32).reshape(1, 1, C_KV_HEADS, g, 1, 1),
                            logits.shape[:-1] + (1,))
    p = jax.nn.softmax(jnp.concatenate([logits, sink], axis=-1), axis=-1)[..., :-1]
    out = jnp.einsum('bnhgqk,bnkhd->bnqhgd', p.astype(v.dtype), vv)
    return out.reshape(b, s, C_HEADS * HEAD_DIM)


def _even_mixer(h, w_in, qn_a, kn_a, lam_q1, lam_k1, lam_q2, lam_k2, subln_a, qn_b, kn_b, layer_idx):
    b, s, _ = h.shape
    aq, ak, av, bq, bk, bv, iq, ik, iw = _split_cols(h @ w_in, EVEN_SIZES)
    aq = _rms_norm(aq.reshape(b, s, A_HEADS, 2, HEAD_DIM), qn_a)
    ak = _rms_norm(ak.reshape(b, s, A_HEADS, 2, HEAD_DIM), kn_a)
    av = av.reshape(b, s, A_HEADS, 2 * HEAD_DIM)
    lam_init = 0.8 - 0.6 * math.exp(-0.3 * layer_idx)
    f32 = jnp.float32
    lam = (jnp.exp(jnp.sum(lam_q1.astype(f32) * lam_k1.astype(f32)))
           - jnp.exp(jnp.sum(lam_q2.astype(f32) * lam_k2.astype(f32))) + lam_init)
    ya = _diff_attention(aq, ak, av, lam, _alibi_slopes(A_HEADS))
    ya = _rms_norm(ya, subln_a) * (1.0 - lam_init)
    bq = _rms_norm(bq.reshape(b, s, B_HEADS, HEAD_DIM), qn_b)
    bk = _rms_norm(bk, kn_b)
    iq = iq.reshape(b, s, IDX_HEADS, IDX_DIM)
    iw = iw * IDX_HEADS ** -0.5
    topk = min(TOPK_MAX, s // 4)
    yb = _dsa_attention(bq, bk, bv, iq, ik, iw, _alibi_slopes(B_HEADS), topk)
    return jnp.concatenate([ya.reshape(b, s, -1), yb.reshape(b, s, -1)], axis=-1)


def _odd_mixer(h, w_in, qn_c, kn_c, sinks):
    b, s, _ = h.shape
    q, k, v = _split_cols(h @ w_in, ODD_SIZES)
    q = _rms_norm(q.reshape(b, s, C_HEADS, HEAD_DIM), qn_c)
    k = _rms_norm(k.reshape(b, s, C_KV_HEADS, HEAD_DIM), kn_c)
    v = v.reshape(b, s, C_KV_HEADS, HEAD_DIM)
    return _swa_sink_attention(q, k, v, sinks, _alibi_slopes(C_HEADS))


def _swiglu(h, wg, wu, wd):
    return (jax.nn.silu(h @ wg) * (h @ wu)) @ wd


def setup_inputs(seed: int = 0) -> dict:
    key = jax.random.key(seed)
    ks = iter(list(jax.random.split(key, 32)))
    d, f = D_MODEL, FFN_HIDDEN

    def nrm(shape, scale):
        return jax.random.normal(next(ks), shape, jnp.float32) * scale

    def gain(shape):
        return 1.0 + nrm(shape, 0.02)

    return {
        'x': nrm((BATCH, SEQ, d), 1.0),
        'c': nrm((BATCH, d), 1.0),
        'ada_w': nrm((DEPTH, d, 6 * d), 0.5 * d ** -0.5),
        'ada_b': nrm((DEPTH, 6 * d), 0.02),
        'norm_mix': gain((DEPTH, d)),
        'norm_ffn': gain((DEPTH, d)),
        'w_out': nrm((DEPTH, d, d), d ** -0.5),
        'ffn_gate': nrm((DEPTH, d, f), d ** -0.5),
        'ffn_up': nrm((DEPTH, d, f), d ** -0.5),
        'ffn_down': nrm((DEPTH, f, d), f ** -0.5),
        'w_in_even': nrm((N_EVEN, d, EVEN_COLS), d ** -0.5),
        'qn_a': gain((N_EVEN, HEAD_DIM)),
        'kn_a': gain((N_EVEN, HEAD_DIM)),
        'lam_q1': nrm((N_EVEN, HEAD_DIM), 0.1),
        'lam_k1': nrm((N_EVEN, HEAD_DIM), 0.1),
        'lam_q2': nrm((N_EVEN, HEAD_DIM), 0.1),
        'lam_k2': nrm((N_EVEN, HEAD_DIM), 0.1),
        'subln_a': gain((N_EVEN, 2 * HEAD_DIM)),
        'qn_b': gain((N_EVEN, HEAD_DIM)),
        'kn_b': gain((N_EVEN, HEAD_DIM)),
        'w_in_odd': nrm((N_ODD, d, ODD_COLS), d ** -0.5),
        'qn_c': gain((N_ODD, HEAD_DIM)),
        'kn_c': gain((N_ODD, HEAD_DIM)),
        'sinks_c': nrm((N_ODD, C_HEADS), 0.5),
    }


def reference(x, c, ada_w, ada_b, norm_mix, norm_ffn, w_out, ffn_gate, ffn_up, ffn_down,
              w_in_even, qn_a, kn_a, lam_q1, lam_k1, lam_q2, lam_k2, subln_a, qn_b, kn_b,
              w_in_odd, qn_c, kn_c, sinks_c):
    cond = jax.nn.silu(c)
    for l in range(DEPTH):
        mod = cond @ ada_w[l] + ada_b[l]
        sh1, sc1, g1, sh2, sc2, g2 = [m[:, None, :] for m in jnp.split(mod, 6, axis=-1)]
        h = _rms_norm(x, norm_mix[l]) * (1.0 + sc1) + sh1
        if l % 2 == 0:
            e = l // 2
            y = _even_mixer(h, w_in_even[e], qn_a[e], kn_a[e], lam_q1[e], lam_k1[e],
                            lam_q2[e], lam_k2[e], subln_a[e], qn_b[e], kn_b[e], l)
        else:
            o = l // 2
            y = _odd_mixer(h, w_in_odd[o], qn_c[o], kn_c[o], sinks_c[o])
        x = x + g1 * (y @ w_out[l])
        h = _rms_norm(x, norm_ffn[l]) * (1.0 + sc2) + sh2
        x = x + g2 * _swiglu(h, ffn_gate[l], ffn_up[l], ffn_down[l])
    return x
```

```cpp
#include <hip/hip_runtime.h>
#include <stdint.h>

typedef unsigned short bf16_t;
constexpr int D = 1024, BATCH = 4, SEQ = 4096, M = BATCH * SEQ, FF = 2816, ECOLS = 2760, EP = 2816, OP = 1536, MODN = 6144;
constexpr float LOG2E = 1.4426950408889634f;
constexpr float QS = 0.125f * LOG2E;
constexpr float IS = 0.125f * 0.35355339059327373f;
constexpr float EPS = 1e-6f;

constexpr int C_AQ = 0, C_AK = 512, C_AV = 1024, C_BQ = 1536, C_BK = 2048, C_BV = 2112, C_IQ = 2176, C_IK = 2688, C_IW = 2752;
constexpr int C1_Q = 0, C1_K = 1024, C1_V = 1280;

constexpr size_t MiB = 1u << 20;
constexpr size_t WS_MOD = 1 * MiB, WS_SGN = 1 * MiB + 512 * 1024, WS_XN = 50 * MiB, WS_Y = 82 * MiB, WS_E = 114 * MiB;

__device__ __forceinline__ float bf2f(bf16_t v) { return __uint_as_float((unsigned)v << 16); }
__device__ __forceinline__ bf16_t f2bf(float f) { unsigned u = __float_as_uint(f); return (bf16_t)((u + 0x7fffu + ((u >> 16) & 1u)) >> 16); }
__device__ __forceinline__ float wave_sum(float v) {
#pragma unroll
    for (int o = 1; o < 64; o <<= 1) v += __shfl_xor(v, o);
    return v;
}
__device__ __forceinline__ float wave_max(float v) {
#pragma unroll
    for (int o = 1; o < 64; o <<= 1) v = fmaxf(v, __shfl_xor(v, o));
    return v;
}
__device__ __forceinline__ int wave_sum_i(int v) {
#pragma unroll
    for (int o = 1; o < 64; o <<= 1) v += __shfl_xor(v, o);
    return v;
}

__global__ void __launch_bounds__(512) k_ada(const float* __restrict__ c, const float* __restrict__ ada_w, const float* __restrict__ ada_b, float* __restrict__ mod) {
    __shared__ float sc[4096];
    __shared__ float part[8][4][64];
    const int tid = threadIdx.x;
    for (int i = tid; i < 4096; i += 512) { float v = c[i]; sc[i] = v / (1.f + expf(-v)); }
    __syncthreads();
    const int item = blockIdx.x, l = item / 96, strip = item % 96, n0 = strip * 64;
    const int w = tid >> 6, lane = tid & 63;
    const float* W = ada_w + (size_t)l * 1024 * MODN + n0 + lane;
    float a0 = 0, a1 = 0, a2 = 0, a3 = 0;
    for (int k = w * 128; k < w * 128 + 128; ++k) {
        float wv = W[(size_t)k * MODN];
        a0 += sc[k] * wv; a1 += sc[1024 + k] * wv; a2 += sc[2048 + k] * wv; a3 += sc[3072 + k] * wv;
    }
    part[w][0][lane] = a0; part[w][1][lane] = a1; part[w][2][lane] = a2; part[w][3][lane] = a3;
    __syncthreads();
    if (tid < 256) {
        int b = tid >> 6, col = tid & 63; float s = 0;
        for (int ww = 0; ww < 8; ++ww) s += part[ww][b][col];
        mod[(size_t)(l * 4 + b) * MODN + n0 + col] = s + ada_b[l * MODN + n0 + col];
    }
}

__global__ void __launch_bounds__(512) k_norm(const float* __restrict__ x, const float* __restrict__ gain, const float* __restrict__ modl, int sh_off, int sc_off, bf16_t* __restrict__ XN) {
    const int row = blockIdx.x * 8 + (threadIdx.x >> 6), lane = threadIdx.x & 63, b = row / SEQ;
    const float4* xr = (const float4*)(x + (size_t)row * D);
    float4 v[4]; float s = 0.f;
#pragma unroll
    for (int j = 0; j < 4; ++j) { v[j] = xr[64 * j + lane]; s += v[j].x * v[j].x + v[j].y * v[j].y + v[j].z * v[j].z + v[j].w * v[j].w; }
    s = wave_sum(s);
    const float r = rsqrtf(s * (1.f / D) + EPS);
    const float* mb = modl + (size_t)b * MODN;
#pragma unroll
    for (int j = 0; j < 4; ++j) {
        const int col = 4 * (64 * j + lane);
        const float4 g = *(const float4*)(gain + col), scv = *(const float4*)(mb + sc_off + col), shv = *(const float4*)(mb + sh_off + col);
        float y0 = v[j].x * r * g.x * (1.f + scv.x) + shv.x, y1 = v[j].y * r * g.y * (1.f + scv.y) + shv.y;
        float y2 = v[j].z * r * g.z * (1.f + scv.z) + shv.z, y3 = v[j].w * r * g.w * (1.f + scv.w) + shv.w;
        uint2 o; o.x = (unsigned)f2bf(y0) | ((unsigned)f2bf(y1) << 16); o.y = (unsigned)f2bf(y2) | ((unsigned)f2bf(y3) << 16);
        *(uint2*)(XN + (size_t)row * D + col) = o;
    }
}

template <int MODE>
__global__ void __launch_bounds__(256) k_gemm_naive(const bf16_t* __restrict__ A, int lda, int K, const float* __restrict__ W, const float* __restrict__ W2, int ldw, int N,
                                                    bf16_t* __restrict__ Cb, int ldc, const float* base, float* out, const float* __restrict__ gate) {
    __shared__ float As[16][68];
    __shared__ float Ws[16][64];
    __shared__ float Ws2[16][64];
    const int tid = threadIdx.x, tx = tid & 15, ty = tid >> 4;
    const int m0 = blockIdx.y * 64, n0 = blockIdx.x * 64;
    float acc[4][4], acc2[4][4];
#pragma unroll
    for (int i = 0; i < 4; ++i)
#pragma unroll
        for (int j = 0; j < 4; ++j) { acc[i][j] = 0.f; acc2[i][j] = 0.f; }
    for (int k0 = 0; k0 < K; k0 += 16) {
        { const int r = tid >> 2, kq = (tid & 3) * 4; const bf16_t* p = A + (size_t)(m0 + r) * lda + k0 + kq;
#pragma unroll
          for (int i = 0; i < 4; ++i) As[kq + i][r] = bf2f(p[i]); }
        { const int kk = tid >> 4, nq = (tid & 15) * 4;
#pragma unroll
          for (int i = 0; i < 4; ++i) { const int n = n0 + nq + i; Ws[kk][nq + i] = (n < N) ? W[(size_t)(k0 + kk) * ldw + n] : 0.f;
              if (MODE == 2) Ws2[kk][nq + i] = (n < N) ? W2[(size_t)(k0 + kk) * ldw + n] : 0.f; } }
        __syncthreads();
#pragma unroll
        for (int kk = 0; kk < 16; ++kk) {
            float a[4], b[4], b2[4];
#pragma unroll
            for (int i = 0; i < 4; ++i) { a[i] = As[kk][ty * 4 + i]; b[i] = Ws[kk][tx * 4 + i]; if (MODE == 2) b2[i] = Ws2[kk][tx * 4 + i]; }
#pragma unroll
            for (int i = 0; i < 4; ++i)
#pragma unroll
                for (int j = 0; j < 4; ++j) { acc[i][j] += a[i] * b[j]; if (MODE == 2) acc2[i][j] += a[i] * b2[j]; }
        }
        __syncthreads();
    }
#pragma unroll
    for (int i = 0; i < 4; ++i) {
        const int m = m0 + ty * 4 + i, b = m / SEQ;
#pragma unroll
        for (int j = 0; j < 4; ++j) {
            const int n = n0 + tx * 4 + j;
            if (MODE == 0) { if (n < ldc) Cb[(size_t)m * ldc + n] = f2bf(acc[i][j]); }
            else if (MODE == 1) { if (n < N) out[(size_t)m * D + n] = base[(size_t)m * D + n] + gate[(size_t)b * MODN + n] * acc[i][j]; }
            else { if (n < N) { float g = acc[i][j]; Cb[(size_t)m * ldc + n] = f2bf(g / (1.f + expf(-g)) * acc2[i][j]); } }
        }
    }
}

__global__ void __launch_bounds__(512) k_post0(bf16_t* E, unsigned* __restrict__ SGN, const float* __restrict__ qn_a, const float* __restrict__ kn_a,
                                               const float* __restrict__ qn_b, const float* __restrict__ kn_b) {
    const int row = blockIdx.x * 8 + (threadIdx.x >> 6), lane = threadIdx.x & 63;
    bf16_t* e = E + (size_t)row * EP;
    float w[8]; unsigned sgn = 0;
#pragma unroll
    for (int h = 0; h < 8; ++h) { w[h] = bf2f(e[C_IW + h]); if (w[h] < 0.f) sgn |= 1u << h; }
    if (lane == 0) SGN[row] = sgn;
    for (int it = 0; it < 6; ++it) {
        const int grp = it * 8 + (lane >> 3), sub = (lane & 7) * 8, col = grp * 64 + sub;
        const bool act = grp < 43;
        uint4 raw = act ? *(const uint4*)(e + col) : make_uint4(0, 0, 0, 0);
        float v[8];
        v[0] = __uint_as_float(raw.x << 16); v[1] = __uint_as_float(raw.x & 0xffff0000u);
        v[2] = __uint_as_float(raw.y << 16); v[3] = __uint_as_float(raw.y & 0xffff0000u);
        v[4] = __uint_as_float(raw.z << 16); v[5] = __uint_as_float(raw.z & 0xffff0000u);
        v[6] = __uint_as_float(raw.w << 16); v[7] = __uint_as_float(raw.w & 0xffff0000u);
        float ss = 0.f;
#pragma unroll
        for (int i = 0; i < 8; ++i) ss += v[i] * v[i];
        ss += __shfl_xor(ss, 1); ss += __shfl_xor(ss, 2); ss += __shfl_xor(ss, 4);
        const float r = rsqrtf(ss * (1.f / 64.f) + EPS);
        const float* gp = nullptr; float scale = 1.f; bool write = false;
        if (grp < 8) { gp = qn_a; scale = r * QS; write = true; }
        else if (grp < 16) { gp = kn_a; scale = r; write = true; }
        else if (grp < 24) { }
        else if (grp < 32) { gp = qn_b; scale = r * QS; write = true; }
        else if (grp == 32) { gp = kn_b; scale = r; write = true; }
        else if (grp == 33) { }
        else if (grp < 42) { float wsel = 0.f;
#pragma unroll
            for (int h = 0; h < 8; ++h) wsel = (grp - 34 == h) ? w[h] : wsel;
            scale = fabsf(wsel) * IS; write = true; }
        if (act && write) {
            float o[8];
#pragma unroll
            for (int i = 0; i < 8; ++i) o[i] = v[i] * scale * (gp ? gp[sub + i] : 1.f);
            uint4 ov;
            ov.x = (unsigned)f2bf(o[0]) | ((unsigned)f2bf(o[1]) << 16); ov.y = (unsigned)f2bf(o[2]) | ((unsigned)f2bf(o[3]) << 16);
            ov.z = (unsigned)f2bf(o[4]) | ((unsigned)f2bf(o[5]) << 16); ov.w = (unsigned)f2bf(o[6]) | ((unsigned)f2bf(o[7]) << 16);
            *(uint4*)(e + col) = ov;
        }
    }
}

__global__ void __launch_bounds__(64) k_attnA_naive(const bf16_t* __restrict__ E, bf16_t* __restrict__ Y, const float* __restrict__ lq1, const float* __restrict__ lk1,
                                                    const float* __restrict__ lq2, const float* __restrict__ lk2, const float* __restrict__ subln) {
    __shared__ float qs[128];
    __shared__ float lg[2][4096];
    const int blk = blockIdx.x, h = blk & 3, tok = blk >> 2, b = tok / SEQ, i = tok % SEQ, lane = threadIdx.x;
    float t1 = wave_sum(lq1[lane] * lk1[lane]), t2 = wave_sum(lq2[lane] * lk2[lane]);
    const float lam = expf(t1) - expf(t2) + 0.2f;
    const bf16_t* er = E + (size_t)tok * EP;
    qs[lane] = bf2f(er[C_AQ + h * 128 + lane]); qs[64 + lane] = bf2f(er[C_AQ + h * 128 + 64 + lane]);
    __syncthreads();
    const float slope2 = exp2f(-2.f * (float)(h + 1)) * LOG2E;
    float mx0 = -1e30f, mx1 = -1e30f;
    for (int j = lane; j <= i; j += 64) {
        const bf16_t* kr = E + (size_t)(b * SEQ + j) * EP + C_AK + h * 128;
        float d0 = 0.f, d1 = 0.f;
        for (int d = 0; d < 64; d += 8) {
            uint4 r0 = *(const uint4*)(kr + d), r1 = *(const uint4*)(kr + 64 + d);
            const unsigned a0[4] = {r0.x, r0.y, r0.z, r0.w}, a1[4] = {r1.x, r1.y, r1.z, r1.w};
#pragma unroll
            for (int t = 0; t < 4; ++t) {
                d0 += qs[d + 2 * t] * __uint_as_float(a0[t] << 16) + qs[d + 2 * t + 1] * __uint_as_float(a0[t] & 0xffff0000u);
                d1 += qs[64 + d + 2 * t] * __uint_as_float(a1[t] << 16) + qs[64 + d + 2 * t + 1] * __uint_as_float(a1[t] & 0xffff0000u);
            }
        }
        const float bias = slope2 * (float)(j - i);
        d0 += bias; d1 += bias; lg[0][j] = d0; lg[1][j] = d1; mx0 = fmaxf(mx0, d0); mx1 = fmaxf(mx1, d1);
    }
    mx0 = wave_max(mx0); mx1 = wave_max(mx1);
    float s0 = 0.f, s1 = 0.f;
    for (int j = lane; j <= i; j += 64) { float e0 = exp2f(lg[0][j] - mx0), e1 = exp2f(lg[1][j] - mx1); s0 += e0; s1 += e1; lg[0][j] = e0; lg[1][j] = e1; }
    s0 = wave_sum(s0); s1 = wave_sum(s1);
    const float inv0 = 1.f / s0, inv1 = lam / s1;
    for (int j = lane; j <= i; j += 64) lg[0][j] = lg[0][j] * inv0 - lg[1][j] * inv1;
    __syncthreads();
    float o0 = 0.f, o1 = 0.f;
    for (int j = 0; j <= i; ++j) {
        const float a = lg[0][j]; const bf16_t* vr = E + (size_t)(b * SEQ + j) * EP + C_AV + h * 128;
        o0 += a * bf2f(vr[lane]); o1 += a * bf2f(vr[64 + lane]);
    }
    const float ss = wave_sum(o0 * o0 + o1 * o1);
    const float r = rsqrtf(ss * (1.f / 128.f) + EPS) * 0.8f;
    Y[(size_t)tok * D + h * 128 + lane] = f2bf(o0 * r * subln[lane]);
    Y[(size_t)tok * D + h * 128 + 64 + lane] = f2bf(o1 * r * subln[64 + lane]);
}

__global__ void __launch_bounds__(64) k_dsa_naive(const bf16_t* __restrict__ E, const unsigned* __restrict__ SGN, bf16_t* __restrict__ Y) {
    __shared__ float iqs[512];
    __shared__ float bqs[512];
    __shared__ unsigned keys[4096];
    __shared__ unsigned short list[256];
    __shared__ float ps[8][256];
    const int tok = blockIdx.x, b = tok / SEQ, i = tok % SEQ, lane = threadIdx.x, n = i + 1;
    const bf16_t* er = E + (size_t)tok * EP;
    for (int t = 0; t < 8; ++t) { iqs[t * 64 + lane] = bf2f(er[C_IQ + t * 64 + lane]); bqs[t * 64 + lane] = bf2f(er[C_BQ + t * 64 + lane]); }
    const unsigned sgn = SGN[tok];
    __syncthreads();
    for (int j = lane; j < n; j += 64) {
        const bf16_t* kr = E + (size_t)(b * SEQ + j) * EP + C_IK;
        float kv[64];
#pragma unroll
        for (int d = 0; d < 64; d += 8) { uint4 r0 = *(const uint4*)(kr + d); const unsigned a0[4] = {r0.x, r0.y, r0.z, r0.w};
#pragma unroll
            for (int t = 0; t < 4; ++t) { kv[d + 2 * t] = __uint_as_float(a0[t] << 16); kv[d + 2 * t + 1] = __uint_as_float(a0[t] & 0xffff0000u); } }
        float score = 0.f;
#pragma unroll
        for (int h = 0; h < 8; ++h) { float dot = 0.f;
#pragma unroll
            for (int d = 0; d < 64; ++d) dot += iqs[h * 64 + d] * kv[d];
            const float r = fmaxf(dot, 0.f); score += ((sgn >> h) & 1u) ? -r : r; }
        score += 0.0f;
        unsigned u = __float_as_uint(score); u = (u & 0x80000000u) ? ~u : (u | 0x80000000u);
        keys[j] = u;
    }
    __syncthreads();
    unsigned T = 0; int need = 1 << 20;
    if (n > 256) {
        for (int bit = 31; bit >= 0; --bit) {
            const unsigned cand = T | (1u << bit); int c = 0;
            for (int j = lane; j < n; j += 64) c += (keys[j] >= cand) ? 1 : 0;
            c = wave_sum_i(c);
            if (c >= 256) T = cand;
        }
        int cg = 0;
        for (int j = lane; j < n; j += 64) cg += (keys[j] > T) ? 1 : 0;
        cg = wave_sum_i(cg);
        need = 256 - cg;
    }
    int basep = 0;
    const unsigned long long lt = (lane == 0) ? 0ull : (~0ull >> (64 - lane));
    for (int j0 = 0; j0 < n; j0 += 64) {
        const int j = j0 + lane; const bool valid = j < n; const unsigned k = valid ? keys[j] : 0u;
        const bool gt = valid && (n <= 256 || k > T), eq = valid && n > 256 && k == T;
        const unsigned long long beq = __ballot(eq);
        const int rank = __popcll(beq & lt);
        const bool sel = gt || (eq && rank < need);
        need -= __popcll(beq); if (need < 0) need = 0;
        const unsigned long long bs = __ballot(sel);
        const int pos = basep + __popcll(bs & lt);
        if (sel && pos < 256) list[pos] = (unsigned short)j;
        basep += __popcll(bs);
    }
    const int cnt = basep < 256 ? basep : 256;
    __syncthreads();
    for (int s = lane; s < 256; s += 64) {
        if (s < cnt) {
            const int j = list[s]; const bf16_t* kr = E + (size_t)(b * SEQ + j) * EP + C_BK;
            float kv[64];
#pragma unroll
            for (int d = 0; d < 64; d += 8) { uint4 r0 = *(const uint4*)(kr + d); const unsigned a0[4] = {r0.x, r0.y, r0.z, r0.w};
#pragma unroll
                for (int t = 0; t < 4; ++t) { kv[d + 2 * t] = __uint_as_float(a0[t] << 16); kv[d + 2 * t + 1] = __uint_as_float(a0[t] & 0xffff0000u); } }
#pragma unroll
            for (int h = 0; h < 8; ++h) { float dot = 0.f;
#pragma unroll
                for (int d = 0; d < 64; ++d) dot += bqs[h * 64 + d] * kv[d];
                ps[h][s] = dot + exp2f(-(float)(h + 1)) * LOG2E * (float)(j - i); }
        } else {
#pragma unroll
            for (int h = 0; h < 8; ++h) ps[h][s] = -1e30f;
        }
    }
    __syncthreads();
    for (int h = 0; h < 8; ++h) {
        float v0 = ps[h][lane], v1 = ps[h][64 + lane], v2 = ps[h][128 + lane], v3 = ps[h][192 + lane];
        const float mx = wave_max(fmaxf(fmaxf(v0, v1), fmaxf(v2, v3)));
        v0 = exp2f(v0 - mx); v1 = exp2f(v1 - mx); v2 = exp2f(v2 - mx); v3 = exp2f(v3 - mx);
        if (lane >= cnt) v0 = 0.f; if (64 + lane >= cnt) v1 = 0.f; if (128 + lane >= cnt) v2 = 0.f; if (192 + lane >= cnt) v3 = 0.f;
        const float inv = 1.f / wave_sum(v0 + v1 + v2 + v3);
        ps[h][lane] = v0 * inv; ps[h][64 + lane] = v1 * inv; ps[h][128 + lane] = v2 * inv; ps[h][192 + lane] = v3 * inv;
    }
    __syncthreads();
    float o[8];
#pragma unroll
    for (int h = 0; h < 8; ++h) o[h] = 0.f;
    for (int s = 0; s < cnt; ++s) {
        const int j = list[s]; const float v = bf2f(E[(size_t)(b * SEQ + j) * EP + C_BV + lane]);
#pragma unroll
        for (int h = 0; h < 8; ++h) o[h] += ps[h][s] * v;
    }
#pragma unroll
    for (int h = 0; h < 8; ++h) Y[(size_t)tok * D + 512 + h * 64 + lane] = f2bf(o[h]);
}

__global__ void __launch_bounds__(64) k_swa_naive(const bf16_t* __restrict__ E1, bf16_t* __restrict__ Y, const float* __restrict__ qn_c, const float* __restrict__ kn_c, const float* __restrict__ sinks) {
    __shared__ float qs[64];
    __shared__ float ps[128];
    const int blk = blockIdx.x, head = blk & 15, tok = blk >> 4, kvh = head >> 2, b = tok / SEQ, i = tok % SEQ, lane = threadIdx.x;
    { const float v = bf2f(E1[(size_t)tok * OP + C1_Q + head * 64 + lane]); const float ss = wave_sum(v * v);
      qs[lane] = v * rsqrtf(ss * (1.f / 64.f) + EPS) * qn_c[lane] * QS; }
    __syncthreads();
    const int jlo = (i - 127 > 0) ? i - 127 : 0, nk = i - jlo + 1;
    const float slope2 = exp2f(-0.5f * (float)(head + 1)) * LOG2E;
    float lgv[2]; float mx = -1e30f;
#pragma unroll
    for (int t2 = 0; t2 < 2; ++t2) {
        const int t = lane + 64 * t2; lgv[t2] = -1e30f;
        if (t < nk) {
            const int j = jlo + t; const bf16_t* kr = E1 + (size_t)(b * SEQ + j) * OP + C1_K + kvh * 64;
            float ss = 0.f, dot = 0.f;
            for (int d = 0; d < 64; ++d) { const float kv = bf2f(kr[d]); ss += kv * kv; dot += qs[d] * kv * kn_c[d]; }
            lgv[t2] = dot * rsqrtf(ss * (1.f / 64.f) + EPS) - slope2 * (float)(i - j);
        }
        mx = fmaxf(mx, lgv[t2]);
    }
    const float sink2 = sinks[head] * LOG2E;
    mx = fmaxf(wave_max(mx), sink2);
    float e0 = (lane < nk) ? exp2f(lgv[0] - mx) : 0.f, e1 = (lane + 64 < nk) ? exp2f(lgv[1] - mx) : 0.f;
    const float inv = 1.f / (wave_sum(e0 + e1) + exp2f(sink2 - mx));
    ps[lane] = e0 * inv; ps[64 + lane] = e1 * inv;
    __syncthreads();
    float o = 0.f;
    for (int t = 0; t < nk; ++t) o += ps[t] * bf2f(E1[(size_t)(b * SEQ + jlo + t) * OP + C1_V + kvh * 64 + lane]);
    Y[(size_t)tok * D + head * 64 + lane] = f2bf(o);
}

extern "C" void kernel_launch(void* const* d_in, const int* in_sizes, int n_in, void* d_out, int out_size, void* d_ws, size_t ws_size, hipStream_t stream) {
    const float* x = (const float*)d_in[0]; const float* c = (const float*)d_in[1]; const float* ada_w = (const float*)d_in[2]; const float* ada_b = (const float*)d_in[3];
    const float* norm_mix = (const float*)d_in[4]; const float* norm_ffn = (const float*)d_in[5]; const float* w_out = (const float*)d_in[6];
    const float* ffn_gate = (const float*)d_in[7]; const float* ffn_up = (const float*)d_in[8]; const float* ffn_down = (const float*)d_in[9];
    const float* w_in_even = (const float*)d_in[10]; const float* qn_a = (const float*)d_in[11]; const float* kn_a = (const float*)d_in[12];
    const float* lq1 = (const float*)d_in[13]; const float* lk1 = (const float*)d_in[14]; const float* lq2 = (const float*)d_in[15]; const float* lk2 = (const float*)d_in[16];
    const float* subln = (const float*)d_in[17]; const float* qn_b = (const float*)d_in[18]; const float* kn_b = (const float*)d_in[19];
    const float* w_in_odd = (const float*)d_in[20]; const float* qn_c = (const float*)d_in[21]; const float* kn_c = (const float*)d_in[22]; const float* sinks = (const float*)d_in[23];
    float* out = (float*)d_out; unsigned char* ws = (unsigned char*)d_ws;
    float* mod = (float*)(ws + WS_MOD); unsigned* SGN = (unsigned*)(ws + WS_SGN);
    bf16_t* XN = (bf16_t*)(ws + WS_XN); bf16_t* Y = (bf16_t*)(ws + WS_Y); bf16_t* E = (bf16_t*)(ws + WS_E);

    k_ada<<<192, 512, 0, stream>>>(c, ada_w, ada_b, mod);
    for (int l = 0; l < 2; ++l) {
        const float* modl = mod + (size_t)l * 4 * MODN;
        k_norm<<<M / 8, 512, 0, stream>>>(l == 0 ? x : out, norm_mix + l * D, modl, 0, 1024, XN);
        if (l == 0) {
            k_gemm_naive<0><<<dim3(EP / 64, M / 64), 256, 0, stream>>>(XN, D, D, w_in_even, nullptr, ECOLS, ECOLS, E, EP, nullptr, nullptr, nullptr);
            k_post0<<<M / 8, 512, 0, stream>>>(E, SGN, qn_a, kn_a, qn_b, kn_b);
            k_attnA_naive<<<M * 4, 64, 0, stream>>>(E, Y, lq1, lk1, lq2, lk2, subln);
            k_dsa_naive<<<M, 64, 0, stream>>>(E, SGN, Y);
        } else {
            k_gemm_naive<0><<<dim3(OP / 64, M / 64), 256, 0, stream>>>(XN, D, D, w_in_odd, nullptr, OP, OP, E, OP, nullptr, nullptr, nullptr);
            k_swa_naive<<<M * 16, 64, 0, stream>>>(E, Y, qn_c, kn_c, sinks);
        }
        k_gemm_naive<1><<<dim3(D / 64, M / 64), 256, 0, stream>>>(Y, D, D, w_out + (size_t)l * D * D, nullptr, D, D, nullptr, 0, l == 0 ? x : out, out, modl + 2048);
        k_norm<<<M / 8, 512, 0, stream>>>(out, norm_ffn + l * D, modl, 3072, 4096, XN);
        k_gemm_naive<2><<<dim3(FF / 64, M / 64), 256, 0, stream>>>(XN, D, D, ffn_gate + (size_t)l * D * FF, ffn_up + (size_t)l * D * FF, FF, FF, E, FF, nullptr, nullptr, nullptr);
        k_gemm_naive<1><<<dim3(D / 64, M / 64), 256, 0, stream>>>(E, FF, FF, ffn_down + (size_t)l * FF * D, nullptr, D, D, nullptr, 0, out, out, modl + 5120);
    }
}
```

```cpp
#include <hip/hip_runtime.h>
#include <cstdio>
#include <stdint.h>

#define LAS __attribute__((address_space(3)))
#define GAS __attribute__((address_space(1)))
typedef unsigned short bf16_t;
typedef short bf16x8 __attribute__((ext_vector_type(8)));
typedef short s16x4 __attribute__((ext_vector_type(4)));
typedef short v4i16_t __attribute__((ext_vector_type(4)));
typedef float f32x4 __attribute__((ext_vector_type(4)));
typedef float f32x16 __attribute__((ext_vector_type(16)));
typedef unsigned u32x4 __attribute__((ext_vector_type(4)));
typedef unsigned u32x2 __attribute__((ext_vector_type(2)));
typedef float f32x2_t __attribute__((ext_vector_type(2)));
typedef __bf16 bf16x2_t __attribute__((ext_vector_type(2)));
typedef LAS const char* lds_cptr;

constexpr int D = 1024, BATCH = 4, SEQ = 4096, M = BATCH * SEQ, FF = 2816, ECOLS = 2760, EP = 2816, OP = 1536, MODN = 6144, GU = 2 * FF;
constexpr float LOG2E = 1.4426950408889634f;
constexpr float QS = 0.125f * LOG2E;
constexpr float IS = 0.125f * 0.35355339059327373f;
constexpr float EPS = 1e-6f;
constexpr int C_AQ = 0, C_AK = 512, C_AV = 1024, C_BQ = 1536, C_BK = 2048, C_BV = 2112, C_IQ = 2176, C_IK = 2688, C_IW = 2752;
constexpr int C1_Q = 0, C1_K = 1024, C1_V = 1280;

constexpr size_t MiB = 1u << 20;
constexpr size_t WS_CTL = 0, CTL_ZERO_BYTES = 64 * 1024;
constexpr size_t WS_MOD = 1 * MiB, WS_SGN = 1 * MiB + 512 * 1024;
constexpr size_t WS_WIN0 = 2 * MiB;
constexpr size_t WS_WOUT = 8 * MiB;
constexpr size_t WS_WGU = 12 * MiB;
constexpr size_t WS_WDN = 34 * MiB;
constexpr size_t WS_WIN1 = 45 * MiB;
constexpr size_t WS_XN = 50 * MiB, WS_Y = 82 * MiB, WS_E = 114 * MiB, WS_END = 202 * MiB;

__device__ __forceinline__ float bf2f(bf16_t v) { return __uint_as_float((unsigned)v << 16); }
__device__ __forceinline__ bf16_t f2bf(float f) { unsigned u = __float_as_uint(f); return (bf16_t)((u + 0x7fffu + ((u >> 16) & 1u)) >> 16); }
__device__ __forceinline__ unsigned pk2(float lo, float hi) { return (unsigned)f2bf(lo) | ((unsigned)f2bf(hi) << 16); }
__device__ __forceinline__ unsigned cvtpk(float lo, float hi) { f32x2_t v = {lo, hi}; bf16x2_t b = __builtin_convertvector(v, bf16x2_t); return __builtin_bit_cast(unsigned, b); }
__device__ __forceinline__ float wave_sum(float v) {
#pragma unroll
    for (int o = 1; o < 64; o <<= 1) v += __shfl_xor(v, o);
    return v;
}
__device__ __forceinline__ float wave_max(float v) {
#pragma unroll
    for (int o = 1; o < 64; o <<= 1) v = fmaxf(v, __shfl_xor(v, o));
    return v;
}
__device__ __forceinline__ int crow(int r, int hi) { return (r & 3) + 8 * (r >> 2) + 4 * hi; }
__device__ __forceinline__ float xhalf_max(float m) { auto rr = __builtin_amdgcn_permlane32_swap(__float_as_uint(m), __float_as_uint(m), false, false); return fmaxf(__uint_as_float(rr[0]), __uint_as_float(rr[1])); }
__device__ __forceinline__ float xhalf_sum(float m) { auto rr = __builtin_amdgcn_permlane32_swap(__float_as_uint(m), __float_as_uint(m), false, false); return __uint_as_float(rr[0]) + __uint_as_float(rr[1]); }
__device__ __forceinline__ void glds16(const void* gsrc, unsigned lds_dst) { unsigned keep;
    asm volatile("s_mov_b32 %0, m0\n\ts_mov_b32 m0, %2\n\ts_nop 0\n\tglobal_load_lds_dwordx4 %1, off\n\ts_mov_b32 m0, %0" : "=&s"(keep) : "v"(gsrc), "s"(lds_dst) : "memory"); }
__device__ __forceinline__ s16x4 vtr(lds_cptr p) { return __builtin_bit_cast(s16x4, __builtin_amdgcn_ds_read_tr16_b64_v4i16((LAS v4i16_t*)p)); }
#define WAITV_BAR() asm volatile("s_waitcnt vmcnt(0) lgkmcnt(0)\n\ts_barrier" ::: "memory")
#define WAITL_BAR() asm volatile("s_waitcnt lgkmcnt(0)\n\ts_barrier" ::: "memory")

namespace pg8 {
constexpr int BM = 256, BK = 64, HALF = 128, HTB = HALF * BK * 2, STAGE_BYTES = 8 * HTB, NXCD = 8, WGM = 8;
__host__ __device__ __forceinline__ int lds_byte(int r, int c) { const int st = (r >> 4) * 2 + (c >> 5), rr = r & 15, cc = c & 31, ob = rr * 64 + cc * 2; return st * 1024 + (ob ^ (((ob >> 9) & 1) << 5)); }
__host__ __device__ __forceinline__ void stage_rc(int b, int& R, int& C) { const int st = b / 1024, sb = b % 1024, swz = sb ^ (((sb >> 9) & 1) << 5); R = (st >> 1) * 16 + swz / 64; C = (st & 1) * 32 + (swz % 64) / 2; }
__host__ __device__ __forceinline__ int perm32(int rho) { const int n = rho >> 4, i = rho & 15; return 8 * (i >> 2) + 4 * n + (i & 3); }
struct Unit { int pm, pn; };
struct Gemm { const bf16_t* A; const bf16_t* Bt; int M, N, K; };
struct StaticOrder {
    int nM, nN, nwg, G, c;
    __host__ __device__ void init(int M_, int N_, int G_, int c_) { nM = M_ / BM; nN = N_ / BM; nwg = nM * nN; G = G_; c = c_; }
    __host__ __device__ bool next(int i, Unit& u) const {
        const long L = (long)i * G + c; if (L >= nwg) return false;
        int wgid = (int)L; { const int q = nwg / NXCD, r = nwg % NXCD, xcd = wgid % NXCD, off = wgid / NXCD; wgid = (xcd < r ? xcd * (q + 1) : r * (q + 1) + (xcd - r) * q) + off; }
        const int nig = WGM * nN, gid = wgid / nig, fm = gid * WGM, gsz = (nM - fm) < WGM ? (nM - fm) : WGM;
        u.pm = fm + ((wgid % nig) % gsz); u.pn = (wgid % nig) / gsz; return true;
    }
    __device__ __forceinline__ void a_ready(const Unit&) const {}
    __device__ __forceinline__ void done(const Unit&) const {}
};
__device__ __forceinline__ unsigned cvt_pk_bf16(float lo, float hi) { unsigned r; asm volatile("v_cvt_pk_bf16_f32 %0, %1, %2" : "=v"(r) : "v"(lo), "v"(hi)); return r; }

struct EpiRawBf16 {
    static constexpr bool PERM = true, AFTER_DRAIN = false;
    bf16_t* O; int ldc;
    __device__ __forceinline__ void operator()(const f32x4 (&acc)[2][2][4][2], const Unit& u, int wr, int wc, int fr, int fq) const {
        const int row0 = u.pm * BM + wr * 64 + fr, col0 = u.pn * BM + wc * 32 + 8 * fq;
#pragma unroll
        for (int ai = 0; ai < 2; ++ai)
#pragma unroll
            for (int m = 0; m < 4; ++m) { bf16_t* rowp = O + (size_t)(row0 + ai * HALF + m * 16) * ldc + col0;
#pragma unroll
                for (int bj = 0; bj < 2; ++bj) { const f32x4 v0 = acc[ai][bj][m][0], v1 = acc[ai][bj][m][1];
                    u32x4 w; w.x = cvt_pk_bf16(v0[0], v0[1]); w.y = cvt_pk_bf16(v0[2], v0[3]); w.z = cvt_pk_bf16(v1[0], v1[1]); w.w = cvt_pk_bf16(v1[2], v1[3]);
                    *(u32x4*)(rowp + bj * HALF) = w; } }
    }
};
struct EpiResGate {
    static constexpr bool PERM = true, AFTER_DRAIN = false;
    const float* base; float* out; const float* gate;
    __device__ __forceinline__ void operator()(const f32x4 (&acc)[2][2][4][2], const Unit& u, int wr, int wc, int fr, int fq) const {
        const int row0 = u.pm * BM + wr * 64 + fr, col0 = u.pn * BM + wc * 32 + 8 * fq, b = (u.pm * BM) / SEQ;
        f32x4 g[2][2];
#pragma unroll
        for (int bj = 0; bj < 2; ++bj)
#pragma unroll
            for (int n = 0; n < 2; ++n) g[bj][n] = *(const f32x4*)(gate + (size_t)b * MODN + col0 + bj * HALF + 4 * n);
#pragma unroll
        for (int ai = 0; ai < 2; ++ai)
#pragma unroll
            for (int m = 0; m < 4; ++m) { const size_t off = (size_t)(row0 + ai * HALF + m * 16) * D + col0;
#pragma unroll
                for (int bj = 0; bj < 2; ++bj)
#pragma unroll
                    for (int n = 0; n < 2; ++n) { const f32x4 bs = *(const f32x4*)(base + off + bj * HALF + 4 * n);
                        *(f32x4*)(out + off + bj * HALF + 4 * n) = bs + g[bj][n] * acc[ai][bj][m][n]; } }
    }
};
struct EpiSwiglu {
    static constexpr bool PERM = true, AFTER_DRAIN = false;
    bf16_t* H;
    __device__ __forceinline__ void operator()(const f32x4 (&acc)[2][2][4][2], const Unit& u, int wr, int wc, int fr, int fq) const {
        const int row0 = u.pm * BM + wr * 64 + fr, col0 = u.pn * HALF + wc * 32 + 8 * fq;
#pragma unroll
        for (int ai = 0; ai < 2; ++ai)
#pragma unroll
            for (int m = 0; m < 4; ++m) { bf16_t* rowp = H + (size_t)(row0 + ai * HALF + m * 16) * FF + col0;
                float hv[8];
#pragma unroll
                for (int n = 0; n < 2; ++n)
#pragma unroll
                    for (int e = 0; e < 4; ++e) { const float gv = acc[ai][0][m][n][e], uv = acc[ai][1][m][n][e];
                        hv[n * 4 + e] = gv * __builtin_amdgcn_rcpf(1.f + __builtin_amdgcn_exp2f(-gv * LOG2E)) * uv; }
                u32x4 w; w.x = cvt_pk_bf16(hv[0], hv[1]); w.y = cvt_pk_bf16(hv[2], hv[3]); w.z = cvt_pk_bf16(hv[4], hv[5]); w.w = cvt_pk_bf16(hv[6], hv[7]);
                *(u32x4*)rowp = w; }
    }
};

template <class Epi, class Sched, bool ALIGN_EPI = false, bool SP2 = false>
__device__ __forceinline__ void gemm_phase(LAS unsigned char* lds, const Gemm g, const Sched& S, const Epi& E) {
    int tid_ = threadIdx.x; asm volatile("" : "+v"(tid_));
    const int tid = tid_, wid = __builtin_amdgcn_readfirstlane(tid >> 6), lane = tid & 63, wr = wid >> 2, wc = wid & 3, fr = lane & 15, fq = lane >> 4;
    const int K = g.K, nt = K / BK;
    unsigned voffA[2], voffB[2];
#pragma unroll
    for (int i = 0; i < 2; ++i) { int R, C; stage_rc(tid * 16 + i * 8192, R, C); const int Rb = Epi::PERM ? ((R & ~31) + perm32(R & 31)) : R;
        voffA[i] = (unsigned)(R * K + C) * 2u; voffB[i] = (unsigned)(Rb * K + C) * 2u; }
    const size_t kstep = (size_t)(BK * 2);
    const size_t hstep = (size_t)HALF * K * 2;
    const size_t tstep = 2 * hstep;
    const unsigned ldsw = (unsigned)wid * 1024u;
    const int aoff = lds_byte(wr * 64 + fr, fq * 8), boff = lds_byte(wc * 32 + fr, fq * 8);
#define PG8_SA(b, h) (((b) * 2 + (h)) * HTB)
#define PG8_SB(b, h) ((4 + (b) * 2 + (h)) * HTB)
#define PG8_STAGE(bufoff, gbase, voff) do { _Pragma("unroll") for (int _i = 0; _i < 2; ++_i) \
        __builtin_amdgcn_global_load_lds((const unsigned*)((const char*)(gbase) + (voff)[_i]), (LAS unsigned*)(lds + (bufoff) + ldsw + _i * 8192), 16, 0, 0); } while (0)
#define PG8_LDA(dst, b, h) do { _Pragma("unroll") for (int m = 0; m < 4; ++m) _Pragma("unroll") for (int k = 0; k < 2; ++k) dst[m][k] = *(const LAS bf16x8*)(lds + PG8_SA(b, h) + aoff + m * 2048 + k * 1024); } while (0)
#define PG8_LDB(dst, b, h) do { _Pragma("unroll") for (int n = 0; n < 2; ++n) _Pragma("unroll") for (int k = 0; k < 2; ++k) dst[n][k] = *(const LAS bf16x8*)(lds + PG8_SB(b, h) + boff + n * 2048 + k * 1024); } while (0)
#define PG8_MMA(ai, bj, At, Bt) do { __builtin_amdgcn_s_setprio(1); _Pragma("unroll") for (int m = 0; m < 4; ++m) _Pragma("unroll") for (int n = 0; n < 2; ++n) _Pragma("unroll") for (int k = 0; k < 2; ++k) \
        acc[ai][bj][m][n] = __builtin_amdgcn_mfma_f32_16x16x32_bf16(Bt[n][k], At[m][k], acc[ai][bj][m][n], 0, 0, 0); __builtin_amdgcn_s_setprio(0); } while (0)
#define PG8_WAIT_V(n) asm volatile("s_waitcnt vmcnt(" #n ")" ::: "memory")
#define PG8_WAIT_L(n) asm volatile("s_waitcnt lgkmcnt(" #n ")" ::: "memory")
#define PG8_BAR __builtin_amdgcn_s_barrier()
#define PG8_SCHED __builtin_amdgcn_sched_barrier(0)
    Unit cur, nxt; int ui = 0;
    if (!S.next(0, cur)) return;
    f32x4 acc[2][2][4][2];
#pragma unroll
    for (int a = 0; a < 2; ++a)
#pragma unroll
        for (int b = 0; b < 2; ++b)
#pragma unroll
            for (int m = 0; m < 4; ++m)
#pragma unroll
                for (int n = 0; n < 2; ++n) acc[a][b][m][n] = (f32x4){0.f, 0.f, 0.f, 0.f};
    bf16x8 At[4][2], B0[2][2], B1[2][2];
    const char* cA = (const char*)g.A + (size_t)cur.pm * tstep; const char* cB = (const char*)g.Bt + (size_t)cur.pn * tstep;
    S.a_ready(cur);
    if constexpr (SP2) {
        PG8_STAGE(PG8_SB(0, 0), cB, voffB); PG8_STAGE(PG8_SB(0, 1), cB + hstep, voffB); PG8_STAGE(PG8_SA(0, 0), cA, voffA); PG8_STAGE(PG8_SA(0, 1), cA + hstep, voffA);
        if (wr == 1) PG8_BAR;
        PG8_WAIT_V(2); PG8_BAR;
        PG8_STAGE(PG8_SB(1, 0), cB + kstep, voffB); PG8_STAGE(PG8_SA(1, 0), cA + kstep, voffA); PG8_STAGE(PG8_SB(1, 1), cB + hstep + kstep, voffB);
        PG8_WAIT_V(6); PG8_BAR;
    } else {
        PG8_STAGE(PG8_SB(0, 0), cB, voffB); PG8_STAGE(PG8_SA(0, 0), cA, voffA); PG8_STAGE(PG8_SB(0, 1), cB + hstep, voffB); PG8_STAGE(PG8_SA(0, 1), cA + hstep, voffA);
        if (wr == 1) PG8_BAR;
        PG8_WAIT_V(4); PG8_BAR;
        PG8_STAGE(PG8_SB(1, 0), cB + kstep, voffB); PG8_STAGE(PG8_SA(1, 0), cA + kstep, voffA); PG8_STAGE(PG8_SB(1, 1), cB + hstep + kstep, voffB);
        PG8_WAIT_V(6); PG8_BAR;
    }
    for (;;) {
        const bool has_next = S.next(ui + 1, nxt);
        const char* nA = has_next ? (const char*)g.A + (size_t)nxt.pm * tstep : cA; const char* nB = has_next ? (const char*)g.Bt + (size_t)nxt.pn * tstep : cB;
        for (int t = 0; t < nt; t += 2) {
            const bool last = (t == nt - 2);
            const char* a1 = cA + (size_t)(t + 1) * kstep;
            const char* a2 = last ? nA : cA + (size_t)(t + 2) * kstep; const char* b2 = last ? nB : cB + (size_t)(t + 2) * kstep;
            const char* a3 = a2 + kstep; const char* b3 = b2 + kstep;
            if (last && has_next) S.a_ready(nxt);
            if constexpr (SP2) {
            PG8_LDB(B0, 0, 0); PG8_LDB(B1, 0, 1); PG8_SCHED; PG8_LDA(At, 0, 0); PG8_STAGE(PG8_SA(1, 1), a1 + hstep, voffA);
            PG8_WAIT_V(8); PG8_WAIT_L(0); PG8_BAR; PG8_MMA(0, 0, At, B0); PG8_MMA(0, 1, At, B1); PG8_BAR; PG8_SCHED;
            PG8_LDA(At, 0, 1); PG8_STAGE(PG8_SB(0, 0), b2, voffB); PG8_STAGE(PG8_SB(0, 1), b2 + hstep, voffB); PG8_STAGE(PG8_SA(0, 0), a2, voffA);
            PG8_WAIT_V(8); PG8_WAIT_L(0); PG8_BAR; PG8_MMA(1, 0, At, B0); PG8_MMA(1, 1, At, B1); PG8_BAR; PG8_SCHED;
            PG8_LDB(B0, 1, 0); PG8_LDB(B1, 1, 1); PG8_SCHED; PG8_LDA(At, 1, 0); PG8_STAGE(PG8_SA(0, 1), a2 + hstep, voffA);
            PG8_WAIT_V(8); PG8_WAIT_L(0); PG8_BAR; PG8_MMA(0, 0, At, B0); PG8_MMA(0, 1, At, B1); PG8_BAR; PG8_SCHED;
            PG8_LDA(At, 1, 1); PG8_STAGE(PG8_SB(1, 0), b3, voffB); PG8_STAGE(PG8_SB(1, 1), b3 + hstep, voffB); PG8_STAGE(PG8_SA(1, 0), a3, voffA);
            PG8_WAIT_V(8); PG8_WAIT_L(0); PG8_BAR; PG8_MMA(1, 0, At, B0); PG8_MMA(1, 1, At, B1); PG8_BAR; PG8_SCHED;
            } else {
            PG8_LDB(B0, 0, 0); PG8_SCHED; PG8_LDA(At, 0, 0); PG8_STAGE(PG8_SA(1, 1), a1 + hstep, voffA);
            PG8_WAIT_L(8); PG8_BAR; PG8_WAIT_L(0); PG8_MMA(0, 0, At, B0); PG8_BAR; PG8_SCHED;
            PG8_LDB(B1, 0, 1); PG8_STAGE(PG8_SB(0, 0), b2, voffB);
            PG8_BAR; PG8_WAIT_L(0); PG8_MMA(0, 1, At, B1); PG8_BAR;
            PG8_LDA(At, 0, 1); PG8_STAGE(PG8_SA(0, 0), a2, voffA);
            PG8_BAR; PG8_WAIT_L(0); PG8_MMA(1, 0, At, B0); PG8_BAR; PG8_SCHED;
            PG8_STAGE(PG8_SB(0, 1), b2 + hstep, voffB);
            PG8_WAIT_V(6); PG8_BAR; PG8_MMA(1, 1, At, B1); PG8_BAR;
            PG8_LDB(B0, 1, 0); PG8_SCHED; PG8_LDA(At, 1, 0); PG8_STAGE(PG8_SA(0, 1), a2 + hstep, voffA);
            PG8_WAIT_L(8); PG8_BAR; PG8_WAIT_L(0); PG8_MMA(0, 0, At, B0); PG8_BAR; PG8_SCHED;
            PG8_LDB(B1, 1, 1); PG8_STAGE(PG8_SB(1, 0), b3, voffB);
            PG8_BAR; PG8_WAIT_L(0); PG8_MMA(0, 1, At, B1); PG8_BAR;
            PG8_LDA(At, 1, 1); PG8_STAGE(PG8_SA(1, 0), a3, voffA);
            PG8_BAR; PG8_WAIT_L(0); PG8_MMA(1, 0, At, B0); PG8_BAR; PG8_SCHED;
            PG8_STAGE(PG8_SB(1, 1), b3 + hstep, voffB);
            PG8_WAIT_V(6); PG8_BAR; PG8_MMA(1, 1, At, B1); PG8_BAR;
            }
        }
        if constexpr (ALIGN_EPI) { if (wr == 0) PG8_BAR; }
        if constexpr (!Epi::AFTER_DRAIN) { E(acc, cur, wr, wc, fr, fq); S.done(cur); }
        if (!has_next) break;
#pragma unroll
        for (int a = 0; a < 2; ++a)
#pragma unroll
            for (int b = 0; b < 2; ++b)
#pragma unroll
                for (int m = 0; m < 4; ++m)
#pragma unroll
                    for (int n = 0; n < 2; ++n) acc[a][b][m][n] = (f32x4){0.f, 0.f, 0.f, 0.f};
        cur = nxt; cA = nA; cB = nB; ++ui;
        if constexpr (ALIGN_EPI) { if (wr == 1) PG8_BAR; }
    }
    PG8_WAIT_V(0);
    if constexpr (!ALIGN_EPI) { if (wr == 0) PG8_BAR; }
    PG8_BAR;
#undef PG8_SA
#undef PG8_SB
#undef PG8_STAGE
#undef PG8_LDA
#undef PG8_LDB
#undef PG8_MMA
#undef PG8_WAIT_V
#undef PG8_WAIT_L
#undef PG8_BAR
#undef PG8_SCHED
}
}

__device__ __forceinline__ void qk_tile(f32x16& p0, f32x16& p1, lds_cptr Kt, const bf16x8 (&qr)[4], int r32, int hi) {
    lds_cptr kb = Kt + hi * 1024 + r32 * 16;
#pragma unroll
    for (int d0 = 0; d0 < 4; ++d0) {
        const bf16x8 b0 = *(const LAS bf16x8*)(kb + d0 * 2048);
        const bf16x8 b1 = *(const LAS bf16x8*)(kb + d0 * 2048 + 512);
        p0 = __builtin_amdgcn_mfma_f32_32x32x16_bf16(b0, qr[d0], p0, 0, 0, 0);
        p1 = __builtin_amdgcn_mfma_f32_32x32x16_bf16(b1, qr[d0], p1, 0, 0, 0);
    }
}
__device__ __forceinline__ float max32(const f32x16& p0, const f32x16& p1) {
    float a = fmaxf(p0[0], p1[0]), b = fmaxf(p0[1], p1[1]);
#pragma unroll
    for (int r = 2; r < 16; r += 2) { a = fmaxf(a, fmaxf(p0[r], p1[r])); b = fmaxf(b, fmaxf(p0[r + 1], p1[r + 1])); }
    return fmaxf(a, b);
}
template <int NDB>
__device__ __forceinline__ void softmax_pv(f32x16 (&o)[NDB], float& mref, float& lrun, f32x16& p0, f32x16& p1, lds_cptr Vt, LAS float* wsf, int r32, int hi, int lane) {
    float rm = xhalf_max(max32(p0, p1));
    if (__any(rm > 8.f)) {
        const float dl = fmaxf(rm, 0.f); mref += dl;
#pragma unroll
        for (int r = 0; r < 16; ++r) { p0[r] -= dl; p1[r] -= dl; }
        const float f = __builtin_amdgcn_exp2f(-dl); lrun *= f;
        if (hi == 0) wsf[r32] = f;
#pragma unroll
        for (int r = 0; r < 16; ++r) { const float fr_ = wsf[crow(r, hi)];
#pragma unroll
            for (int db = 0; db < NDB; ++db) o[db][r] *= fr_; }
    }
    float s = 0.f;
#pragma unroll
    for (int r = 0; r < 16; ++r) { p0[r] = __builtin_amdgcn_exp2f(p0[r]); p1[r] = __builtin_amdgcn_exp2f(p1[r]); s += p0[r] + p1[r]; }
    lrun += s;
    u32x4 pw[4];
#pragma unroll
    for (int k = 0; k < 4; ++k) {
        pw[0][k] = cvtpk(p0[2 * k], p0[2 * k + 1]); pw[1][k] = cvtpk(p0[8 + 2 * k], p0[8 + 2 * k + 1]);
        pw[2][k] = cvtpk(p1[2 * k], p1[2 * k + 1]); pw[3][k] = cvtpk(p1[8 + 2 * k], p1[8 + 2 * k + 1]);
    }
    lds_cptr vp = Vt + ((lane >> 4) & 1) * 32 + (lane & 3) * 8 + (4 * hi + ((lane & 15) >> 2)) * 64;
#pragma unroll
    for (int db = 0; db < NDB; ++db) {
#pragma unroll
        for (int ks = 0; ks < 4; ++ks) {
            const s16x4 lo = vtr(vp + db * 4096 + ks * 1024), hh = vtr(vp + db * 4096 + ks * 1024 + 512);
            const bf16x8 vf = (bf16x8){lo[0], lo[1], lo[2], lo[3], hh[0], hh[1], hh[2], hh[3]};
            o[db] = __builtin_amdgcn_mfma_f32_32x32x16_bf16(__builtin_bit_cast(bf16x8, pw[ks]), vf, o[db], 0, 0, 0);
        }
    }
}

constexpr int AT_STAGE = 32768, AT_XCHG = 65536, AT_WSF = 131072;
__device__ __forceinline__ void attnA_unit(const int b, const int h, const int qb, const bf16_t* __restrict__ E, bf16_t* __restrict__ Y, const float lam, const float* __restrict__ subln, unsigned char* lds) {
    int tid_ = threadIdx.x; asm volatile("" : "+v"(tid_));
    const int tid = tid_, lane = tid & 63, r32 = lane & 31, hi = lane >> 5; const int wid = __builtin_amdgcn_readfirstlane(tid >> 6);
    const int mm = wid >> 2, rb = wid & 3;
    const int q0w = 128 * qb + 32 * rb, iq = q0w + r32, NT = 2 * (qb + 1);
    const bf16_t* Eb = E + (size_t)b * SEQ * EP;
    const unsigned lds0 = (unsigned)(uintptr_t)(LAS unsigned char*)lds;
    lds_cptr L = (lds_cptr)(LAS unsigned char*)lds;
    LAS float* wsf = (LAS float*)((LAS unsigned char*)lds + AT_WSF) + wid * 64;
    const bf16_t* src[4]; unsigned dsto[4];
#pragma unroll
    for (int i4 = 0; i4 < 4; ++i4) {
        if (wid < 4) { const int pidx = wid * 4 + i4, m_ = pidx >> 3, c = pidx & 7;
            src[i4] = Eb + (size_t)lane * EP + C_AK + h * 128 + m_ * 64 + c * 8; dsto[i4] = m_ * 8192 + c * 1024; }
        else { const int pidx = (wid - 4) * 4 + i4, db = pidx >> 2, rg = pidx & 3;
            src[i4] = Eb + (size_t)(16 * rg + (lane >> 2)) * EP + C_AV + h * 128 + db * 32 + (lane & 3) * 8; dsto[i4] = 16384 + db * 4096 + rg * 1024; }
    }
#define AT_DMA(t, stg) do { _Pragma("unroll") for (int i4 = 0; i4 < 4; ++i4) glds16(src[i4] + (size_t)(t) * 64 * EP, (unsigned)__builtin_amdgcn_readfirstlane(lds0 + (stg) * AT_STAGE + dsto[i4])); } while (0)
    AT_DMA(0, 0);
    bf16x8 qr[4];
    { const bf16_t* Qw = Eb + (size_t)iq * EP + C_AQ + h * 128 + mm * 64;
#pragma unroll
      for (int d0 = 0; d0 < 4; ++d0) qr[d0] = *(const bf16x8*)(Qw + d0 * 16 + hi * 8); }
    const float slope2 = __builtin_amdgcn_exp2f(-2.f * (float)(h + 1)) * LOG2E;
    f32x16 o[4];
#pragma unroll
    for (int db = 0; db < 4; ++db) o[db] = f32x16{};
    float mref = 0.f, lrun = 0.f;
    for (int t = 0; t < NT; ++t) {
        WAITV_BAR();
        if (t + 1 < NT) AT_DMA(t + 1, (t + 1) & 1);
        if (64 * t <= q0w + 31) {
            lds_cptr st = L + (t & 1) * AT_STAGE;
            const float tbm = slope2 * (float)(64 * t - iq) - mref;
            f32x16 p0, p1;
#pragma unroll
            for (int r = 0; r < 16; ++r) { p0[r] = tbm + slope2 * (float)crow(r, hi); p1[r] = p0[r] + 32.f * slope2; }
            qk_tile(p0, p1, st + mm * 8192, qr, r32, hi);
            if (64 * t + 63 > q0w) {
                const int kb = 64 * t + 4 * hi;
#pragma unroll
                for (int r = 0; r < 16; ++r) { const int kv = kb + (r & 3) + 8 * (r >> 2); if (kv > iq) p0[r] = -1e30f; if (kv + 32 > iq) p1[r] = -1e30f; }
            }
            softmax_pv<4>(o, mref, lrun, p0, p1, st + 16384, wsf, r32, hi, lane);
        }
    }
#undef AT_DMA
    lrun = xhalf_sum(lrun);
    if (hi == 0) wsf[r32] = lrun;
    float rli[16];
#pragma unroll
    for (int r = 0; r < 16; ++r) rli[r] = __builtin_amdgcn_rcpf(wsf[crow(r, hi)]);
    LAS float* xb = (LAS float*)((LAS unsigned char*)lds + AT_XCHG) + rb * 4096;
    if (mm == 1) {
#pragma unroll
        for (int db = 0; db < 4; ++db)
#pragma unroll
            for (int r = 0; r < 16; ++r) xb[(db * 16 + r) * 64 + lane] = o[db][r] * rli[r] * lam;
    }
    WAITL_BAR();
    if (mm == 0) {
        float ss[16];
#pragma unroll
        for (int r = 0; r < 16; ++r) ss[r] = 0.f;
#pragma unroll
        for (int db = 0; db < 4; ++db)
#pragma unroll
            for (int r = 0; r < 16; ++r) { const float dv = o[db][r] * rli[r] - xb[(db * 16 + r) * 64 + lane]; o[db][r] = dv; ss[r] += dv * dv; }
#pragma unroll
        for (int r = 0; r < 16; ++r) { float s = ss[r]; s += __shfl_xor(s, 1); s += __shfl_xor(s, 2); s += __shfl_xor(s, 4); s += __shfl_xor(s, 8); s += __shfl_xor(s, 16);
            ss[r] = __builtin_amdgcn_rsqf(s * (1.f / 128.f) + EPS) * 0.8f; }
        LAS bf16_t* stg = (LAS bf16_t*)((LAS unsigned char*)lds) + rb * 4096;
#pragma unroll
        for (int db = 0; db < 4; ++db) { const float gsub = subln[db * 32 + r32];
#pragma unroll
            for (int r = 0; r < 16; ++r) stg[crow(r, hi) * 128 + db * 32 + r32] = f2bf(o[db][r] * ss[r] * gsub); }
        bf16_t* Yw = Y + (size_t)(b * SEQ + q0w) * D + h * 128;
#pragma unroll
        for (int i8 = 0; i8 < 8; ++i8) { const int row = i8 * 4 + (lane >> 4), ch = lane & 15; const u32x4 v = *(const LAS u32x4*)(stg + row * 128 + ch * 8);
            *(u32x4*)(Yw + (size_t)row * D + ch * 8) = v; }
    }
    WAITL_BAR();
}

constexpr int SW_V = 32768, SW_OST = 65536;
__device__ __forceinline__ void swa_unit(const int b, const int kvh, const int nb, const bf16_t* __restrict__ E1, bf16_t* __restrict__ Y, const float* __restrict__ qn_c, const float* __restrict__ kn_c,
                                         const float* __restrict__ sinks, unsigned char* lds) {
    int tid_ = threadIdx.x; asm volatile("" : "+v"(tid_));
    const int tid = tid_, lane = tid & 63, r32 = lane & 31, hi = lane >> 5; const int wid = __builtin_amdgcn_readfirstlane(tid >> 6);
    const bf16_t* Eb = E1 + (size_t)b * SEQ * OP;
    LAS unsigned char* l3 = (LAS unsigned char*)lds;
    lds_cptr L = (lds_cptr)l3;
    LAS float* wsf = (LAS float*)(l3 + AT_WSF) + wid * 64;
    const int kt0 = (nb == 0) ? 2 : 0;
    {
        const int sub = lane & 7, rowi = tid >> 3;
        float kg[8];
#pragma unroll
        for (int i = 0; i < 8; ++i) kg[i] = kn_c[sub * 8 + i];
        for (int kt = kt0; kt < 4; ++kt) {
            const int key = 128 * (nb - 1) + 64 * kt + rowi;
            const u32x4 kr = *(const u32x4*)(Eb + (size_t)key * OP + C1_K + kvh * 64 + sub * 8);
            const u32x4 vr = *(const u32x4*)(Eb + (size_t)key * OP + C1_V + kvh * 64 + sub * 8);
            float v[8];
            v[0] = __uint_as_float(kr.x << 16); v[1] = __uint_as_float(kr.x & 0xffff0000u); v[2] = __uint_as_float(kr.y << 16); v[3] = __uint_as_float(kr.y & 0xffff0000u);
            v[4] = __uint_as_float(kr.z << 16); v[5] = __uint_as_float(kr.z & 0xffff0000u); v[6] = __uint_as_float(kr.w << 16); v[7] = __uint_as_float(kr.w & 0xffff0000u);
            float ss = 0.f;
#pragma unroll
            for (int i = 0; i < 8; ++i) ss += v[i] * v[i];
            ss += __shfl_xor(ss, 1); ss += __shfl_xor(ss, 2); ss += __shfl_xor(ss, 4);
            const float rr = __builtin_amdgcn_rsqf(ss * (1.f / 64.f) + EPS);
            u32x4 kw;
            kw.x = cvtpk(v[0] * rr * kg[0], v[1] * rr * kg[1]); kw.y = cvtpk(v[2] * rr * kg[2], v[3] * rr * kg[3]);
            kw.z = cvtpk(v[4] * rr * kg[4], v[5] * rr * kg[5]); kw.w = cvtpk(v[6] * rr * kg[6], v[7] * rr * kg[7]);
            *(LAS u32x4*)(l3 + kt * 8192 + sub * 1024 + rowi * 16) = kw;
            *(LAS u32x4*)(l3 + SW_V + kt * 8192 + (sub >> 2) * 4096 + (rowi >> 4) * 1024 + (rowi & 15) * 64 + (sub & 3) * 16) = vr;
        }
    }
    WAITL_BAR();
    const int g = wid >> 1, head = kvh * 4 + g;
    const float slope2 = __builtin_amdgcn_exp2f(-0.5f * (float)(head + 1)) * LOG2E;
    const float sink2 = sinks[head] * LOG2E;
    float qg[4][8];
#pragma unroll
    for (int d0 = 0; d0 < 4; ++d0)
#pragma unroll
        for (int i = 0; i < 8; ++i) qg[d0][i] = qn_c[d0 * 16 + hi * 8 + i] * QS;
    for (int rbi = 0; rbi < 2; ++rbi) {
        const int rb = 2 * (wid & 1) + rbi, rloc = 32 * rb + r32;
        const int tok = b * SEQ + 128 * nb + rloc;
        bf16x8 qr[4];
        { const bf16_t* Qw = E1 + (size_t)tok * OP + C1_Q + head * 64; u32x4 raw[4]; float ss = 0.f;
#pragma unroll
          for (int d0 = 0; d0 < 4; ++d0) { raw[d0] = *(const u32x4*)(Qw + d0 * 16 + hi * 8);
#pragma unroll
              for (int k = 0; k < 4; ++k) { const float a = __uint_as_float(raw[d0][k] << 16), c = __uint_as_float(raw[d0][k] & 0xffff0000u); ss += a * a + c * c; } }
          ss = xhalf_sum(ss);
          const float rr = __builtin_amdgcn_rsqf(ss * (1.f / 64.f) + EPS);
#pragma unroll
          for (int d0 = 0; d0 < 4; ++d0) { u32x4 w;
#pragma unroll
              for (int k = 0; k < 4; ++k) { const float a = __uint_as_float(raw[d0][k] << 16), c = __uint_as_float(raw[d0][k] & 0xffff0000u);
                  w[k] = cvtpk(a * rr * qg[d0][2 * k], c * rr * qg[d0][2 * k + 1]); }
              qr[d0] = __builtin_bit_cast(bf16x8, w); } }
        f32x16 o[2]; o[0] = f32x16{}; o[1] = f32x16{};
        float mref = 0.f, lrun = 0.f;
        const int ktlo = (rb < 2) ? 0 : 1, kthi = (rb < 2) ? 2 : 3;
        for (int kt = ktlo; kt <= kthi; ++kt) {
            if (kt < kt0) continue;
            const float tbm = slope2 * (float)(64 * kt - 128 - rloc) - mref;
            f32x16 p0, p1;
#pragma unroll
            for (int r = 0; r < 16; ++r) { p0[r] = tbm + slope2 * (float)crow(r, hi); p1[r] = p0[r] + 32.f * slope2; }
            qk_tile(p0, p1, L + kt * 8192, qr, r32, hi);
            const int jb = 64 * kt + 4 * hi;
#pragma unroll
            for (int r = 0; r < 16; ++r) { const int jj = jb + (r & 3) + 8 * (r >> 2);
                if (jj < rloc + 1 || jj > rloc + 128) p0[r] = -1e30f;
                if (jj + 32 < rloc + 1 || jj + 32 > rloc + 128) p1[r] = -1e30f; }
            softmax_pv<2>(o, mref, lrun, p0, p1, L + SW_V + kt * 8192, wsf, r32, hi, lane);
        }
        lrun = xhalf_sum(lrun) + __builtin_amdgcn_exp2f(sink2 - mref);
        if (hi == 0) wsf[r32] = lrun;
        LAS bf16_t* stg = (LAS bf16_t*)(l3 + SW_OST) + wid * 2048;
#pragma unroll
        for (int r = 0; r < 16; ++r) { const float rl = __builtin_amdgcn_rcpf(wsf[crow(r, hi)]);
#pragma unroll
            for (int db = 0; db < 2; ++db) stg[crow(r, hi) * 64 + db * 32 + r32] = f2bf(o[db][r] * rl); }
        bf16_t* Yw = Y + (size_t)(b * SEQ + 128 * nb + 32 * rb) * D + head * 64;
#pragma unroll
        for (int i4 = 0; i4 < 4; ++i4) { const int row = i4 * 8 + (lane >> 3), ch = lane & 7; const u32x4 v = *(const LAS u32x4*)(stg + row * 64 + ch * 8);
            *(u32x4*)(Yw + (size_t)row * D + ch * 8) = v; }
    }
    WAITL_BAR();
}

constexpr int DS_KSTR = 4100, DS_QROW = DS_KSTR * 4;
constexpr int DS_HIST = 131584, DS_LIST = 139776;
#define MFMA16(a, b, c) __builtin_amdgcn_mfma_f32_16x16x32_bf16((a), (b), (c), 0, 0, 0)
__device__ __forceinline__ void dsa_unit(const int b, const int i0, const bf16_t* __restrict__ E, const unsigned* __restrict__ SGN, bf16_t* __restrict__ Y, unsigned char* lds) {
    int tid_ = threadIdx.x; asm volatile("" : "+v"(tid_));
    const int tid = tid_, lane = tid & 63, kq = lane >> 4, c16 = lane & 15; const int wid = __builtin_amdgcn_readfirstlane(tid >> 6);
    LAS unsigned char* l3 = (LAS unsigned char*)lds;
    LAS unsigned* keys = (LAS unsigned*)l3;
    const bf16_t* Eb = E + (size_t)b * SEQ * EP;
    const int nt16 = (i0 + 8 + 15) >> 4, n16 = nt16 * 16;
    {
        const int q = c16 & 7, hg = c16 >> 3; const size_t tokq = (size_t)b * SEQ + i0 + q;
        bf16x8 Bq[4][2];
#pragma unroll
        for (int hh = 0; hh < 4; ++hh)
#pragma unroll
            for (int ks = 0; ks < 2; ++ks) Bq[hh][ks] = *(const bf16x8*)(E + tokq * EP + C_IQ + (4 * hg + hh) * 64 + ks * 32 + kq * 8);
        const unsigned sg = SGN[tokq] >> (4 * hg);
        float sm[4];
#pragma unroll
        for (int hh = 0; hh < 4; ++hh) sm[hh] = ((sg >> hh) & 1u) ? -1.f : 1.f;
        for (int t = wid; t < nt16; t += 8) {
            const bf16_t* kr = Eb + (size_t)(16 * t + c16) * EP + C_IK + kq * 8;
            const bf16x8 a0 = *(const bf16x8*)kr, a1 = *(const bf16x8*)(kr + 32);
            f32x4 sc = (f32x4){0.f, 0.f, 0.f, 0.f};
#pragma unroll
            for (int hh = 0; hh < 4; ++hh) { f32x4 acc = MFMA16(a0, Bq[hh][0], ((f32x4){0.f, 0.f, 0.f, 0.f})); acc = MFMA16(a1, Bq[hh][1], acc);
#pragma unroll
                for (int r = 0; r < 4; ++r) sc[r] += sm[hh] * fmaxf(acc[r], 0.f); }
            u32x4 kv;
#pragma unroll
            for (int r = 0; r < 4; ++r) { float s = sc[r] + __shfl_xor(sc[r], 8); s += 0.0f;
                unsigned u = __float_as_uint(s); u = (u & 0x80000000u) ? ~u : (u | 0x80000000u);
                kv[r] = (16 * t + 4 * kq + r <= i0 + q) ? u : 0u; }
            if (hg == 0) *(LAS u32x4*)(keys + q * DS_KSTR + 16 * t + 4 * kq) = kv;
        }
    }
    WAITL_BAR();
    const int qi = i0 + wid, nq = qi + 1;
    LAS unsigned short* list = (LAS unsigned short*)(l3 + DS_LIST) + wid * 256;
    int cnt;
    {
        LAS unsigned* myk = keys + wid * DS_KSTR;
        unsigned kreg[64];
#pragma unroll
        for (int i = 0; i < 64; ++i) { const int j = 64 * i + lane; kreg[i] = (j < n16) ? myk[j] : 0u; }
        unsigned T = 0u; int need = 1 << 20;
        if (nq > 256) {
            LAS unsigned* hist = (LAS unsigned*)(l3 + DS_HIST) + wid * 256;
            unsigned prefix = 0u, msk = 0u; int remaining = 256;
#pragma unroll 1
            for (int pass = 0; pass < 4; ++pass) {
                const int shift = 24 - 8 * pass;
                *(LAS u32x4*)(hist + 4 * lane) = (u32x4){0u, 0u, 0u, 0u};
                asm volatile("" ::: "memory");
#pragma unroll
                for (int i = 0; i < 64; ++i) { const unsigned k = kreg[i];
                    if (k != 0u && (k & msk) == prefix) __hip_atomic_fetch_add(hist + ((k >> shift) & 255u), 1u, __ATOMIC_RELAXED, __HIP_MEMORY_SCOPE_WAVEFRONT); }
                asm volatile("s_waitcnt lgkmcnt(0)" ::: "memory");
                const u32x4 hv = *(const LAS u32x4*)(hist + 4 * lane);
                const int s = (int)(hv[0] + hv[1] + hv[2] + hv[3]);
                int suf = s;
#pragma unroll
                for (int off = 1; off < 64; off <<= 1) { const int tv = __shfl_down(suf, off); if (lane + off < 64) suf += tv; }
                int cum = suf - s, found = -1, remn = 0;
#pragma unroll
                for (int d = 3; d >= 0; --d) { const int c = (int)hv[d]; if (found < 0 && cum < remaining && cum + c >= remaining) { found = 4 * lane + d; remn = remaining - cum; } cum += c; }
                const unsigned long long bal = __ballot(found >= 0);
                const int srcl = (int)__ffsll((long long)bal) - 1;
                const int digit = __shfl(found, srcl); remaining = __shfl(remn, srcl);
                prefix |= (unsigned)digit << shift; msk |= 255u << shift;
            }
            T = prefix; need = remaining;
        }
        int basep = 0;
        const unsigned long long lt = (lane == 0) ? 0ull : (~0ull >> (64 - lane));
#pragma unroll
        for (int i = 0; i < 64; ++i) {
            if (64 * i < n16) {
                const unsigned k = kreg[i];
                const bool gt = (nq > 256) ? (k > T) : (k != 0u), eq = (nq > 256) && (k == T);
                const unsigned long long beq = __ballot(eq);
                const int rank = __popcll(beq & lt);
                const bool sel = gt || (eq && rank < need);
                need -= __popcll(beq); if (need < 0) need = 0;
                const unsigned long long bs = __ballot(sel);
                const int pos = basep + __popcll(bs & lt);
                if (sel && pos < 256) list[pos] = (unsigned short)(64 * i + lane);
                basep += __popcll(bs);
            }
        }
        cnt = basep < 256 ? basep : 256;
    }
    asm volatile("s_waitcnt lgkmcnt(0)" ::: "memory");
    {
        const size_t tok = (size_t)b * SEQ + qi; const int hd = c16 & 7;
        bf16x8 Bb[2];
#pragma unroll
        for (int ks = 0; ks < 2; ++ks) Bb[ks] = *(const bf16x8*)(E + tok * EP + C_BQ + hd * 64 + ks * 32 + kq * 8);
        const float slope2 = __builtin_amdgcn_exp2f(-(float)(hd + 1)) * LOG2E;
        f32x4 lg[4][4];
#pragma unroll
        for (int c4 = 0; c4 < 4; ++c4)
#pragma unroll
            for (int tt = 0; tt < 4; ++tt) {
                const int slot = 64 * c4 + 16 * tt + c16; const int j = (slot < cnt) ? (int)list[slot] : 0;
                const bf16_t* kr = Eb + (size_t)j * EP + C_BK + kq * 8;
                const bf16x8 a0 = *(const bf16x8*)kr, a1 = *(const bf16x8*)(kr + 32);
                f32x4 acc = MFMA16(a0, Bb[0], ((f32x4){0.f, 0.f, 0.f, 0.f})); acc = MFMA16(a1, Bb[1], acc);
                const int s0 = 64 * c4 + 16 * tt + 4 * kq;
                const u32x2 jl = *(const LAS u32x2*)(list + s0);
                const int j0 = jl[0] & 0xffff, j1 = jl[0] >> 16, j2 = jl[1] & 0xffff, j3 = jl[1] >> 16;
                lg[c4][tt][0] = (s0 + 0 < cnt) ? acc[0] + slope2 * (float)(j0 - qi) : -1e30f;
                lg[c4][tt][1] = (s0 + 1 < cnt) ? acc[1] + slope2 * (float)(j1 - qi) : -1e30f;
                lg[c4][tt][2] = (s0 + 2 < cnt) ? acc[2] + slope2 * (float)(j2 - qi) : -1e30f;
                lg[c4][tt][3] = (s0 + 3 < cnt) ? acc[3] + slope2 * (float)(j3 - qi) : -1e30f;
            }
        float mx = -1e30f;
#pragma unroll
        for (int c4 = 0; c4 < 4; ++c4)
#pragma unroll
            for (int tt = 0; tt < 4; ++tt)
#pragma unroll
                for (int r = 0; r < 4; ++r) mx = fmaxf(mx, lg[c4][tt][r]);
        mx = fmaxf(mx, __shfl_xor(mx, 16)); mx = fmaxf(mx, __shfl_xor(mx, 32));
        float sum = 0.f;
#pragma unroll
        for (int c4 = 0; c4 < 4; ++c4)
#pragma unroll
            for (int tt = 0; tt < 4; ++tt)
#pragma unroll
                for (int r = 0; r < 4; ++r) { const float e = __builtin_amdgcn_exp2f(lg[c4][tt][r] - mx); lg[c4][tt][r] = e; sum += e; }
        sum += __shfl_xor(sum, 16); sum += __shfl_xor(sum, 32);
        const float inv = __builtin_amdgcn_rcpf(sum);
        LAS unsigned char* vst = l3 + wid * DS_QROW;
        f32x4 oacc[4];
#pragma unroll
        for (int dt = 0; dt < 4; ++dt) oacc[dt] = (f32x4){0.f, 0.f, 0.f, 0.f};
        const int qp = c16 >> 2, pp4 = c16 & 3;
#pragma unroll
        for (int c4 = 0; c4 < 4; ++c4) {
#pragma unroll
            for (int it = 0; it < 8; ++it) { const int row = 8 * it + (lane >> 3), ch = lane & 7, slot = 64 * c4 + row; const int j = (slot < cnt) ? (int)list[slot] : 0;
                const u32x4 v = *(const u32x4*)(Eb + (size_t)j * EP + C_BV + ch * 8);
                *(LAS u32x4*)(vst + row * 128 + ((ch ^ (row & 7)) * 16)) = v; }
            asm volatile("" ::: "memory");
#pragma unroll
            for (int pp = 0; pp < 2; ++pp) {
                const f32x4 l0 = lg[c4][2 * pp] * inv, l1 = lg[c4][2 * pp + 1] * inv;
                u32x4 pw; pw[0] = cvtpk(l0[0], l0[1]); pw[1] = cvtpk(l0[2], l0[3]); pw[2] = cvtpk(l1[0], l1[1]); pw[3] = cvtpk(l1[2], l1[3]);
                const int rlo = 32 * pp + 4 * kq + qp, rhi = rlo + 16;
#pragma unroll
                for (int dt = 0; dt < 4; ++dt) { const int chunk = 2 * dt + (pp4 >> 1);
                    const s16x4 lo = vtr((lds_cptr)(vst + rlo * 128 + ((chunk ^ (rlo & 7)) * 16) + (pp4 & 1) * 8));
                    const s16x4 hh = vtr((lds_cptr)(vst + rhi * 128 + ((chunk ^ (rhi & 7)) * 16) + (pp4 & 1) * 8));
                    const bf16x8 vf = (bf16x8){lo[0], lo[1], lo[2], lo[3], hh[0], hh[1], hh[2], hh[3]};
                    oacc[dt] = MFMA16(vf, __builtin_bit_cast(bf16x8, pw), oacc[dt]); }
            }
            asm volatile("" ::: "memory");
        }
        if (c16 < 8) {
            bf16_t* yo = Y + tok * D + 512 + hd * 64 + 4 * kq;
#pragma unroll
            for (int dt = 0; dt < 4; ++dt) { u32x2 w; w[0] = cvtpk(oacc[dt][0], oacc[dt][1]); w[1] = cvtpk(oacc[dt][2], oacc[dt][3]); *(u32x2*)(yo + 16 * dt) = w; }
        }
    }
    WAITL_BAR();
}

#define XB_TMO      128
#define XB_XCNT(j)  (256  + 64 * (j))
#define XB_XSUB(j)  (1280 + 64 * (j))
#define XB_XGEN(j)  (2304 + 64 * (j))
#define XB_TOP      3328
#define XB_TOPGEN   3392
#define XCD_BAR_WORDS 3456
#define XB_SPIN_CAP (1u << 18)
__device__ __forceinline__ unsigned xb_ld(unsigned* p)              { return __hip_atomic_load(p, __ATOMIC_RELAXED, __HIP_MEMORY_SCOPE_AGENT); }
__device__ __forceinline__ unsigned xb_add(unsigned* p, unsigned v) { return __hip_atomic_fetch_add(p, v, __ATOMIC_RELAXED, __HIP_MEMORY_SCOPE_AGENT); }
__device__ __forceinline__ unsigned xb_xcc_id() { return (unsigned)__builtin_amdgcn_s_getreg((3 << 11) | 20) & 0xFu; }
#define XB_SPIN(cond, bar) do { unsigned _sp = 0; while (cond) { __builtin_amdgcn_s_sleep(1); \
    if ((++_sp & 255u) == 0u) { if (xb_ld(&(bar)[XB_TMO])) break; if (_sp > XB_SPIN_CAP) { atomicAdd(&(bar)[XB_TMO], 1u); break; } } } } while (0)
struct XcdBarrier { unsigned* bar; unsigned x; volatile LAS unsigned* st; };
__device__ __forceinline__ XcdBarrier xcd_barrier_post(unsigned* bar, volatile LAS unsigned* st) {
    XcdBarrier b; b.bar = bar; b.x = xb_xcc_id(); b.st = st;
    if (threadIdx.x == 0) (void)xb_add(&bar[XB_XCNT(b.x)], 1u);
    return b;
}
__device__ __forceinline__ void xcd_barrier_complete(unsigned* bar, unsigned x, unsigned& nloc, unsigned& nx) {
    const unsigned G = gridDim.x * gridDim.y * gridDim.z;
    unsigned sum, cnt, mine, sp = 0u;
    for (;;) {
        sum = 0u; cnt = 0u; mine = 0u;
#pragma unroll
        for (unsigned j = 0; j < 16; ++j) { const unsigned c = xb_ld(&bar[XB_XCNT(j)]); sum += c; cnt += (c > 0u) ? 1u : 0u; mine = (j == x) ? c : mine; }
        if (sum == G) break;
        __builtin_amdgcn_s_sleep(1);
        if ((++sp & 255u) == 0u) { if (xb_ld(&bar[XB_TMO])) break; if (sp > XB_SPIN_CAP) { atomicAdd(&bar[XB_TMO], 1u); break; } }
    }
    nloc = mine > 0u ? mine : 1u; nx = cnt > 0u ? cnt : 1u;
}
__device__ __forceinline__ void xcd_barrier(const XcdBarrier& b) {
    asm volatile("s_waitcnt vmcnt(0)" ::: "memory");
    __syncthreads();
    if (threadIdx.x == 0) {
        unsigned* bar = b.bar;
        __builtin_amdgcn_s_waitcnt(0);
        unsigned nloc = b.st[0], nx = b.st[1];
        if (nloc == 0u) { xcd_barrier_complete(bar, b.x, nloc, nx); b.st[0] = nloc; b.st[1] = nx; }
        const unsigned old = xb_add(&bar[XB_XSUB(b.x)], 1u);
        const unsigned gen = old / nloc;
        if (old + 1u == (gen + 1u) * nloc) {
            __builtin_amdgcn_fence(__ATOMIC_RELEASE, "agent");
            asm volatile("s_waitcnt vmcnt(0)" ::: "memory");
            const unsigned og = xb_add(&bar[XB_TOP], 1u);
            const unsigned tg = og / nx;
            if (og + 1u == (tg + 1u) * nx) xb_add(&bar[XB_TOPGEN], 1u);
            else XB_SPIN(xb_ld(&bar[XB_TOPGEN]) == tg, bar);
            __builtin_amdgcn_fence(__ATOMIC_ACQUIRE, "agent");
            xb_add(&bar[XB_XGEN(b.x)], 1u);
            asm volatile("s_waitcnt vmcnt(0)" ::: "memory");
        } else {
            XB_SPIN(xb_ld(&bar[XB_XGEN(b.x)]) == gen, bar);
            __builtin_amdgcn_fence(__ATOMIC_ACQUIRE, "agent");
            asm volatile("s_waitcnt vmcnt(0)" ::: "memory");
        }
    }
    __syncthreads();
}

struct Params {
    const float* in[24]; float* out; unsigned char* ws; int ph_lo, ph_hi;
};
constexpr int LDS_BYTES = 163840, MISC_OFF = LDS_BYTES - 512;

__device__ __forceinline__ void tr_item(const float* __restrict__ W, int ldsrc, int ncol0, int nvalid, int K, int k0, bf16_t* __restrict__ WT, LAS float* scr, int lane) {
    const int c = lane & 31;
#pragma unroll 8
    for (int i = 0; i < 32; ++i) { const int kk = 2 * i + (lane >> 5); scr[kk * 33 + c] = (c < nvalid) ? W[(size_t)(k0 + kk) * ldsrc + ncol0 + c] : 0.f; }
    asm volatile("s_waitcnt lgkmcnt(0)" ::: "memory");
    const int c8 = lane & 7;
#pragma unroll
    for (int j = 0; j < 4; ++j) { const int n = (lane >> 3) + 8 * j; const LAS float* s = scr + (8 * c8) * 33 + n;
        u32x4 o; o.x = pk2(s[0 * 33], s[1 * 33]); o.y = pk2(s[2 * 33], s[3 * 33]); o.z = pk2(s[4 * 33], s[5 * 33]); o.w = pk2(s[6 * 33], s[7 * 33]);
        *(u32x4*)(WT + (size_t)n * K + k0 + 8 * c8) = o; }
    asm volatile("s_waitcnt lgkmcnt(0)" ::: "memory");
}

__device__ __forceinline__ void phase_prologue(const Params& p, unsigned char* lds, int G) {
    int tid_ = threadIdx.x; asm volatile("" : "+v"(tid_));
    const int tid = tid_, lane = tid & 63; const int wid = __builtin_amdgcn_readfirstlane(tid >> 6);
    LAS unsigned char* l3 = (LAS unsigned char*)lds;
    {
        LAS float* sc = (LAS float*)l3; LAS float* part = (LAS float*)(l3 + 16384);
        const float* c = p.in[1]; const float* ada_w = p.in[2]; const float* ada_b = p.in[3]; float* mod = (float*)(p.ws + WS_MOD);
        if ((int)blockIdx.x < 192) {
            for (int i = tid; i < 4096; i += 512) { const float v = c[i]; sc[i] = v / (1.f + expf(-v)); }
            __syncthreads();
            for (int item = blockIdx.x; item < 192; item += G) {
                const int l = item / 96, n0 = (item % 96) * 64;
                const float* W = ada_w + (size_t)l * 1024 * MODN + n0 + lane;
                float a0 = 0.f, a1 = 0.f, a2 = 0.f, a3 = 0.f;
#pragma unroll 8
                for (int k = wid * 128; k < wid * 128 + 128; ++k) { const float wv = W[(size_t)k * MODN]; a0 += sc[k] * wv; a1 += sc[1024 + k] * wv; a2 += sc[2048 + k] * wv; a3 += sc[3072 + k] * wv; }
                part[(wid * 4 + 0) * 64 + lane] = a0; part[(wid * 4 + 1) * 64 + lane] = a1; part[(wid * 4 + 2) * 64 + lane] = a2; part[(wid * 4 + 3) * 64 + lane] = a3;
                __syncthreads();
                if (tid < 256) { const int b = tid >> 6, col = tid & 63; float s = 0.f;
#pragma unroll
                    for (int ww = 0; ww < 8; ++ww) s += part[(ww * 4 + b) * 64 + col];
                    mod[(size_t)(l * 4 + b) * MODN + n0 + col] = s + ada_b[l * MODN + n0 + col]; }
                __syncthreads();
            }
        }
        __syncthreads();
    }
    LAS float* scr = (LAS float*)(l3 + wid * 16384);
    const int gw = blockIdx.x * 8 + wid, NGW = G * 8;
    constexpr int I0 = 88 * 16, I1 = 2 * 32 * 16, I2 = 2 * 176 * 16, I3 = 2 * 32 * 44, I4 = 48 * 16, NIT = I0 + I1 + I2 + I3 + I4;
    for (int it = gw; it < NIT; it += NGW) {
        int r = it;
        if (r < I0) { const int g = r / 16, kb = r % 16; int nv = ECOLS - 32 * g; nv = nv < 0 ? 0 : (nv > 32 ? 32 : nv);
            tr_item(p.in[10], ECOLS, 32 * g, nv, D, 64 * kb, (bf16_t*)(p.ws + WS_WIN0) + (size_t)(32 * g) * D, scr, lane); continue; }
        r -= I0;
        if (r < I1) { const int l = r / 512, g = (r % 512) / 16, kb = r % 16;
            tr_item(p.in[6] + (size_t)l * D * D, D, 32 * g, 32, D, 64 * kb, (bf16_t*)(p.ws + WS_WOUT) + (size_t)l * D * D + (size_t)(32 * g) * D, scr, lane); continue; }
        r -= I1;
        if (r < I2) { const int l = r / (176 * 16), g = (r % (176 * 16)) / 16, kb = r % 16; const int tile = g >> 3, cg = g & 7;
            const float* src = (cg < 4 ? p.in[7] : p.in[8]) + (size_t)l * D * FF;
            tr_item(src, FF, tile * 128 + (cg & 3) * 32, 32, D, 64 * kb, (bf16_t*)(p.ws + WS_WGU) + (size_t)l * GU * D + (size_t)(32 * g) * D, scr, lane); continue; }
        r -= I2;
        if (r < I3) { const int l = r / (32 * 44), g = (r % (32 * 44)) / 44, kb = r % 44;
            tr_item(p.in[9] + (size_t)l * FF * D, D, 32 * g, 32, FF, 64 * kb, (bf16_t*)(p.ws + WS_WDN) + (size_t)l * D * FF + (size_t)(32 * g) * FF, scr, lane); continue; }
        r -= I3;
        { const int g = r / 16, kb = r % 16;
            tr_item(p.in[20], OP, 32 * g, 32, D, 64 * kb, (bf16_t*)(p.ws + WS_WIN1) + (size_t)(32 * g) * D, scr, lane); }
    }
}

__device__ __forceinline__ void phase_norm(const float* __restrict__ x, const float* __restrict__ gain, const float* __restrict__ modl, int sh_off, int sc_off, bf16_t* __restrict__ XN, int G) {
    int tid_ = threadIdx.x; asm volatile("" : "+v"(tid_));
    const int lane = tid_ & 63; const int gw = blockIdx.x * 8 + (tid_ >> 6), NGW = G * 8;
    for (int row = gw; row < M; row += NGW) {
        const int b = row / SEQ;
        const f32x4* xr = (const f32x4*)(x + (size_t)row * D);
        f32x4 v[4]; float s = 0.f;
#pragma unroll
        for (int j = 0; j < 4; ++j) { v[j] = xr[64 * j + lane]; s += v[j][0] * v[j][0] + v[j][1] * v[j][1] + v[j][2] * v[j][2] + v[j][3] * v[j][3]; }
        s = wave_sum(s);
        const float r = __builtin_amdgcn_rsqf(s * (1.f / D) + EPS);
        const float* mb = modl + (size_t)b * MODN;
#pragma unroll
        for (int j = 0; j < 4; ++j) {
            const int col = 4 * (64 * j + lane);
            const f32x4 g = *(const f32x4*)(gain + col), scv = *(const f32x4*)(mb + sc_off + col), shv = *(const f32x4*)(mb + sh_off + col);
            const f32x4 y = v[j] * r * g * (1.f + scv) + shv;
            u32x2 o; o[0] = pk2(y[0], y[1]); o[1] = pk2(y[2], y[3]);
            *(u32x2*)(XN + (size_t)row * D + col) = o;
        }
    }
}

__device__ __forceinline__ void phase_post0(bf16_t* E, unsigned* __restrict__ SGN, const float* __restrict__ qn_a, const float* __restrict__ kn_a, const float* __restrict__ qn_b, const float* __restrict__ kn_b, int G) {
    int tid_ = threadIdx.x; asm volatile("" : "+v"(tid_));
    const int lane = tid_ & 63; const int gw = blockIdx.x * 8 + (tid_ >> 6), NGW = G * 8;
    const int sub = (lane & 7) * 8;
    for (int row = gw; row < M; row += NGW) {
        bf16_t* e = E + (size_t)row * EP;
        float w[8]; unsigned sgn = 0;
        { const u32x4 wr_ = *(const u32x4*)(e + C_IW);
          w[0] = __uint_as_float(wr_[0] << 16); w[1] = __uint_as_float(wr_[0] & 0xffff0000u); w[2] = __uint_as_float(wr_[1] << 16); w[3] = __uint_as_float(wr_[1] & 0xffff0000u);
          w[4] = __uint_as_float(wr_[2] << 16); w[5] = __uint_as_float(wr_[2] & 0xffff0000u); w[6] = __uint_as_float(wr_[3] << 16); w[7] = __uint_as_float(wr_[3] & 0xffff0000u); }
#pragma unroll
        for (int h = 0; h < 8; ++h) if (w[h] < 0.f) sgn |= 1u << h;
        if (lane == 0) SGN[row] = sgn;
#pragma unroll 1
        for (int it = 0; it < 6; ++it) {
            const int grp = it * 8 + (lane >> 3), col = grp * 64 + sub;
            const bool act = grp < 43;
            const u32x4 raw = act ? *(const u32x4*)(e + col) : (u32x4){0u, 0u, 0u, 0u};
            float v[8];
#pragma unroll
            for (int k = 0; k < 4; ++k) { v[2 * k] = __uint_as_float(raw[k] << 16); v[2 * k + 1] = __uint_as_float(raw[k] & 0xffff0000u); }
            float ss = 0.f;
#pragma unroll
            for (int i = 0; i < 8; ++i) ss += v[i] * v[i];
            ss += __shfl_xor(ss, 1); ss += __shfl_xor(ss, 2); ss += __shfl_xor(ss, 4);
            const float r = __builtin_amdgcn_rsqf(ss * (1.f / 64.f) + EPS);
            const float* gp = nullptr; float scale = 1.f; bool wrt = false;
            if (grp < 8) { gp = qn_a; scale = r * QS; wrt = true; }
            else if (grp < 16) { gp = kn_a; scale = r; wrt = true; }
            else if (grp < 24) { }
            else if (grp < 32) { gp = qn_b; scale = r * QS; wrt = true; }
            else if (grp == 32) { gp = kn_b; scale = r; wrt = true; }
            else if (grp == 33) { }
            else if (grp < 42) { float wsel = 0.f;
#pragma unroll
                for (int h = 0; h < 8; ++h) wsel = (grp - 34 == h) ? w[h] : wsel;
                scale = fabsf(wsel) * IS; wrt = true; }
            if (act && wrt) {
                u32x4 ov;
#pragma unroll
                for (int k = 0; k < 4; ++k) ov[k] = pk2(v[2 * k] * scale * (gp ? gp[sub + 2 * k] : 1.f), v[2 * k + 1] * scale * (gp ? gp[sub + 2 * k + 1] : 1.f));
                *(u32x4*)(e + col) = ov;
            }
        }
    }
}

__global__ void __launch_bounds__(512, 2) mega_fwd(Params p) {
    extern __shared__ __attribute__((aligned(16))) unsigned char lds[];
    const int tid = threadIdx.x, lane = tid & 63; const int wid = __builtin_amdgcn_readfirstlane(tid >> 6);
    const int G = gridDim.x, cb = blockIdx.x;
    LAS unsigned char* l3 = (LAS unsigned char*)lds;
    volatile LAS unsigned* MISC = (volatile LAS unsigned*)(l3 + MISC_OFF);
    if (tid < 128) MISC[tid] = 0u;
    __syncthreads();
    unsigned* ctl = (unsigned*)(p.ws + WS_CTL);
    const bool multi = (p.ph_hi - p.ph_lo) > 1;
    XcdBarrier bar; bar.bar = ctl + 1024; bar.x = 0; bar.st = nullptr;
    if (multi) bar = xcd_barrier_post(ctl + 1024, MISC + 8);
    const float* x = p.in[0]; float* out = p.out;

    for (int ph = p.ph_lo; ph < p.ph_hi; ++ph) {
        unsigned char* ws = p.ws; asm volatile("" : "+s"(ws));
        int lane_o = tid; asm volatile("" : "+v"(lane_o)); lane_o &= 63;
        float* mod = (float*)(ws + WS_MOD); unsigned* SGN = (unsigned*)(ws + WS_SGN);
        bf16_t* XN = (bf16_t*)(ws + WS_XN); bf16_t* Yb = (bf16_t*)(ws + WS_Y); bf16_t* E = (bf16_t*)(ws + WS_E);
        const int l = ph >= 9 ? 1 : 0;
        int kind;
        if (l == 0) kind = ph; else { const int k1 = ph - 9; kind = (k1 == 0) ? 1 : (k1 == 1) ? 2 : (k1 == 2) ? 9 : k1 + 2; }
        const float* modl = mod + (size_t)l * 4 * MODN;
        if (kind == 0) phase_prologue(p, lds, G);
        else if (kind == 1) phase_norm(l == 0 ? x : out, p.in[4] + l * D, modl, 0, 1024, XN, G);
        else if (kind == 6) phase_norm(out, p.in[5] + l * D, modl, 3072, 4096, XN, G);
        else if (kind == 2) {
            pg8::Gemm g{XN, (const bf16_t*)(ws + (l == 0 ? WS_WIN0 : WS_WIN1)), M, l == 0 ? EP : OP, D};
            pg8::StaticOrder S; S.init(M, g.N, G, cb);
            pg8::EpiRawBf16 Ep{E, g.N};
            pg8::gemm_phase<pg8::EpiRawBf16, pg8::StaticOrder, true, true>(l3, g, S, Ep);
        }
        else if (kind == 3) phase_post0(E, SGN, p.in[11], p.in[12], p.in[18], p.in[19], G);
        else if (kind == 4) {
            const float t1 = wave_sum(p.in[13][lane_o] * p.in[14][lane_o]), t2 = wave_sum(p.in[15][lane_o] * p.in[16][lane_o]);
            const float lam = expf(t1) - expf(t2) + 0.2f;
            for (int u = cb; u < 512; u += G) { const int bh = u & 15, s = (u >> 4) & 15, qb = (u >> 8) ? 31 - s : s;
                attnA_unit(bh >> 2, bh & 3, qb, E, Yb, lam, p.in[17], lds); }
            for (int idx = cb; idx < 2048; idx += G) { const int bb = idx & 3, s = idx >> 2, blk = s >> 6, xx = s & 63, ib = (blk & 1) ? (blk * 64 + 63 - xx) : s;
                dsa_unit(bb, ib * 8, E, SGN, Yb, lds); }
        }
        else if (kind == 9) {
            for (int u = cb; u < 512; u += G) { const int bk = u & 15, nb = (u >> 4) & 31;
                swa_unit(bk >> 2, bk & 3, nb, E, Yb, p.in[21], p.in[22], p.in[23], lds); }
        }
        else if (kind == 5 || kind == 8) {
            const bool dn = (kind == 8);
            pg8::Gemm g{dn ? E : Yb, (const bf16_t*)(ws + (dn ? WS_WDN : WS_WOUT)) + (size_t)l * (dn ? D * FF : D * D), M, D, dn ? FF : D};
            pg8::StaticOrder S; S.init(M, D, G, cb);
            pg8::EpiResGate Ep{(kind == 5 && l == 0) ? x : out, out, modl + (dn ? 5120 : 2048)};
            pg8::gemm_phase<pg8::EpiResGate, pg8::StaticOrder, true, true>(l3, g, S, Ep);
        }
        else if (kind == 7) {
            pg8::Gemm g{XN, (const bf16_t*)(ws + WS_WGU) + (size_t)l * GU * D, M, GU, D};
            pg8::StaticOrder S; S.init(M, GU, G, cb);
            pg8::EpiSwiglu Ep{E};
            pg8::gemm_phase<pg8::EpiSwiglu, pg8::StaticOrder, true, true>(l3, g, S, Ep);
        }
        if (ph + 1 < p.ph_hi) xcd_barrier(bar);
    }
}

#ifndef MK_SPLIT
#define MK_SPLIT 0
#endif
extern "C" void kernel_launch(void* const* d_in, const int* in_sizes, int n_in, void* d_out, int out_size, void* d_ws, size_t ws_size, hipStream_t stream) {
    static int grid = 0;
    if (grid == 0) {
        int dev = 0, cus = 0, per_cu = 0;
        if (hipGetDevice(&dev) != hipSuccess || hipDeviceGetAttribute(&cus, hipDeviceAttributeMultiprocessorCount, dev) != hipSuccess) { fprintf(stderr, "kernel_launch: device query failed\n"); grid = -1; return; }
        if (hipFuncSetAttribute((const void*)mega_fwd, hipFuncAttributeMaxDynamicSharedMemorySize, LDS_BYTES) != hipSuccess) { fprintf(stderr, "kernel_launch: hipFuncSetAttribute failed\n"); grid = -1; return; }
        if (hipOccupancyMaxActiveBlocksPerMultiprocessor(&per_cu, (const void*)mega_fwd, 512, LDS_BYTES) != hipSuccess || per_cu < 1) { fprintf(stderr, "kernel_launch: occupancy query says %d\n", per_cu); (void)hipGetLastError(); per_cu = 1; }
        grid = cus;
    }
    if (grid < 0) return;
    (void)hipMemsetAsync((char*)d_ws + WS_CTL, 0, CTL_ZERO_BYTES, stream);
    Params p{};
    for (int i = 0; i < 24; ++i) p.in[i] = (const float*)d_in[i];
    p.out = (float*)d_out; p.ws = (unsigned char*)d_ws;
#if MK_SPLIT
    for (int ph = 0; ph < 16; ++ph) { p.ph_lo = ph; p.ph_hi = ph + 1; hipLaunchKernelGGL(mega_fwd, dim3(grid), dim3(512), LDS_BYTES, stream, p); }
#else
    p.ph_lo = 0; p.ph_hi = 16;
    void* args[] = {&p};
    hipError_t e = hipLaunchCooperativeKernel((const void*)mega_fwd, dim3(grid), dim3(512), args, LDS_BYTES, stream);
    if (e != hipSuccess) fprintf(stderr, "kernel_launch: cooperative launch failed: %s\n", hipGetErrorString(e));
#endif
}
```

```cpp
#include <hip/hip_runtime.h>
#include <cstdio>
#include <stdint.h>

#define LAS __attribute__((address_space(3)))
#define GAS __attribute__((address_space(1)))
typedef unsigned short bf16_t;
typedef short bf16x8 __attribute__((ext_vector_type(8)));
typedef short s16x4 __attribute__((ext_vector_type(4)));
typedef short v4i16_t __attribute__((ext_vector_type(4)));
typedef float f32x4 __attribute__((ext_vector_type(4)));
typedef float f32x16 __attribute__((ext_vector_type(16)));
typedef unsigned u32x4 __attribute__((ext_vector_type(4)));
typedef unsigned u32x2 __attribute__((ext_vector_type(2)));
typedef float f32x2_t __attribute__((ext_vector_type(2)));
typedef __bf16 bf16x2_t __attribute__((ext_vector_type(2)));
typedef LAS const char* lds_cptr;

constexpr int D = 1024, BATCH = 4, SEQ = 4096, M = BATCH * SEQ, FF = 2816, ECOLS = 2760, EP = 2816, OP = 1536, MODN = 6144, GU = 2 * FF;
constexpr float LOG2E = 1.4426950408889634f;
constexpr float QS = 0.125f * LOG2E;
constexpr float IS = 0.125f * 0.35355339059327373f;
constexpr float EPS = 1e-6f;
constexpr int C_AQ = 0, C_AK = 512, C_AV = 1024, C_BQ = 1536, C_BK = 2048, C_BV = 2112, C_IQ = 2176, C_IK = 2688, C_IW = 2752;
constexpr int C1_Q = 0, C1_K = 1024, C1_V = 1280;

constexpr size_t MiB = 1u << 20;
constexpr size_t WS_CTL = 0, CTL_ZERO_BYTES = 64 * 1024;
constexpr size_t WS_MOD = 1 * MiB, WS_SGN = 1 * MiB + 512 * 1024;
constexpr size_t WS_WIN0 = 2 * MiB;
constexpr size_t WS_WOUT = 8 * MiB;
constexpr size_t WS_WGU = 12 * MiB;
constexpr size_t WS_WDN = 34 * MiB;
constexpr size_t WS_WIN1 = 45 * MiB;
constexpr size_t WS_XN = 50 * MiB, WS_Y = 82 * MiB, WS_E = 114 * MiB, WS_END = 202 * MiB;
constexpr size_t WS_IKC = 202 * MiB, WS_BKC = 204 * MiB, WS_BVC = 206 * MiB;

__device__ __forceinline__ float bf2f(bf16_t v) { return __uint_as_float((unsigned)v << 16); }
__device__ __forceinline__ bf16_t f2bf(float f) { unsigned u = __float_as_uint(f); return (bf16_t)((u + 0x7fffu + ((u >> 16) & 1u)) >> 16); }
__device__ __forceinline__ unsigned pk2(float lo, float hi) { return (unsigned)f2bf(lo) | ((unsigned)f2bf(hi) << 16); }
__device__ __forceinline__ unsigned cvtpk(float lo, float hi) { f32x2_t v = {lo, hi}; bf16x2_t b = __builtin_convertvector(v, bf16x2_t); return __builtin_bit_cast(unsigned, b); }
__device__ __forceinline__ float wave_sum(float v) {
#pragma unroll
    for (int o = 1; o < 64; o <<= 1) v += __shfl_xor(v, o);
    return v;
}
__device__ __forceinline__ float wave_max(float v) {
#pragma unroll
    for (int o = 1; o < 64; o <<= 1) v = fmaxf(v, __shfl_xor(v, o));
    return v;
}
__device__ __forceinline__ int crow(int r, int hi) { return (r & 3) + 8 * (r >> 2) + 4 * hi; }
__device__ __forceinline__ float xhalf_max(float m) { auto rr = __builtin_amdgcn_permlane32_swap(__float_as_uint(m), __float_as_uint(m), false, false); return fmaxf(__uint_as_float(rr[0]), __uint_as_float(rr[1])); }
__device__ __forceinline__ float xhalf_sum(float m) { auto rr = __builtin_amdgcn_permlane32_swap(__float_as_uint(m), __float_as_uint(m), false, false); return __uint_as_float(rr[0]) + __uint_as_float(rr[1]); }
__device__ __forceinline__ void glds16(const void* gsrc, unsigned lds_dst) { unsigned keep;
    asm volatile("s_mov_b32 %0, m0\n\ts_mov_b32 m0, %2\n\ts_nop 0\n\tglobal_load_lds_dwordx4 %1, off\n\ts_mov_b32 m0, %0" : "=&s"(keep) : "v"(gsrc), "s"(lds_dst) : "memory"); }
__device__ __forceinline__ s16x4 vtr(lds_cptr p) { return __builtin_bit_cast(s16x4, __builtin_amdgcn_ds_read_tr16_b64_v4i16((LAS v4i16_t*)p)); }
#define WAITV_BAR() asm volatile("s_waitcnt vmcnt(0) lgkmcnt(0)\n\ts_barrier" ::: "memory")
#define WAITL_BAR() asm volatile("s_waitcnt lgkmcnt(0)\n\ts_barrier" ::: "memory")

namespace pg8 {
constexpr int BM = 256, BK = 64, HALF = 128, HTB = HALF * BK * 2, STAGE_BYTES = 8 * HTB, NXCD = 8, WGM = 8;
__host__ __device__ __forceinline__ int lds_byte(int r, int c) { const int st = (r >> 4) * 2 + (c >> 5), rr = r & 15, cc = c & 31, ob = rr * 64 + cc * 2; return st * 1024 + (ob ^ (((ob >> 9) & 1) << 5)); }
__host__ __device__ __forceinline__ void stage_rc(int b, int& R, int& C) { const int st = b / 1024, sb = b % 1024, swz = sb ^ (((sb >> 9) & 1) << 5); R = (st >> 1) * 16 + swz / 64; C = (st & 1) * 32 + (swz % 64) / 2; }
__host__ __device__ __forceinline__ int perm32(int rho) { const int n = rho >> 4, i = rho & 15; return 8 * (i >> 2) + 4 * n + (i & 3); }
struct Unit { int pm, pn; };
struct Gemm { const bf16_t* A; const bf16_t* Bt; int M, N, K; };
struct StaticOrder {
    int nM, nN, nwg, G, c;
    __host__ __device__ void init(int M_, int N_, int G_, int c_) { nM = M_ / BM; nN = N_ / BM; nwg = nM * nN; G = G_; c = c_; }
    __host__ __device__ bool next(int i, Unit& u) const {
        const long L = (long)i * G + c; if (L >= nwg) return false;
        int wgid = (int)L; { const int q = nwg / NXCD, r = nwg % NXCD, xcd = wgid % NXCD, off = wgid / NXCD; wgid = (xcd < r ? xcd * (q + 1) : r * (q + 1) + (xcd - r) * q) + off; }
        const int nig = WGM * nN, gid = wgid / nig, fm = gid * WGM, gsz = (nM - fm) < WGM ? (nM - fm) : WGM;
        u.pm = fm + ((wgid % nig) % gsz); u.pn = (wgid % nig) / gsz; return true;
    }
    __device__ __forceinline__ void a_ready(const Unit&) const {}
    __device__ __forceinline__ void done(const Unit&) const {}
};
__device__ __forceinline__ unsigned cvt_pk_bf16(float lo, float hi) { unsigned r; asm volatile("v_cvt_pk_bf16_f32 %0, %1, %2" : "=v"(r) : "v"(lo), "v"(hi)); return r; }

struct EpiRawBf16 {
    static constexpr bool PERM = true, AFTER_DRAIN = false;
    bf16_t* O; int ldc;
    __device__ __forceinline__ void operator()(const f32x4 (&acc)[2][2][4][2], const Unit& u, int wr, int wc, int fr, int fq) const {
        const int row0 = u.pm * BM + wr * 64 + fr, col0 = u.pn * BM + wc * 32 + 8 * fq;
#pragma unroll
        for (int ai = 0; ai < 2; ++ai)
#pragma unroll
            for (int m = 0; m < 4; ++m) { bf16_t* rowp = O + (size_t)(row0 + ai * HALF + m * 16) * ldc + col0;
#pragma unroll
                for (int bj = 0; bj < 2; ++bj) { const f32x4 v0 = acc[ai][bj][m][0], v1 = acc[ai][bj][m][1];
                    u32x4 w; w.x = cvt_pk_bf16(v0[0], v0[1]); w.y = cvt_pk_bf16(v0[2], v0[3]); w.z = cvt_pk_bf16(v1[0], v1[1]); w.w = cvt_pk_bf16(v1[2], v1[3]);
                    *(u32x4*)(rowp + bj * HALF) = w; } }
    }
};
struct EpiResGate {
    static constexpr bool PERM = true, AFTER_DRAIN = false;
    const float* base; float* out; const float* gate;
    __device__ __forceinline__ void operator()(const f32x4 (&acc)[2][2][4][2], const Unit& u, int wr, int wc, int fr, int fq) const {
        const int row0 = u.pm * BM + wr * 64 + fr, col0 = u.pn * BM + wc * 32 + 8 * fq, b = (u.pm * BM) / SEQ;
        f32x4 g[2][2];
#pragma unroll
        for (int bj = 0; bj < 2; ++bj)
#pragma unroll
            for (int n = 0; n < 2; ++n) g[bj][n] = *(const f32x4*)(gate + (size_t)b * MODN + col0 + bj * HALF + 4 * n);
#pragma unroll
        for (int ai = 0; ai < 2; ++ai)
#pragma unroll
            for (int m = 0; m < 4; ++m) { const size_t off = (size_t)(row0 + ai * HALF + m * 16) * D + col0;
#pragma unroll
                for (int bj = 0; bj < 2; ++bj)
#pragma unroll
                    for (int n = 0; n < 2; ++n) { const f32x4 bs = *(const f32x4*)(base + off + bj * HALF + 4 * n);
                        *(f32x4*)(out + off + bj * HALF + 4 * n) = bs + g[bj][n] * acc[ai][bj][m][n]; } }
    }
};
struct EpiSwiglu {
    static constexpr bool PERM = true, AFTER_DRAIN = false;
    bf16_t* H;
    __device__ __forceinline__ void operator()(const f32x4 (&acc)[2][2][4][2], const Unit& u, int wr, int wc, int fr, int fq) const {
        const int row0 = u.pm * BM + wr * 64 + fr, col0 = u.pn * HALF + wc * 32 + 8 * fq;
#pragma unroll
        for (int ai = 0; ai < 2; ++ai)
#pragma unroll
            for (int m = 0; m < 4; ++m) { bf16_t* rowp = H + (size_t)(row0 + ai * HALF + m * 16) * FF + col0;
                float hv[8];
#pragma unroll
                for (int n = 0; n < 2; ++n)
#pragma unroll
                    for (int e = 0; e < 4; ++e) { const float gv = acc[ai][0][m][n][e], uv = acc[ai][1][m][n][e];
                        hv[n * 4 + e] = gv * __builtin_amdgcn_rcpf(1.f + __builtin_amdgcn_exp2f(-gv * LOG2E)) * uv; }
                u32x4 w; w.x = cvt_pk_bf16(hv[0], hv[1]); w.y = cvt_pk_bf16(hv[2], hv[3]); w.z = cvt_pk_bf16(hv[4], hv[5]); w.w = cvt_pk_bf16(hv[6], hv[7]);
                *(u32x4*)rowp = w; }
    }
};

template <class Epi, class Sched, bool ALIGN_EPI = false, bool SP2 = false>
__device__ __forceinline__ void gemm_phase(LAS unsigned char* lds, const Gemm g, const Sched& S, const Epi& E) {
    int tid_ = threadIdx.x; asm volatile("" : "+v"(tid_));
    const int tid = tid_, wid = __builtin_amdgcn_readfirstlane(tid >> 6), lane = tid & 63, wr = wid >> 2, wc = wid & 3, fr = lane & 15, fq = lane >> 4;
    const int K = g.K, nt = K / BK;
    unsigned voffA[2], voffB[2];
#pragma unroll
    for (int i = 0; i < 2; ++i) { int R, C; stage_rc(tid * 16 + i * 8192, R, C); const int Rb = Epi::PERM ? ((R & ~31) + perm32(R & 31)) : R;
        voffA[i] = (unsigned)(R * K + C) * 2u; voffB[i] = (unsigned)(Rb * K + C) * 2u; }
    const size_t kstep = (size_t)(BK * 2);
    const size_t hstep = (size_t)HALF * K * 2;
    const size_t tstep = 2 * hstep;
    const unsigned ldsw = (unsigned)wid * 1024u;
    const int aoff = lds_byte(wr * 64 + fr, fq * 8), boff = lds_byte(wc * 32 + fr, fq * 8);
#define PG8_SA(b, h) (((b) * 2 + (h)) * HTB)
#define PG8_SB(b, h) ((4 + (b) * 2 + (h)) * HTB)
#define PG8_STAGE(bufoff, gbase, voff) do { _Pragma("unroll") for (int _i = 0; _i < 2; ++_i) \
        __builtin_amdgcn_global_load_lds((const unsigned*)((const char*)(gbase) + (voff)[_i]), (LAS unsigned*)(lds + (bufoff) + ldsw + _i * 8192), 16, 0, 0); } while (0)
#define PG8_LDA(dst, b, h) do { _Pragma("unroll") for (int m = 0; m < 4; ++m) _Pragma("unroll") for (int k = 0; k < 2; ++k) dst[m][k] = *(const LAS bf16x8*)(lds + PG8_SA(b, h) + aoff + m * 2048 + k * 1024); } while (0)
#define PG8_LDB(dst, b, h) do { _Pragma("unroll") for (int n = 0; n < 2; ++n) _Pragma("unroll") for (int k = 0; k < 2; ++k) dst[n][k] = *(const LAS bf16x8*)(lds + PG8_SB(b, h) + boff + n * 2048 + k * 1024); } while (0)
#define PG8_MMA(ai, bj, At, Bt) do { __builtin_amdgcn_s_setprio(1); _Pragma("unroll") for (int m = 0; m < 4; ++m) _Pragma("unroll") for (int n = 0; n < 2; ++n) _Pragma("unroll") for (int k = 0; k < 2; ++k) \
        acc[ai][bj][m][n] = __builtin_amdgcn_mfma_f32_16x16x32_bf16(Bt[n][k], At[m][k], acc[ai][bj][m][n], 0, 0, 0); __builtin_amdgcn_s_setprio(0); } while (0)
#define PG8_WAIT_V(n) asm volatile("s_waitcnt vmcnt(" #n ")" ::: "memory")
#define PG8_WAIT_L(n) asm volatile("s_waitcnt lgkmcnt(" #n ")" ::: "memory")
#define PG8_BAR __builtin_amdgcn_s_barrier()
#define PG8_SCHED __builtin_amdgcn_sched_barrier(0)
    Unit cur, nxt; int ui = 0;
    if (!S.next(0, cur)) return;
    f32x4 acc[2][2][4][2];
#pragma unroll
    for (int a = 0; a < 2; ++a)
#pragma unroll
        for (int b = 0; b < 2; ++b)
#pragma unroll
            for (int m = 0; m < 4; ++m)
#pragma unroll
                for (int n = 0; n < 2; ++n) acc[a][b][m][n] = (f32x4){0.f, 0.f, 0.f, 0.f};
    bf16x8 At[4][2], B0[2][2], B1[2][2];
    const char* cA = (const char*)g.A + (size_t)cur.pm * tstep; const char* cB = (const char*)g.Bt + (size_t)cur.pn * tstep;
    S.a_ready(cur);
    if constexpr (SP2) {
        PG8_STAGE(PG8_SB(0, 0), cB, voffB); PG8_STAGE(PG8_SB(0, 1), cB + hstep, voffB); PG8_STAGE(PG8_SA(0, 0), cA, voffA); PG8_STAGE(PG8_SA(0, 1), cA + hstep, voffA);
        if (wr == 1) PG8_BAR;
        PG8_WAIT_V(2); PG8_BAR;
        PG8_STAGE(PG8_SB(1, 0), cB + kstep, voffB); PG8_STAGE(PG8_SA(1, 0), cA + kstep, voffA); PG8_STAGE(PG8_SB(1, 1), cB + hstep + kstep, voffB);
        PG8_WAIT_V(6); PG8_BAR;
    } else {
        PG8_STAGE(PG8_SB(0, 0), cB, voffB); PG8_STAGE(PG8_SA(0, 0), cA, voffA); PG8_STAGE(PG8_SB(0, 1), cB + hstep, voffB); PG8_STAGE(PG8_SA(0, 1), cA + hstep, voffA);
        if (wr == 1) PG8_BAR;
        PG8_WAIT_V(4); PG8_BAR;
        PG8_STAGE(PG8_SB(1, 0), cB + kstep, voffB); PG8_STAGE(PG8_SA(1, 0), cA + kstep, voffA); PG8_STAGE(PG8_SB(1, 1), cB + hstep + kstep, voffB);
        PG8_WAIT_V(6); PG8_BAR;
    }
    for (;;) {
        const bool has_next = S.next(ui + 1, nxt);
        const char* nA = has_next ? (const char*)g.A + (size_t)nxt.pm * tstep : cA; const char* nB = has_next ? (const char*)g.Bt + (size_t)nxt.pn * tstep : cB;
        for (int t = 0; t < nt; t += 2) {
            const bool last = (t == nt - 2);
            const char* a1 = cA + (size_t)(t + 1) * kstep;
            const char* a2 = last ? nA : cA + (size_t)(t + 2) * kstep; const char* b2 = last ? nB : cB + (size_t)(t + 2) * kstep;
            const char* a3 = a2 + kstep; const char* b3 = b2 + kstep;
            if (last && has_next) S.a_ready(nxt);
            if constexpr (SP2) {
            PG8_LDB(B0, 0, 0); PG8_LDB(B1, 0, 1); PG8_SCHED; PG8_LDA(At, 0, 0); PG8_STAGE(PG8_SA(1, 1), a1 + hstep, voffA);
            PG8_WAIT_V(8); PG8_WAIT_L(0); PG8_BAR; PG8_MMA(0, 0, At, B0); PG8_MMA(0, 1, At, B1); PG8_BAR; PG8_SCHED;
            PG8_LDA(At, 0, 1); PG8_STAGE(PG8_SB(0, 0), b2, voffB); PG8_STAGE(PG8_SB(0, 1), b2 + hstep, voffB); PG8_STAGE(PG8_SA(0, 0), a2, voffA);
            PG8_WAIT_V(8); PG8_WAIT_L(0); PG8_BAR; PG8_MMA(1, 0, At, B0); PG8_MMA(1, 1, At, B1); PG8_BAR; PG8_SCHED;
            PG8_LDB(B0, 1, 0); PG8_LDB(B1, 1, 1); PG8_SCHED; PG8_LDA(At, 1, 0); PG8_STAGE(PG8_SA(0, 1), a2 + hstep, voffA);
            PG8_WAIT_V(8); PG8_WAIT_L(0); PG8_BAR; PG8_MMA(0, 0, At, B0); PG8_MMA(0, 1, At, B1); PG8_BAR; PG8_SCHED;
            PG8_LDA(At, 1, 1); PG8_STAGE(PG8_SB(1, 0), b3, voffB); PG8_STAGE(PG8_SB(1, 1), b3 + hstep, voffB); PG8_STAGE(PG8_SA(1, 0), a3, voffA);
            PG8_WAIT_V(8); PG8_WAIT_L(0); PG8_BAR; PG8_MMA(1, 0, At, B0); PG8_MMA(1, 1, At, B1); PG8_BAR; PG8_SCHED;
            } else {
            PG8_LDB(B0, 0, 0); PG8_SCHED; PG8_LDA(At, 0, 0); PG8_STAGE(PG8_SA(1, 1), a1 + hstep, voffA);
            PG8_WAIT_L(8); PG8_BAR; PG8_WAIT_L(0); PG8_MMA(0, 0, At, B0); PG8_BAR; PG8_SCHED;
            PG8_LDB(B1, 0, 1); PG8_STAGE(PG8_SB(0, 0), b2, voffB);
            PG8_BAR; PG8_WAIT_L(0); PG8_MMA(0, 1, At, B1); PG8_BAR;
            PG8_LDA(At, 0, 1); PG8_STAGE(PG8_SA(0, 0), a2, voffA);
            PG8_BAR; PG8_WAIT_L(0); PG8_MMA(1, 0, At, B0); PG8_BAR; PG8_SCHED;
            PG8_STAGE(PG8_SB(0, 1), b2 + hstep, voffB);
            PG8_WAIT_V(6); PG8_BAR; PG8_MMA(1, 1, At, B1); PG8_BAR;
            PG8_LDB(B0, 1, 0); PG8_SCHED; PG8_LDA(At, 1, 0); PG8_STAGE(PG8_SA(0, 1), a2 + hstep, voffA);
            PG8_WAIT_L(8); PG8_BAR; PG8_WAIT_L(0); PG8_MMA(0, 0, At, B0); PG8_BAR; PG8_SCHED;
            PG8_LDB(B1, 1, 1); PG8_STAGE(PG8_SB(1, 0), b3, voffB);
            PG8_BAR; PG8_WAIT_L(0); PG8_MMA(0, 1, At, B1); PG8_BAR;
            PG8_LDA(At, 1, 1); PG8_STAGE(PG8_SA(1, 0), a3, voffA);
            PG8_BAR; PG8_WAIT_L(0); PG8_MMA(1, 0, At, B0); PG8_BAR; PG8_SCHED;
            PG8_STAGE(PG8_SB(1, 1), b3 + hstep, voffB);
            PG8_WAIT_V(6); PG8_BAR; PG8_MMA(1, 1, At, B1); PG8_BAR;
            }
        }
        if constexpr (ALIGN_EPI) { if (wr == 0) PG8_BAR; }
        if constexpr (!Epi::AFTER_DRAIN) { E(acc, cur, wr, wc, fr, fq); S.done(cur); }
        if (!has_next) break;
#pragma unroll
        for (int a = 0; a < 2; ++a)
#pragma unroll
            for (int b = 0; b < 2; ++b)
#pragma unroll
                for (int m = 0; m < 4; ++m)
#pragma unroll
                    for (int n = 0; n < 2; ++n) acc[a][b][m][n] = (f32x4){0.f, 0.f, 0.f, 0.f};
        cur = nxt; cA = nA; cB = nB; ++ui;
        if constexpr (ALIGN_EPI) { if (wr == 1) PG8_BAR; }
    }
    PG8_WAIT_V(0);
    if constexpr (!ALIGN_EPI) { if (wr == 0) PG8_BAR; }
    PG8_BAR;
#undef PG8_SA
#undef PG8_SB
#undef PG8_STAGE
#undef PG8_LDA
#undef PG8_LDB
#undef PG8_MMA
#undef PG8_WAIT_V
#undef PG8_WAIT_L
#undef PG8_BAR
#undef PG8_SCHED
}
}

__device__ __forceinline__ void qk_tile(f32x16& p0, f32x16& p1, lds_cptr Kt, const bf16x8 (&qr)[4], int r32, int hi) {
    lds_cptr kb = Kt + hi * 1024 + r32 * 16;
#pragma unroll
    for (int d0 = 0; d0 < 4; ++d0) {
        const bf16x8 b0 = *(const LAS bf16x8*)(kb + d0 * 2048);
        const bf16x8 b1 = *(const LAS bf16x8*)(kb + d0 * 2048 + 512);
        p0 = __builtin_amdgcn_mfma_f32_32x32x16_bf16(b0, qr[d0], p0, 0, 0, 0);
        p1 = __builtin_amdgcn_mfma_f32_32x32x16_bf16(b1, qr[d0], p1, 0, 0, 0);
    }
}
__device__ __forceinline__ float max32(const f32x16& p0, const f32x16& p1) {
    float a = fmaxf(p0[0], p1[0]), b = fmaxf(p0[1], p1[1]);
#pragma unroll
    for (int r = 2; r < 16; r += 2) { a = fmaxf(a, fmaxf(p0[r], p1[r])); b = fmaxf(b, fmaxf(p0[r + 1], p1[r + 1])); }
    return fmaxf(a, b);
}
template <int NDB>
__device__ __forceinline__ void softmax_pv(f32x16 (&o)[NDB], float& mref, float& lrun, f32x16& p0, f32x16& p1, lds_cptr Vt, LAS float* wsf, int r32, int hi, int lane) {
    float rm = xhalf_max(max32(p0, p1));
    if (__any(rm > 8.f)) {
        const float dl = fmaxf(rm, 0.f); mref += dl;
#pragma unroll
        for (int r = 0; r < 16; ++r) { p0[r] -= dl; p1[r] -= dl; }
        const float f = __builtin_amdgcn_exp2f(-dl); lrun *= f;
        if (hi == 0) wsf[r32] = f;
#pragma unroll
        for (int r = 0; r < 16; ++r) { const float fr_ = wsf[crow(r, hi)];
#pragma unroll
            for (int db = 0; db < NDB; ++db) o[db][r] *= fr_; }
    }
    float s = 0.f;
#pragma unroll
    for (int r = 0; r < 16; ++r) { p0[r] = __builtin_amdgcn_exp2f(p0[r]); p1[r] = __builtin_amdgcn_exp2f(p1[r]); s += p0[r] + p1[r]; }
    lrun += s;
    u32x4 pw[4];
#pragma unroll
    for (int k = 0; k < 4; ++k) {
        pw[0][k] = cvtpk(p0[2 * k], p0[2 * k + 1]); pw[1][k] = cvtpk(p0[8 + 2 * k], p0[8 + 2 * k + 1]);
        pw[2][k] = cvtpk(p1[2 * k], p1[2 * k + 1]); pw[3][k] = cvtpk(p1[8 + 2 * k], p1[8 + 2 * k + 1]);
    }
    lds_cptr vp = Vt + ((lane >> 4) & 1) * 32 + (lane & 3) * 8 + (4 * hi + ((lane & 15) >> 2)) * 64;
#pragma unroll
    for (int db = 0; db < NDB; ++db) {
#pragma unroll
        for (int ks = 0; ks < 4; ++ks) {
            const s16x4 lo = vtr(vp + db * 4096 + ks * 1024), hh = vtr(vp + db * 4096 + ks * 1024 + 512);
            const bf16x8 vf = (bf16x8){lo[0], lo[1], lo[2], lo[3], hh[0], hh[1], hh[2], hh[3]};
            o[db] = __builtin_amdgcn_mfma_f32_32x32x16_bf16(__builtin_bit_cast(bf16x8, pw[ks]), vf, o[db], 0, 0, 0);
        }
    }
}

constexpr int AT_STAGE = 32768, AT_XCHG = 65536, AT_WSF = 131072;
__device__ __forceinline__ void attnA_unit(const int b, const int h, const int qb, const int t0, const bf16_t* __restrict__ E, bf16_t* __restrict__ Y, const float lam, const float* __restrict__ subln, unsigned char* lds) {
    int tid_ = threadIdx.x; asm volatile("" : "+v"(tid_));
    const int tid = tid_, lane = tid & 63, r32 = lane & 31, hi = lane >> 5; const int wid = __builtin_amdgcn_readfirstlane(tid >> 6);
    const int mm = wid >> 2, rb = wid & 3;
    const int q0w = 128 * qb + 32 * rb, iq = q0w + r32, NT = 2 * (qb + 1);
    const bf16_t* Eb = E + (size_t)b * SEQ * EP;
    const unsigned lds0 = (unsigned)(uintptr_t)(LAS unsigned char*)lds;
    lds_cptr L = (lds_cptr)(LAS unsigned char*)lds;
    LAS float* wsf = (LAS float*)((LAS unsigned char*)lds + AT_WSF) + wid * 64;
    const bf16_t* src[4]; unsigned dsto[4];
#pragma unroll
    for (int i4 = 0; i4 < 4; ++i4) {
        if (wid < 4) { const int pidx = wid * 4 + i4, m_ = pidx >> 3, c = pidx & 7;
            src[i4] = Eb + (size_t)lane * EP + C_AK + h * 128 + m_ * 64 + c * 8; dsto[i4] = m_ * 8192 + c * 1024; }
        else { const int pidx = (wid - 4) * 4 + i4, db = pidx >> 2, rg = pidx & 3;
            src[i4] = Eb + (size_t)(16 * rg + (lane >> 2)) * EP + C_AV + h * 128 + db * 32 + (lane & 3) * 8; dsto[i4] = 16384 + db * 4096 + rg * 1024; }
    }
#define AT_DMA(t, stg) do { _Pragma("unroll") for (int i4 = 0; i4 < 4; ++i4) glds16(src[i4] + (size_t)(t) * 64 * EP, (unsigned)__builtin_amdgcn_readfirstlane(lds0 + (stg) * AT_STAGE + dsto[i4])); } while (0)
    AT_DMA(t0, 0);
    bf16x8 qr[4];
    { const bf16_t* Qw = Eb + (size_t)iq * EP + C_AQ + h * 128 + mm * 64;
#pragma unroll
      for (int d0 = 0; d0 < 4; ++d0) qr[d0] = *(const bf16x8*)(Qw + d0 * 16 + hi * 8); }
    const float slope2 = __builtin_amdgcn_exp2f(-2.f * (float)(h + 1)) * LOG2E;
    f32x16 o[4];
#pragma unroll
    for (int db = 0; db < 4; ++db) o[db] = f32x16{};
    float mref = 0.f, lrun = 0.f;
    for (int t = t0; t < NT; ++t) {
        WAITV_BAR();
        if (t + 1 < NT) AT_DMA(t + 1, (t + 1 - t0) & 1);
        if (64 * t <= q0w + 31) {
            lds_cptr st = L + ((t - t0) & 1) * AT_STAGE;
            const float tbm = slope2 * (float)(64 * t - iq) - mref;
            f32x16 p0, p1;
#pragma unroll
            for (int r = 0; r < 16; ++r) { p0[r] = tbm + slope2 * (float)crow(r, hi); p1[r] = p0[r] + 32.f * slope2; }
            qk_tile(p0, p1, st + mm * 8192, qr, r32, hi);
            if (64 * t + 63 > q0w) {
                const int kb = 64 * t + 4 * hi;
#pragma unroll
                for (int r = 0; r < 16; ++r) { const int kv = kb + (r & 3) + 8 * (r >> 2); if (kv > iq) p0[r] = -1e30f; if (kv + 32 > iq) p1[r] = -1e30f; }
            }
            softmax_pv<4>(o, mref, lrun, p0, p1, st + 16384, wsf, r32, hi, lane);
        }
    }
#undef AT_DMA
    lrun = xhalf_sum(lrun);
    if (hi == 0) wsf[r32] = lrun;
    float rli[16];
#pragma unroll
    for (int r = 0; r < 16; ++r) rli[r] = __builtin_amdgcn_rcpf(wsf[crow(r, hi)]);
    LAS float* xb = (LAS float*)((LAS unsigned char*)lds + AT_XCHG) + rb * 4096;
    if (mm == 1) {
#pragma unroll
        for (int db = 0; db < 4; ++db)
#pragma unroll
            for (int r = 0; r < 16; ++r) xb[(db * 16 + r) * 64 + lane] = o[db][r] * rli[r] * lam;
    }
    WAITL_BAR();
    if (mm == 0) {
        float ss[16];
#pragma unroll
        for (int r = 0; r < 16; ++r) ss[r] = 0.f;
#pragma unroll
        for (int db = 0; db < 4; ++db)
#pragma unroll
            for (int r = 0; r < 16; ++r) { const float dv = o[db][r] * rli[r] - xb[(db * 16 + r) * 64 + lane]; o[db][r] = dv; ss[r] += dv * dv; }
#pragma unroll
        for (int r = 0; r < 16; ++r) { float s = ss[r]; s += __shfl_xor(s, 1); s += __shfl_xor(s, 2); s += __shfl_xor(s, 4); s += __shfl_xor(s, 8); s += __shfl_xor(s, 16);
            ss[r] = __builtin_amdgcn_rsqf(s * (1.f / 128.f) + EPS) * 0.8f; }
        LAS bf16_t* stg = (LAS bf16_t*)((LAS unsigned char*)lds) + rb * 4096;
#pragma unroll
        for (int db = 0; db < 4; ++db) { const float gsub = subln[db * 32 + r32];
#pragma unroll
            for (int r = 0; r < 16; ++r) stg[crow(r, hi) * 128 + db * 32 + r32] = f2bf(o[db][r] * ss[r] * gsub); }
        bf16_t* Yw = Y + (size_t)(b * SEQ + q0w) * D + h * 128;
#pragma unroll
        for (int i8 = 0; i8 < 8; ++i8) { const int row = i8 * 4 + (lane >> 4), ch = lane & 15; const u32x4 v = *(const LAS u32x4*)(stg + row * 128 + ch * 8);
            *(u32x4*)(Yw + (size_t)row * D + ch * 8) = v; }
    }
    WAITL_BAR();
}

constexpr int SW_V = 32768, SW_OST = 65536;
__device__ __forceinline__ void swa_unit(const int b, const int kvh, const int nb, const bf16_t* __restrict__ E1, bf16_t* __restrict__ Y, const float* __restrict__ qn_c, const float* __restrict__ kn_c,
                                         const float* __restrict__ sinks, unsigned char* lds) {
    int tid_ = threadIdx.x; asm volatile("" : "+v"(tid_));
    const int tid = tid_, lane = tid & 63, r32 = lane & 31, hi = lane >> 5; const int wid = __builtin_amdgcn_readfirstlane(tid >> 6);
    const bf16_t* Eb = E1 + (size_t)b * SEQ * OP;
    LAS unsigned char* l3 = (LAS unsigned char*)lds;
    lds_cptr L = (lds_cptr)l3;
    LAS float* wsf = (LAS float*)(l3 + AT_WSF) + wid * 64;
    const int kt0 = (nb == 0) ? 2 : 0;
    {
        const int sub = lane & 7, rowi = tid >> 3;
        float kg[8];
#pragma unroll
        for (int i = 0; i < 8; ++i) kg[i] = kn_c[sub * 8 + i];
        for (int kt = kt0; kt < 4; ++kt) {
            const int key = 128 * (nb - 1) + 64 * kt + rowi;
            const u32x4 kr = *(const u32x4*)(Eb + (size_t)key * OP + C1_K + kvh * 64 + sub * 8);
            const u32x4 vr = *(const u32x4*)(Eb + (size_t)key * OP + C1_V + kvh * 64 + sub * 8);
            float v[8];
            v[0] = __uint_as_float(kr.x << 16); v[1] = __uint_as_float(kr.x & 0xffff0000u); v[2] = __uint_as_float(kr.y << 16); v[3] = __uint_as_float(kr.y & 0xffff0000u);
            v[4] = __uint_as_float(kr.z << 16); v[5] = __uint_as_float(kr.z & 0xffff0000u); v[6] = __uint_as_float(kr.w << 16); v[7] = __uint_as_float(kr.w & 0xffff0000u);
            float ss = 0.f;
#pragma unroll
            for (int i = 0; i < 8; ++i) ss += v[i] * v[i];
            ss += __shfl_xor(ss, 1); ss += __shfl_xor(ss, 2); ss += __shfl_xor(ss, 4);
            const float rr = __builtin_amdgcn_rsqf(ss * (1.f / 64.f) + EPS);
            u32x4 kw;
            kw.x = cvtpk(v[0] * rr * kg[0], v[1] * rr * kg[1]); kw.y = cvtpk(v[2] * rr * kg[2], v[3] * rr * kg[3]);
            kw.z = cvtpk(v[4] * rr * kg[4], v[5] * rr * kg[5]); kw.w = cvtpk(v[6] * rr * kg[6], v[7] * rr * kg[7]);
            *(LAS u32x4*)(l3 + kt * 8192 + sub * 1024 + rowi * 16) = kw;
            *(LAS u32x4*)(l3 + SW_V + kt * 8192 + (sub >> 2) * 4096 + (rowi >> 4) * 1024 + (rowi & 15) * 64 + (sub & 3) * 16) = vr;
        }
    }
    WAITL_BAR();
    const int g = wid >> 1, head = kvh * 4 + g;
    const float slope2 = __builtin_amdgcn_exp2f(-0.5f * (float)(head + 1)) * LOG2E;
    const float sink2 = sinks[head] * LOG2E;
    float qg[4][8];
#pragma unroll
    for (int d0 = 0; d0 < 4; ++d0)
#pragma unroll
        for (int i = 0; i < 8; ++i) qg[d0][i] = qn_c[d0 * 16 + hi * 8 + i] * QS;
    for (int rbi = 0; rbi < 2; ++rbi) {
        const int rb = 2 * (wid & 1) + rbi, rloc = 32 * rb + r32;
        const int tok = b * SEQ + 128 * nb + rloc;
        bf16x8 qr[4];
        { const bf16_t* Qw = E1 + (size_t)tok * OP + C1_Q + head * 64; u32x4 raw[4]; float ss = 0.f;
#pragma unroll
          for (int d0 = 0; d0 < 4; ++d0) { raw[d0] = *(const u32x4*)(Qw + d0 * 16 + hi * 8);
#pragma unroll
              for (int k = 0; k < 4; ++k) { const float a = __uint_as_float(raw[d0][k] << 16), c = __uint_as_float(raw[d0][k] & 0xffff0000u); ss += a * a + c * c; } }
          ss = xhalf_sum(ss);
          const float rr = __builtin_amdgcn_rsqf(ss * (1.f / 64.f) + EPS);
#pragma unroll
          for (int d0 = 0; d0 < 4; ++d0) { u32x4 w;
#pragma unroll
              for (int k = 0; k < 4; ++k) { const float a = __uint_as_float(raw[d0][k] << 16), c = __uint_as_float(raw[d0][k] & 0xffff0000u);
                  w[k] = cvtpk(a * rr * qg[d0][2 * k], c * rr * qg[d0][2 * k + 1]); }
              qr[d0] = __builtin_bit_cast(bf16x8, w); } }
        f32x16 o[2]; o[0] = f32x16{}; o[1] = f32x16{};
        float mref = 0.f, lrun = 0.f;
        const int ktlo = (rb < 2) ? 0 : 1, kthi = (rb < 2) ? 2 : 3;
        for (int kt = ktlo; kt <= kthi; ++kt) {
            if (kt < kt0) continue;
            const float tbm = slope2 * (float)(64 * kt - 128 - rloc) - mref;
            f32x16 p0, p1;
#pragma unroll
            for (int r = 0; r < 16; ++r) { p0[r] = tbm + slope2 * (float)crow(r, hi); p1[r] = p0[r] + 32.f * slope2; }
            qk_tile(p0, p1, L + kt * 8192, qr, r32, hi);
            const int jb = 64 * kt + 4 * hi;
#pragma unroll
            for (int r = 0; r < 16; ++r) { const int jj = jb + (r & 3) + 8 * (r >> 2);
                if (jj < rloc + 1 || jj > rloc + 128) p0[r] = -1e30f;
                if (jj + 32 < rloc + 1 || jj + 32 > rloc + 128) p1[r] = -1e30f; }
            softmax_pv<2>(o, mref, lrun, p0, p1, L + SW_V + kt * 8192, wsf, r32, hi, lane);
        }
        lrun = xhalf_sum(lrun) + __builtin_amdgcn_exp2f(sink2 - mref);
        if (hi == 0) wsf[r32] = lrun;
        LAS bf16_t* stg = (LAS bf16_t*)(l3 + SW_OST) + wid * 2048;
#pragma unroll
        for (int r = 0; r < 16; ++r) { const float rl = __builtin_amdgcn_rcpf(wsf[crow(r, hi)]);
#pragma unroll
            for (int db = 0; db < 2; ++db) stg[crow(r, hi) * 64 + db * 32 + r32] = f2bf(o[db][r] * rl); }
        bf16_t* Yw = Y + (size_t)(b * SEQ + 128 * nb + 32 * rb) * D + head * 64;
#pragma unroll
        for (int i4 = 0; i4 < 4; ++i4) { const int row = i4 * 8 + (lane >> 3), ch = lane & 7; const u32x4 v = *(const LAS u32x4*)(stg + row * 64 + ch * 8);
            *(u32x4*)(Yw + (size_t)row * D + ch * 8) = v; }
    }
    WAITL_BAR();
}

constexpr int DS_KSTR = 4100, DS_QROW = DS_KSTR * 4;
constexpr int DS_HIST = 131584, DS_LIST = 139776;
#define MFMA16(a, b, c) __builtin_amdgcn_mfma_f32_16x16x32_bf16((a), (b), (c), 0, 0, 0)
#ifndef DSA_REP1
#define DSA_REP1 1
#endif
#ifndef DSA_REP2
#define DSA_REP2 1
#endif
#ifndef DSA_REP3
#define DSA_REP3 1
#endif
__device__ __forceinline__ int pick_digit(const u32x4 hv, int& remaining, int lane) {
    const int s = (int)(hv[0] + hv[1] + hv[2] + hv[3]);
    int suf = s;
#pragma unroll
    for (int off = 1; off < 64; off <<= 1) { const int tv = __shfl_down(suf, off); if (lane + off < 64) suf += tv; }
    int cum = suf - s, found = -1, remn = 0;
#pragma unroll
    for (int d = 3; d >= 0; --d) { const int c = (int)hv[d]; if (found < 0 && cum < remaining && cum + c >= remaining) { found = 4 * lane + d; remn = remaining - cum; } cum += c; }
    const unsigned long long bal = __ballot(found >= 0);
    const int srcl = (int)__ffsll((long long)bal) - 1;
    remaining = __shfl(remn, srcl);
    return __shfl(found, srcl);
}
__device__ __forceinline__ void dsa_unit(const int b, const int i0, const bf16_t* __restrict__ E, const bf16_t* __restrict__ KC3, const unsigned* __restrict__ SGN, bf16_t* __restrict__ Y, unsigned char* lds) {
    int tid_ = threadIdx.x; asm volatile("" : "+v"(tid_));
    const int tid = tid_, lane = tid & 63, kq = lane >> 4, c16 = lane & 15; const int wid = __builtin_amdgcn_readfirstlane(tid >> 6);
    LAS unsigned char* l3 = (LAS unsigned char*)lds;
    LAS unsigned* keys = (LAS unsigned*)l3;
    const bf16_t* Eb = E + (size_t)b * SEQ * EP;
    const int nt16 = (i0 + 8 + 15) >> 4, n16 = nt16 * 16;
    const int nblk = (n16 + 511) >> 9;
    for (int rep1 = 0; rep1 < DSA_REP1; ++rep1)
    {
        for (int x4 = (n16 >> 2) + tid; x4 < 128 * nblk; x4 += 512) {
#pragma unroll
            for (int qq = 0; qq < 8; ++qq) *(LAS u32x4*)(keys + qq * DS_KSTR + 4 * x4) = (u32x4){0u, 0u, 0u, 0u};
        }
        const int q = c16 & 7, hg = c16 >> 3; const size_t tokq = (size_t)b * SEQ + i0 + q;
        bf16x8 Bq[4][2];
#pragma unroll
        for (int hh = 0; hh < 4; ++hh)
#pragma unroll
            for (int ks = 0; ks < 2; ++ks) Bq[hh][ks] = *(const bf16x8*)(E + tokq * EP + C_IQ + (4 * hg + hh) * 64 + ks * 32 + kq * 8);
        const unsigned sg = SGN[tokq] >> (4 * hg);
        float sm[4];
#pragma unroll
        for (int hh = 0; hh < 4; ++hh) sm[hh] = ((sg >> hh) & 1u) ? -1.f : 1.f;
        const char* kbase = (const char*)(KC3 + ((size_t)b * SEQ + c16) * 64 + kq * 8);
        bf16x8 a0[4], a1[4], n0[4], n1[4];
#pragma unroll
        for (int j = 0; j < 4; ++j) { int t = wid + 8 * j; t = t < nt16 ? t : nt16 - 1; const char* kr = kbase + (unsigned)(t * (16 * 64 * 2)); n0[j] = *(const bf16x8*)kr; n1[j] = *(const bf16x8*)(kr + 64); }
        for (int tg = wid; tg < nt16; tg += 32) {
#pragma unroll
            for (int j = 0; j < 4; ++j) { a0[j] = n0[j]; a1[j] = n1[j]; }
            if (tg + 32 < nt16) {
#pragma unroll
                for (int j = 0; j < 4; ++j) { int t = tg + 32 + 8 * j; t = t < nt16 ? t : nt16 - 1; const char* kr = kbase + (unsigned)(t * (16 * 64 * 2)); n0[j] = *(const bf16x8*)kr; n1[j] = *(const bf16x8*)(kr + 64); }
            }
#pragma unroll
            for (int j = 0; j < 4; ++j) {
                const int t = tg + 8 * j;
                f32x4 sc = (f32x4){0.f, 0.f, 0.f, 0.f};
#pragma unroll
                for (int hh = 0; hh < 4; ++hh) { f32x4 acc = MFMA16(a0[j], Bq[hh][0], ((f32x4){0.f, 0.f, 0.f, 0.f})); acc = MFMA16(a1[j], Bq[hh][1], acc);
#pragma unroll
                    for (int r = 0; r < 4; ++r) { const float rl = __builtin_amdgcn_fmed3f(acc[r], 0.f, __builtin_inff()); sc[r] = __builtin_fmaf(sm[hh], rl, sc[r]); } }
                u32x4 kv;
#pragma unroll
                for (int r = 0; r < 4; ++r) { const float oth = __shfl_xor(sc[r], 8);
                    float s = sc[r] + oth; s += 0.0f;
                    const unsigned u = __float_as_uint(s); kv[r] = u ^ ((unsigned)((int)u >> 31) | 0x80000000u); }
                if (16 * t + 15 > i0) {
#pragma unroll
                    for (int r = 0; r < 4; ++r) kv[r] = (16 * t + 4 * kq + r <= i0 + q) ? kv[r] : 0u;
                }
                if (hg == 0 && t < nt16) *(LAS u32x4*)(keys + q * DS_KSTR + 16 * t + 4 * kq) = kv;
            }
        }
    }
    WAITL_BAR();
    const int qi = i0 + wid, nq = qi + 1;
    LAS unsigned short* list = (LAS unsigned short*)(l3 + DS_LIST) + wid * 320;
    int cnt = 0;
    {
        LAS unsigned* myk = keys + wid * DS_KSTR;
        unsigned kreg[64];
#pragma unroll
        for (int blk = 0; blk < 8; ++blk) {
            if (blk < nblk) {
#pragma unroll
                for (int i = 8 * blk; i < 8 * blk + 8; ++i) kreg[i] = myk[64 * i + lane];
            } else {
#pragma unroll
                for (int i = 8 * blk; i < 8 * blk + 8; ++i) kreg[i] = 0u;
            }
        }
        unsigned T = 0u; int need = 0;
        if (nq > 256) {
            asm volatile("s_waitcnt lgkmcnt(0)" ::: "memory");
            constexpr int TB = 10, SH = 32 - TB;
            unsigned d0 = 0u; int cabove = 0;
#pragma unroll 1
            for (int bit = TB - 1; bit >= 0; --bit) {
                const unsigned cand = d0 | (1u << bit), lim = cand << SH; int c = 0;
#pragma unroll
                for (int blk = 0; blk < 8; ++blk) {
                    if (blk < nblk) {
                        unsigned long long bm[8];
#pragma unroll
                        for (int j = 0; j < 8; ++j) bm[j] = __ballot(kreg[8 * blk + j] >= lim);
#pragma unroll
                        for (int j = 0; j < 8; ++j) c += __popcll(bm[j]);
                    }
                }
                if (c >= 256) d0 = cand; else cabove = c;
            }
            int remaining = 256 - cabove;
            int ncand = 0;
#pragma unroll
            for (int blk = 0; blk < 8; ++blk) {
                if (blk < nblk) {
                    unsigned long long bm[8]; int off[8];
#pragma unroll
                    for (int j = 0; j < 8; ++j) bm[j] = __ballot((kreg[8 * blk + j] >> SH) == d0);
                    __builtin_amdgcn_sched_barrier(0);
#pragma unroll
                    for (int j = 0; j < 8; ++j) { off[j] = ncand; ncand += __popcll(bm[j]); }
                    __builtin_amdgcn_sched_barrier(0);
#pragma unroll
                    for (int j = 0; j < 8; ++j) { const unsigned k = kreg[8 * blk + j];
                        const int pos = (int)__builtin_amdgcn_mbcnt_hi((unsigned)(bm[j] >> 32), __builtin_amdgcn_mbcnt_lo((unsigned)bm[j], (unsigned)off[j]));
                        myk[((k >> SH) == d0) ? pos : 4099] = k; }
                    __builtin_amdgcn_sched_barrier(0);
                }
            }
            LAS unsigned* hist = (LAS unsigned*)(l3 + DS_HIST) + wid * 256;
            unsigned prefix = d0 << SH, msk = ~0u << SH;
#pragma unroll 1
            for (int pass = 0; pass < 3; ++pass) {
                const int shift = (pass == 0) ? 14 : (pass == 1) ? 6 : 0; const unsigned dm = (pass == 2) ? 63u : 255u;
                *(LAS u32x4*)(hist + 4 * lane) = (u32x4){0u, 0u, 0u, 0u};
                asm volatile("s_waitcnt lgkmcnt(0)" ::: "memory");
                for (int j = lane; j < ncand; j += 64) { const unsigned k = myk[j];
                    if ((k & msk) == prefix) __hip_atomic_fetch_add(hist + ((k >> shift) & dm), 1u, __ATOMIC_RELAXED, __HIP_MEMORY_SCOPE_WAVEFRONT); }
                asm volatile("s_waitcnt lgkmcnt(0)" ::: "memory");
                const u32x4 hv2 = *(const LAS u32x4*)(hist + 4 * lane);
                const int digit = pick_digit(hv2, remaining, lane);
                prefix |= (unsigned)digit << shift; msk |= dm << shift;
            }
            T = prefix; need = remaining;
        }
        int basep = 0;
#pragma unroll
        for (int blk = 0; blk < 8; ++blk) {
            if (blk < nblk) {
                unsigned long long bs[8]; int off[8];
#pragma unroll
                for (int j = 0; j < 8; ++j) bs[j] = __ballot(kreg[8 * blk + j] > T);
                __builtin_amdgcn_sched_barrier(0);
#pragma unroll
                for (int j = 0; j < 8; ++j) { off[j] = basep; basep += __popcll(bs[j]); }
                __builtin_amdgcn_sched_barrier(0);
#pragma unroll
                for (int j = 0; j < 8; ++j) {
                    const int pos = (int)__builtin_amdgcn_mbcnt_hi((unsigned)(bs[j] >> 32), __builtin_amdgcn_mbcnt_lo((unsigned)bs[j], (unsigned)off[j]));
                    list[(kreg[8 * blk + j] > T) ? pos : 319] = (unsigned short)(64 * (8 * blk + j) + lane); }
                __builtin_amdgcn_sched_barrier(0);
            }
        }
        if (nq > 256) {
#pragma unroll
            for (int blk = 0; blk < 8; ++blk) {
                if (blk < nblk) {
                    unsigned long long any = 0ull;
#pragma unroll
                    for (int i = 8 * blk; i < 8 * blk + 8; ++i) any |= __ballot(kreg[i] == T);
                    if (any != 0ull) {
#pragma unroll
                        for (int i = 8 * blk; i < 8 * blk + 8; ++i) {
                            const bool eq = kreg[i] == T;
                            const unsigned long long be = __ballot(eq);
                            const int rank = (int)__builtin_amdgcn_mbcnt_hi((unsigned)(be >> 32), __builtin_amdgcn_mbcnt_lo((unsigned)be, 0u));
                            const bool sel = eq && rank < need;
                            list[sel ? basep + rank : 319] = (unsigned short)(64 * i + lane);
                            int c = __popcll(be); c = c < need ? c : need;
                            basep += c; need -= c;
                        }
                    }
                }
            }
        }
        cnt = basep < 256 ? basep : 256;
        for (int s2 = cnt + lane; s2 < 256; s2 += 64) list[s2] = (unsigned short)0;
    }
    asm volatile("s_waitcnt lgkmcnt(0)" ::: "memory");
    for (int rep3 = 0; rep3 < DSA_REP3; ++rep3)
    {
        const size_t tok = (size_t)b * SEQ + qi; const int hd = c16 & 7;
        bf16x8 Bb[2];
#pragma unroll
        for (int ks = 0; ks < 2; ++ks) Bb[ks] = *(const bf16x8*)(E + tok * EP + C_BQ + hd * 64 + ks * 32 + kq * 8);
        const float slope2 = __builtin_amdgcn_exp2f(-(float)(hd + 1)) * LOG2E;
        LAS unsigned char* vst = l3 + wid * DS_QROW;
        const char* Ebk = (const char*)(KC3 + (size_t)M * 64 + (size_t)b * SEQ * 64) + kq * 16;
        const char* Ebv = (const char*)(KC3 + (size_t)2 * M * 64 + (size_t)b * SEQ * 64) + (lane & 7) * 16;
        u32x4 vreg[8];
#define DS_VLOAD(c4_) do { _Pragma("unroll") for (int it = 0; it < 8; ++it) { const unsigned j_ = list[64 * (c4_) + 8 * it + (lane >> 3)]; \
            vreg[it] = *(const u32x4*)(Ebv + j_ * 128u); } } while (0)
        DS_VLOAD(0);
        f32x4 lg[4][4];
#pragma unroll
        for (int hf = 0; hf < 2; ++hf) {
            bf16x8 ka0[8], ka1[8];
#pragma unroll
            for (int e = 0; e < 8; ++e) { const unsigned j = list[128 * hf + 16 * e + c16];
                const char* kr = Ebk + j * 128u; ka0[e] = *(const bf16x8*)kr; ka1[e] = *(const bf16x8*)(kr + 64); }
#pragma unroll
            for (int e = 0; e < 8; ++e) { const int c4 = 2 * hf + (e >> 2), tt = e & 3;
                f32x4 acc = MFMA16(ka0[e], Bb[0], ((f32x4){0.f, 0.f, 0.f, 0.f})); acc = MFMA16(ka1[e], Bb[1], acc);
                const int s0 = 64 * c4 + 16 * tt + 4 * kq;
                const u32x2 jl = *(const LAS u32x2*)(list + s0);
                const int j0 = jl[0] & 0xffff, j1 = jl[0] >> 16, j2 = jl[1] & 0xffff, j3 = jl[1] >> 16;
                lg[c4][tt][0] = (s0 + 0 < cnt) ? acc[0] + slope2 * (float)(j0 - qi) : -1e30f;
                lg[c4][tt][1] = (s0 + 1 < cnt) ? acc[1] + slope2 * (float)(j1 - qi) : -1e30f;
                lg[c4][tt][2] = (s0 + 2 < cnt) ? acc[2] + slope2 * (float)(j2 - qi) : -1e30f;
                lg[c4][tt][3] = (s0 + 3 < cnt) ? acc[3] + slope2 * (float)(j3 - qi) : -1e30f; }
        }
        float mx = -1e30f;
#pragma unroll
        for (int c4 = 0; c4 < 4; ++c4)
#pragma unroll
            for (int tt = 0; tt < 4; ++tt)
#pragma unroll
                for (int r = 0; r < 4; ++r) mx = fmaxf(mx, lg[c4][tt][r]);
        mx = fmaxf(mx, __shfl_xor(mx, 16)); mx = fmaxf(mx, __shfl_xor(mx, 32));
        float sum = 0.f;
#pragma unroll
        for (int c4 = 0; c4 < 4; ++c4)
#pragma unroll
            for (int tt = 0; tt < 4; ++tt)
#pragma unroll
                for (int r = 0; r < 4; ++r) { const float e = __builtin_amdgcn_exp2f(lg[c4][tt][r] - mx); lg[c4][tt][r] = e; sum += e; }
        sum += __shfl_xor(sum, 16); sum += __shfl_xor(sum, 32);
        const float inv = __builtin_amdgcn_rcpf(sum);
        f32x4 oacc[4];
#pragma unroll
        for (int dt = 0; dt < 4; ++dt) oacc[dt] = (f32x4){0.f, 0.f, 0.f, 0.f};
        const int qp = c16 >> 2, pp4 = c16 & 3;
#pragma unroll
        for (int c4 = 0; c4 < 4; ++c4) {
#pragma unroll
            for (int it = 0; it < 8; ++it) { const int row = 8 * it + (lane >> 3), ch = lane & 7; *(LAS u32x4*)(vst + row * 128 + ((ch ^ (row & 7)) * 16)) = vreg[it]; }
            if (c4 < 3) DS_VLOAD(c4 + 1);
            asm volatile("" ::: "memory");
#pragma unroll
            for (int pp = 0; pp < 2; ++pp) {
                const f32x4 l0 = lg[c4][2 * pp] * inv, l1 = lg[c4][2 * pp + 1] * inv;
                u32x4 pw; pw[0] = cvtpk(l0[0], l0[1]); pw[1] = cvtpk(l0[2], l0[3]); pw[2] = cvtpk(l1[0], l1[1]); pw[3] = cvtpk(l1[2], l1[3]);
                const int rlo = 32 * pp + 4 * kq + qp, rhi = rlo + 16;
#pragma unroll
                for (int dt = 0; dt < 4; ++dt) { const int chunk = 2 * dt + (pp4 >> 1);
                    const s16x4 lo = vtr((lds_cptr)(vst + rlo * 128 + ((chunk ^ (rlo & 7)) * 16) + (pp4 & 1) * 8));
                    const s16x4 hh = vtr((lds_cptr)(vst + rhi * 128 + ((chunk ^ (rhi & 7)) * 16) + (pp4 & 1) * 8));
                    const bf16x8 vf = (bf16x8){lo[0], lo[1], lo[2], lo[3], hh[0], hh[1], hh[2], hh[3]};
                    oacc[dt] = MFMA16(vf, __builtin_bit_cast(bf16x8, pw), oacc[dt]); }
            }
            asm volatile("" ::: "memory");
        }
#undef DS_VLOAD
        if (c16 < 8) {
            bf16_t* yo = Y + tok * D + 512 + hd * 64 + 4 * kq;
#pragma unroll
            for (int dt = 0; dt < 4; ++dt) { u32x2 w; w[0] = cvtpk(oacc[dt][0], oacc[dt][1]); w[1] = cvtpk(oacc[dt][2], oacc[dt][3]); *(u32x2*)(yo + 16 * dt) = w; }
        }
    }
    WAITL_BAR();
}

#define XB_TMO      128
#define XB_XCNT(j)  (256  + 64 * (j))
#define XB_XSUB(j)  (1280 + 64 * (j))
#define XB_XGEN(j)  (2304 + 64 * (j))
#define XB_TOP      3328
#define XB_TOPGEN   3392
#define XCD_BAR_WORDS 3456
#define XB_SPIN_CAP (1u << 18)
__device__ __forceinline__ unsigned xb_ld(unsigned* p)              { return __hip_atomic_load(p, __ATOMIC_RELAXED, __HIP_MEMORY_SCOPE_AGENT); }
__device__ __forceinline__ unsigned xb_add(unsigned* p, unsigned v) { return __hip_atomic_fetch_add(p, v, __ATOMIC_RELAXED, __HIP_MEMORY_SCOPE_AGENT); }
__device__ __forceinline__ unsigned xb_xcc_id() { return (unsigned)__builtin_amdgcn_s_getreg((3 << 11) | 20) & 0xFu; }
#define XB_SPIN(cond, bar) do { unsigned _sp = 0; while (cond) { __builtin_amdgcn_s_sleep(1); \
    if ((++_sp & 255u) == 0u) { if (xb_ld(&(bar)[XB_TMO])) break; if (_sp > XB_SPIN_CAP) { atomicAdd(&(bar)[XB_TMO], 1u); break; } } } } while (0)
struct XcdBarrier { unsigned* bar; unsigned x; volatile LAS unsigned* st; };
__device__ __forceinline__ XcdBarrier xcd_barrier_post(unsigned* bar, volatile LAS unsigned* st) {
    XcdBarrier b; b.bar = bar; b.x = xb_xcc_id(); b.st = st;
    if (threadIdx.x == 0) (void)xb_add(&bar[XB_XCNT(b.x)], 1u);
    return b;
}
__device__ __forceinline__ void xcd_barrier_complete(unsigned* bar, unsigned x, unsigned& nloc, unsigned& nx) {
    const unsigned G = gridDim.x * gridDim.y * gridDim.z;
    unsigned sum, cnt, mine, sp = 0u;
    for (;;) {
        sum = 0u; cnt = 0u; mine = 0u;
#pragma unroll
        for (unsigned j = 0; j < 16; ++j) { const unsigned c = xb_ld(&bar[XB_XCNT(j)]); sum += c; cnt += (c > 0u) ? 1u : 0u; mine = (j == x) ? c : mine; }
        if (sum == G) break;
        __builtin_amdgcn_s_sleep(1);
        if ((++sp & 255u) == 0u) { if (xb_ld(&bar[XB_TMO])) break; if (sp > XB_SPIN_CAP) { atomicAdd(&bar[XB_TMO], 1u); break; } }
    }
    nloc = mine > 0u ? mine : 1u; nx = cnt > 0u ? cnt : 1u;
}
__device__ __forceinline__ void xcd_barrier(const XcdBarrier& b) {
    asm volatile("s_waitcnt vmcnt(0)" ::: "memory");
    __syncthreads();
    if (threadIdx.x == 0) {
        unsigned* bar = b.bar;
        __builtin_amdgcn_s_waitcnt(0);
        unsigned nloc = b.st[0], nx = b.st[1];
        if (nloc == 0u) { xcd_barrier_complete(bar, b.x, nloc, nx); b.st[0] = nloc; b.st[1] = nx; }
        const unsigned old = xb_add(&bar[XB_XSUB(b.x)], 1u);
        const unsigned gen = old / nloc;
        if (old + 1u == (gen + 1u) * nloc) {
            __builtin_amdgcn_fence(__ATOMIC_RELEASE, "agent");
            asm volatile("s_waitcnt vmcnt(0)" ::: "memory");
            const unsigned og = xb_add(&bar[XB_TOP], 1u);
            const unsigned tg = og / nx;
            if (og + 1u == (tg + 1u) * nx) xb_add(&bar[XB_TOPGEN], 1u);
            else XB_SPIN(xb_ld(&bar[XB_TOPGEN]) == tg, bar);
            __builtin_amdgcn_fence(__ATOMIC_ACQUIRE, "agent");
            xb_add(&bar[XB_XGEN(b.x)], 1u);
            asm volatile("s_waitcnt vmcnt(0)" ::: "memory");
        } else {
            XB_SPIN(xb_ld(&bar[XB_XGEN(b.x)]) == gen, bar);
            __builtin_amdgcn_fence(__ATOMIC_ACQUIRE, "agent");
            asm volatile("s_waitcnt vmcnt(0)" ::: "memory");
        }
    }
    __syncthreads();
}

struct Params {
    const float* in[24]; float* out; unsigned char* ws; int ph_lo, ph_hi;
};
constexpr int LDS_BYTES = 163840, MISC_OFF = LDS_BYTES - 512;

__device__ __forceinline__ void tr_item(const float* __restrict__ W, int ldsrc, int ncol0, int nvalid, int K, int k0, bf16_t* __restrict__ WT, LAS float* scr, int lane) {
    const int c = lane & 31;
#pragma unroll 8
    for (int i = 0; i < 32; ++i) { const int kk = 2 * i + (lane >> 5); scr[kk * 33 + c] = (c < nvalid) ? W[(size_t)(k0 + kk) * ldsrc + ncol0 + c] : 0.f; }
    asm volatile("s_waitcnt lgkmcnt(0)" ::: "memory");
    const int c8 = lane & 7;
#pragma unroll
    for (int j = 0; j < 4; ++j) { const int n = (lane >> 3) + 8 * j; const LAS float* s = scr + (8 * c8) * 33 + n;
        u32x4 o; o.x = pk2(s[0 * 33], s[1 * 33]); o.y = pk2(s[2 * 33], s[3 * 33]); o.z = pk2(s[4 * 33], s[5 * 33]); o.w = pk2(s[6 * 33], s[7 * 33]);
        *(u32x4*)(WT + (size_t)n * K + k0 + 8 * c8) = o; }
    asm volatile("s_waitcnt lgkmcnt(0)" ::: "memory");
}

__device__ __forceinline__ void phase_prologue(const Params& p, unsigned char* lds, int G) {
    int tid_ = threadIdx.x; asm volatile("" : "+v"(tid_));
    const int tid = tid_, lane = tid & 63; const int wid = __builtin_amdgcn_readfirstlane(tid >> 6);
    LAS unsigned char* l3 = (LAS unsigned char*)lds;
    {
        LAS float* sc = (LAS float*)l3; LAS float* part = (LAS float*)(l3 + 16384);
        const float* c = p.in[1]; const float* ada_w = p.in[2]; const float* ada_b = p.in[3]; float* mod = (float*)(p.ws + WS_MOD);
        if ((int)blockIdx.x < 192) {
            for (int i = tid; i < 4096; i += 512) { const float v = c[i]; sc[i] = v / (1.f + expf(-v)); }
            __syncthreads();
            for (int item = blockIdx.x; item < 192; item += G) {
                const int l = item / 96, n0 = (item % 96) * 64;
                const float* W = ada_w + (size_t)l * 1024 * MODN + n0 + lane;
                float a0 = 0.f, a1 = 0.f, a2 = 0.f, a3 = 0.f;
#pragma unroll 8
                for (int k = wid * 128; k < wid * 128 + 128; ++k) { const float wv = W[(size_t)k * MODN]; a0 += sc[k] * wv; a1 += sc[1024 + k] * wv; a2 += sc[2048 + k] * wv; a3 += sc[3072 + k] * wv; }
                part[(wid * 4 + 0) * 64 + lane] = a0; part[(wid * 4 + 1) * 64 + lane] = a1; part[(wid * 4 + 2) * 64 + lane] = a2; part[(wid * 4 + 3) * 64 + lane] = a3;
                __syncthreads();
                if (tid < 256) { const int b = tid >> 6, col = tid & 63; float s = 0.f;
#pragma unroll
                    for (int ww = 0; ww < 8; ++ww) s += part[(ww * 4 + b) * 64 + col];
                    mod[(size_t)(l * 4 + b) * MODN + n0 + col] = s + ada_b[l * MODN + n0 + col]; }
                __syncthreads();
            }
        }
        __syncthreads();
    }
    LAS float* scr = (LAS float*)(l3 + wid * 16384);
    const int gw = blockIdx.x * 8 + wid, NGW = G * 8;
    constexpr int I0 = 88 * 16, I1 = 2 * 32 * 16, I2 = 2 * 176 * 16, I3 = 2 * 32 * 44, I4 = 48 * 16, NIT = I0 + I1 + I2 + I3 + I4;
    for (int it = gw; it < NIT; it += NGW) {
        int r = it;
        if (r < I0) { const int g = r / 16, kb = r % 16; int nv = ECOLS - 32 * g; nv = nv < 0 ? 0 : (nv > 32 ? 32 : nv);
            tr_item(p.in[10], ECOLS, 32 * g, nv, D, 64 * kb, (bf16_t*)(p.ws + WS_WIN0) + (size_t)(32 * g) * D, scr, lane); continue; }
        r -= I0;
        if (r < I1) { const int l = r / 512, g = (r % 512) / 16, kb = r % 16;
            tr_item(p.in[6] + (size_t)l * D * D, D, 32 * g, 32, D, 64 * kb, (bf16_t*)(p.ws + WS_WOUT) + (size_t)l * D * D + (size_t)(32 * g) * D, scr, lane); continue; }
        r -= I1;
        if (r < I2) { const int l = r / (176 * 16), g = (r % (176 * 16)) / 16, kb = r % 16; const int tile = g >> 3, cg = g & 7;
            const float* src = (cg < 4 ? p.in[7] : p.in[8]) + (size_t)l * D * FF;
            tr_item(src, FF, tile * 128 + (cg & 3) * 32, 32, D, 64 * kb, (bf16_t*)(p.ws + WS_WGU) + (size_t)l * GU * D + (size_t)(32 * g) * D, scr, lane); continue; }
        r -= I2;
        if (r < I3) { const int l = r / (32 * 44), g = (r % (32 * 44)) / 44, kb = r % 44;
            tr_item(p.in[9] + (size_t)l * FF * D, D, 32 * g, 32, FF, 64 * kb, (bf16_t*)(p.ws + WS_WDN) + (size_t)l * D * FF + (size_t)(32 * g) * FF, scr, lane); continue; }
        r -= I3;
        { const int g = r / 16, kb = r % 16;
            tr_item(p.in[20], OP, 32 * g, 32, D, 64 * kb, (bf16_t*)(p.ws + WS_WIN1) + (size_t)(32 * g) * D, scr, lane); }
    }
}

__device__ __forceinline__ void phase_norm(const float* __restrict__ x, const float* __restrict__ gain, const float* __restrict__ modl, int sh_off, int sc_off, bf16_t* __restrict__ XN, int G) {
    int tid_ = threadIdx.x; asm volatile("" : "+v"(tid_));
    const int lane = tid_ & 63; const int gw = blockIdx.x * 8 + (tid_ >> 6), NGW = G * 8;
    for (int row = gw; row < M; row += NGW) {
        const int b = row / SEQ;
        const f32x4* xr = (const f32x4*)(x + (size_t)row * D);
        f32x4 v[4]; float s = 0.f;
#pragma unroll
        for (int j = 0; j < 4; ++j) { v[j] = xr[64 * j + lane]; s += v[j][0] * v[j][0] + v[j][1] * v[j][1] + v[j][2] * v[j][2] + v[j][3] * v[j][3]; }
        s = wave_sum(s);
        const float r = __builtin_amdgcn_rsqf(s * (1.f / D) + EPS);
        const float* mb = modl + (size_t)b * MODN;
#pragma unroll
        for (int j = 0; j < 4; ++j) {
            const int col = 4 * (64 * j + lane);
            const f32x4 g = *(const f32x4*)(gain + col), scv = *(const f32x4*)(mb + sc_off + col), shv = *(const f32x4*)(mb + sh_off + col);
            const f32x4 y = v[j] * r * g * (1.f + scv) + shv;
            u32x2 o; o[0] = pk2(y[0], y[1]); o[1] = pk2(y[2], y[3]);
            *(u32x2*)(XN + (size_t)row * D + col) = o;
        }
    }
}

__device__ __forceinline__ void phase_post0(bf16_t* E, bf16_t* __restrict__ KC3, unsigned* __restrict__ SGN, const float* __restrict__ qn_a, const float* __restrict__ kn_a, const float* __restrict__ qn_b, const float* __restrict__ kn_b, int G) {
    int tid_ = threadIdx.x; asm volatile("" : "+v"(tid_));
    const int lane = tid_ & 63; const int gw = blockIdx.x * 8 + (tid_ >> 6), NGW = G * 8;
    const int sub = (lane & 7) * 8;
    for (int row = gw; row < M; row += NGW) {
        bf16_t* e = E + (size_t)row * EP;
        float w[8]; unsigned sgn = 0;
        { const u32x4 wr_ = *(const u32x4*)(e + C_IW);
          w[0] = __uint_as_float(wr_[0] << 16); w[1] = __uint_as_float(wr_[0] & 0xffff0000u); w[2] = __uint_as_float(wr_[1] << 16); w[3] = __uint_as_float(wr_[1] & 0xffff0000u);
          w[4] = __uint_as_float(wr_[2] << 16); w[5] = __uint_as_float(wr_[2] & 0xffff0000u); w[6] = __uint_as_float(wr_[3] << 16); w[7] = __uint_as_float(wr_[3] & 0xffff0000u); }
#pragma unroll
        for (int h = 0; h < 8; ++h) if (w[h] < 0.f) sgn |= 1u << h;
        if (lane == 0) SGN[row] = sgn;
#pragma unroll 1
        for (int it = 0; it < 6; ++it) {
            const int grp = it * 8 + (lane >> 3), col = grp * 64 + sub;
            const bool act = grp < 43;
            const u32x4 raw = act ? *(const u32x4*)(e + col) : (u32x4){0u, 0u, 0u, 0u};
            float v[8];
#pragma unroll
            for (int k = 0; k < 4; ++k) { v[2 * k] = __uint_as_float(raw[k] << 16); v[2 * k + 1] = __uint_as_float(raw[k] & 0xffff0000u); }
            float ss = 0.f;
#pragma unroll
            for (int i = 0; i < 8; ++i) ss += v[i] * v[i];
            ss += __shfl_xor(ss, 1); ss += __shfl_xor(ss, 2); ss += __shfl_xor(ss, 4);
            const float r = __builtin_amdgcn_rsqf(ss * (1.f / 64.f) + EPS);
            const float* gp = nullptr; float scale = 1.f; bool wrt = false;
            if (grp < 8) { gp = qn_a; scale = r * QS; wrt = true; }
            else if (grp < 16) { gp = kn_a; scale = r; wrt = true; }
            else if (grp < 24) { }
            else if (grp < 32) { gp = qn_b; scale = r * QS; wrt = true; }
            else if (grp == 32) { gp = kn_b; scale = r; wrt = true; }
            else if (grp == 33) { }
            else if (grp < 42) { float wsel = 0.f;
#pragma unroll
                for (int h = 0; h < 8; ++h) wsel = (grp - 34 == h) ? w[h] : wsel;
                scale = fabsf(wsel) * IS; wrt = true; }
            if (grp == 33) *(u32x4*)(KC3 + (size_t)2 * M * 64 + (size_t)row * 64 + sub) = raw;
            if (grp == 42) *(u32x4*)(KC3 + (size_t)row * 64 + sub) = raw;
            if (act && wrt) {
                u32x4 ov;
#pragma unroll
                for (int k = 0; k < 4; ++k) ov[k] = pk2(v[2 * k] * scale * (gp ? gp[sub + 2 * k] : 1.f), v[2 * k + 1] * scale * (gp ? gp[sub + 2 * k + 1] : 1.f));
                *(u32x4*)(e + col) = ov;
                if (grp == 32) *(u32x4*)(KC3 + (size_t)M * 64 + (size_t)row * 64 + sub) = ov;
            }
        }
    }
}

__global__ void __launch_bounds__(512, 2) mega_fwd(Params p) {
    extern __shared__ __attribute__((aligned(16))) unsigned char lds[];
    const int tid = threadIdx.x, lane = tid & 63; const int wid = __builtin_amdgcn_readfirstlane(tid >> 6);
    const int G = gridDim.x, cb = blockIdx.x;
    LAS unsigned char* l3 = (LAS unsigned char*)lds;
    volatile LAS unsigned* MISC = (volatile LAS unsigned*)(l3 + MISC_OFF);
    if (tid < 128) MISC[tid] = 0u;
    __syncthreads();
    unsigned* ctl = (unsigned*)(p.ws + WS_CTL);
    const bool multi = (p.ph_hi - p.ph_lo) > 1;
    XcdBarrier bar; bar.bar = ctl + 1024; bar.x = 0; bar.st = nullptr;
    if (multi) bar = xcd_barrier_post(ctl + 1024, MISC + 8);
    const float* x = p.in[0]; float* out = p.out;

    for (int ph = p.ph_lo; ph < p.ph_hi; ++ph) {
        GAS unsigned char* wsg_ = (GAS unsigned char*)p.ws; asm volatile("" : "+s"(wsg_)); unsigned char* ws = (unsigned char*)wsg_;
        int lane_o = tid; asm volatile("" : "+v"(lane_o)); lane_o &= 63;
        float* mod = (float*)(ws + WS_MOD); unsigned* SGN = (unsigned*)(ws + WS_SGN);
        bf16_t* XN = (bf16_t*)(ws + WS_XN); bf16_t* Yb = (bf16_t*)(ws + WS_Y); bf16_t* E = (bf16_t*)(ws + WS_E);
        const int l = ph >= 9 ? 1 : 0;
        int kind;
        if (l == 0) kind = ph; else { const int k1 = ph - 9; kind = (k1 == 0) ? 1 : (k1 == 1) ? 2 : (k1 == 2) ? 9 : k1 + 2; }
        const float* modl = mod + (size_t)l * 4 * MODN;
        if (kind == 0) phase_prologue(p, lds, G);
        else if (kind == 1) phase_norm(l == 0 ? x : out, p.in[4] + l * D, modl, 0, 1024, XN, G);
        else if (kind == 6) phase_norm(out, p.in[5] + l * D, modl, 3072, 4096, XN, G);
        else if (kind == 2) {
            pg8::Gemm g{XN, (const bf16_t*)(ws + (l == 0 ? WS_WIN0 : WS_WIN1)), M, l == 0 ? EP : OP, D};
            pg8::StaticOrder S; S.init(M, g.N, G, cb);
            pg8::EpiRawBf16 Ep{E, g.N};
            pg8::gemm_phase<pg8::EpiRawBf16, pg8::StaticOrder, true, true>(l3, g, S, Ep);
        }
        else if (kind == 3) phase_post0(E, (bf16_t*)(ws + WS_IKC), SGN, p.in[11], p.in[12], p.in[18], p.in[19], G);
        else if (kind == 4) {
            const float t1 = wave_sum(p.in[13][lane_o] * p.in[14][lane_o]), t2 = wave_sum(p.in[15][lane_o] * p.in[16][lane_o]);
            const float lam = expf(t1) - expf(t2) + 0.2f;
            const float gq = wave_max(fabsf(p.in[11][lane_o])), gk = wave_max(fabsf(p.in[12][lane_o]));
            const float cut = 2.f * (8.f * gq * gk * 1.03f) + 30.f;
            unsigned* qctr = ctl + 64;
            if (tid == 0) MISC[16] = atomicAdd(qctr, 1u);
            __syncthreads();
            int item = (int)MISC[16];
            while (item < 512 + 2048) {
                unsigned nxt = 0u;
                if (tid == 0) nxt = atomicAdd(qctr, 1u);
                if (item < 512) {
                    const int hh = 3 - (item >> 7), r_ = item & 127, qb = 31 - (r_ >> 2), bb = r_ & 3;
                    const float dh = cut * __builtin_amdgcn_exp2f(2.f * (float)(hh + 1));
                    int t0 = (int)floorf(((float)(128 * qb) - dh) * (1.f / 64.f)); t0 = t0 < 0 ? 0 : t0;
                    attnA_unit(bb, hh, qb, t0, E, Yb, lam, p.in[17], lds);
                } else {
                    const int k = item - 512, bb = k & 3, ib = 511 - (k >> 2);
                    dsa_unit(bb, ib * 8, E, (const bf16_t*)(ws + WS_IKC), SGN, Yb, lds);
                }
                if (tid == 0) MISC[16] = nxt;
                __syncthreads();
                item = (int)MISC[16];
            }
        }
        else if (kind == 9) {
            for (int u = cb; u < 512; u += G) { const int bk = u & 15, nb = (u >> 4) & 31;
                swa_unit(bk >> 2, bk & 3, nb, E, Yb, p.in[21], p.in[22], p.in[23], lds); }
        }
        else if (kind == 5 || kind == 8) {
            const bool dn = (kind == 8);
            pg8::Gemm g{dn ? E : Yb, (const bf16_t*)(ws + (dn ? WS_WDN : WS_WOUT)) + (size_t)l * (dn ? D * FF : D * D), M, D, dn ? FF : D};
            pg8::StaticOrder S; S.init(M, D, G, cb);
            pg8::EpiResGate Ep{(kind == 5 && l == 0) ? x : out, out, modl + (dn ? 5120 : 2048)};
            pg8::gemm_phase<pg8::EpiResGate, pg8::StaticOrder, true, true>(l3, g, S, Ep);
        }
        else if (kind == 7) {
            pg8::Gemm g{XN, (const bf16_t*)(ws + WS_WGU) + (size_t)l * GU * D, M, GU, D};
            pg8::StaticOrder S; S.init(M, GU, G, cb);
            pg8::EpiSwiglu Ep{E};
            pg8::gemm_phase<pg8::EpiSwiglu, pg8::StaticOrder, true, true>(l3, g, S, Ep);
        }
        if (ph + 1 < p.ph_hi) xcd_barrier(bar);
    }
}

#ifndef MK_SPLIT
#define MK_SPLIT 0
#endif
extern "C" void kernel_launch(void* const* d_in, const int* in_sizes, int n_in, void* d_out, int out_size, void* d_ws, size_t ws_size, hipStream_t stream) {
    static int grid = 0;
    if (grid == 0) {
        int dev = 0, cus = 0, per_cu = 0;
        if (hipGetDevice(&dev) != hipSuccess || hipDeviceGetAttribute(&cus, hipDeviceAttributeMultiprocessorCount, dev) != hipSuccess) { fprintf(stderr, "kernel_launch: device query failed\n"); grid = -1; return; }
        if (hipFuncSetAttribute((const void*)mega_fwd, hipFuncAttributeMaxDynamicSharedMemorySize, LDS_BYTES) != hipSuccess) { fprintf(stderr, "kernel_launch: hipFuncSetAttribute failed\n"); grid = -1; return; }
        if (hipOccupancyMaxActiveBlocksPerMultiprocessor(&per_cu, (const void*)mega_fwd, 512, LDS_BYTES) != hipSuccess || per_cu < 1) { fprintf(stderr, "kernel_launch: occupancy query says %d\n", per_cu); (void)hipGetLastError(); per_cu = 1; }
        grid = cus;
    }
    if (grid < 0) return;
    (void)hipMemsetAsync((char*)d_ws + WS_CTL, 0, CTL_ZERO_BYTES, stream);
    Params p{};
    for (int i = 0; i < 24; ++i) p.in[i] = (const float*)d_in[i];
    p.out = (float*)d_out; p.ws = (unsigned char*)d_ws;
#if MK_SPLIT
    for (int ph = 0; ph < 16; ++ph) { p.ph_lo = ph; p.ph_hi = ph + 1; hipLaunchKernelGGL(mega_fwd, dim3(grid), dim3(512), LDS_BYTES, stream, p); }
#else
    p.ph_lo = 0; p.ph_hi = 16;
    void* args[] = {&p};
    hipError_t e = hipLaunchCooperativeKernel((const void*)mega_fwd, dim3(grid), dim3(512), args, LDS_BYTES, stream);
    if (e != hipSuccess) fprintf(stderr, "kernel_launch: cooperative launch failed: %s\n", hipGetErrorString(e));
#endif
}
```

```cpp
#include <hip/hip_runtime.h>
#include <cstdio>
#include <stdint.h>

#define LAS __attribute__((address_space(3)))
#define GAS __attribute__((address_space(1)))
typedef unsigned short bf16_t;
typedef short bf16x8 __attribute__((ext_vector_type(8)));
typedef short s16x4 __attribute__((ext_vector_type(4)));
typedef short v4i16_t __attribute__((ext_vector_type(4)));
typedef float f32x4 __attribute__((ext_vector_type(4)));
typedef float f32x16 __attribute__((ext_vector_type(16)));
typedef unsigned u32x4 __attribute__((ext_vector_type(4)));
typedef unsigned u32x2 __attribute__((ext_vector_type(2)));
typedef float f32x2_t __attribute__((ext_vector_type(2)));
typedef __bf16 bf16x2_t __attribute__((ext_vector_type(2)));
typedef LAS const char* lds_cptr;

constexpr int D = 1024, BATCH = 4, SEQ = 4096, M = BATCH * SEQ, FF = 2816, ECOLS = 2760, EP = 2816, OP = 1536, MODN = 6144, GU = 2 * FF;
constexpr float LOG2E = 1.4426950408889634f;
constexpr float QS = 0.125f * LOG2E;
constexpr float IS = 0.125f * 0.35355339059327373f;
constexpr float EPS = 1e-6f;
constexpr int C_AQ = 0, C_AK = 512, C_AV = 1024, C_BQ = 1536, C_BK = 2048, C_BV = 2112, C_IQ = 2176, C_IK = 2688, C_IW = 2752;
constexpr int C1_Q = 0, C1_K = 1024, C1_V = 1280;

constexpr size_t MiB = 1u << 20;
constexpr size_t WS_CTL = 0, CTL_ZERO_BYTES = 256 * 1024;
constexpr size_t WS_MOD = 1 * MiB, WS_SGN = 1 * MiB + 512 * 1024;
constexpr size_t WS_SSQ = 64 * 1024;
constexpr size_t WS_BIAS = 1 * MiB + 256 * 1024;
constexpr size_t WS_WIN0 = 2 * MiB;
constexpr size_t WS_WOUT = 8 * MiB;
constexpr size_t WS_WGU = 12 * MiB;
constexpr size_t WS_WDN = 34 * MiB;
constexpr size_t WS_WIN1 = 45 * MiB;
constexpr size_t WS_XN = 50 * MiB, WS_Y = 82 * MiB, WS_E = 114 * MiB, WS_END = 202 * MiB;
constexpr size_t WS_IKC = 202 * MiB, WS_BKC = 204 * MiB, WS_BVC = 206 * MiB;
constexpr size_t WS_R = 208 * MiB;

__device__ __forceinline__ float bf2f(bf16_t v) { return __uint_as_float((unsigned)v << 16); }
__device__ __forceinline__ bf16_t f2bf(float f) { unsigned u = __float_as_uint(f); return (bf16_t)((u + 0x7fffu + ((u >> 16) & 1u)) >> 16); }
__device__ __forceinline__ unsigned pk2(float lo, float hi) { return (unsigned)f2bf(lo) | ((unsigned)f2bf(hi) << 16); }
__device__ __forceinline__ unsigned cvtpk(float lo, float hi) { f32x2_t v = {lo, hi}; bf16x2_t b = __builtin_convertvector(v, bf16x2_t); return __builtin_bit_cast(unsigned, b); }
__device__ __forceinline__ float wave_sum(float v) {
#pragma unroll
    for (int o = 1; o < 64; o <<= 1) v += __shfl_xor(v, o);
    return v;
}
__device__ __forceinline__ float wave_max(float v) {
#pragma unroll
    for (int o = 1; o < 64; o <<= 1) v = fmaxf(v, __shfl_xor(v, o));
    return v;
}
__device__ __forceinline__ int crow(int r, int hi) { return (r & 3) + 8 * (r >> 2) + 4 * hi; }
__device__ __forceinline__ float xhalf_max(float m) { auto rr = __builtin_amdgcn_permlane32_swap(__float_as_uint(m), __float_as_uint(m), false, false); return fmaxf(__uint_as_float(rr[0]), __uint_as_float(rr[1])); }
__device__ __forceinline__ float xhalf_sum(float m) { auto rr = __builtin_amdgcn_permlane32_swap(__float_as_uint(m), __float_as_uint(m), false, false); return __uint_as_float(rr[0]) + __uint_as_float(rr[1]); }
__device__ __forceinline__ void glds16(const void* gsrc, unsigned lds_dst) { unsigned keep;
    asm volatile("s_mov_b32 %0, m0\n\ts_mov_b32 m0, %2\n\ts_nop 0\n\tglobal_load_lds_dwordx4 %1, off\n\ts_mov_b32 m0, %0" : "=&s"(keep) : "v"(gsrc), "s"(lds_dst) : "memory"); }
__device__ __forceinline__ s16x4 vtr(lds_cptr p) { return __builtin_bit_cast(s16x4, __builtin_amdgcn_ds_read_tr16_b64_v4i16((LAS v4i16_t*)p)); }
#define WAITV_BAR() asm volatile("s_waitcnt vmcnt(0) lgkmcnt(0)\n\ts_barrier" ::: "memory")
#define WAITL_BAR() asm volatile("s_waitcnt lgkmcnt(0)\n\ts_barrier" ::: "memory")

namespace pg8 {
constexpr int BM = 256, BK = 64, HALF = 128, HTB = HALF * BK * 2, STAGE_BYTES = 8 * HTB, NXCD = 8, WGM = 8;
__host__ __device__ __forceinline__ int lds_byte(int r, int c) { const int st = (r >> 4) * 2 + (c >> 5), rr = r & 15, cc = c & 31, ob = rr * 64 + cc * 2; return st * 1024 + (ob ^ (((ob >> 9) & 1) << 5)); }
__host__ __device__ __forceinline__ void stage_rc(int b, int& R, int& C) { const int st = b / 1024, sb = b % 1024, swz = sb ^ (((sb >> 9) & 1) << 5); R = (st >> 1) * 16 + swz / 64; C = (st & 1) * 32 + (swz % 64) / 2; }
__host__ __device__ __forceinline__ int perm32(int rho) { const int n = rho >> 4, i = rho & 15; return 8 * (i >> 2) + 4 * n + (i & 3); }
struct Unit { int pm, pn; };
struct Gemm { const bf16_t* A; const bf16_t* Bt; int M, N, K; };
struct StaticOrder {
    int nM, nN, nwg, G, c;
    __host__ __device__ void init(int M_, int N_, int G_, int c_) { nM = M_ / BM; nN = N_ / BM; nwg = nM * nN; G = G_; c = c_; }
    __host__ __device__ bool next(int i, Unit& u) const {
        const long L = (long)i * G + c; if (L >= nwg) return false;
        int wgid = (int)L; { const int q = nwg / NXCD, r = nwg % NXCD, xcd = wgid % NXCD, off = wgid / NXCD; wgid = (xcd < r ? xcd * (q + 1) : r * (q + 1) + (xcd - r) * q) + off; }
        const int nig = WGM * nN, gid = wgid / nig, fm = gid * WGM, gsz = (nM - fm) < WGM ? (nM - fm) : WGM;
        u.pm = fm + ((wgid % nig) % gsz); u.pn = (wgid % nig) / gsz; return true;
    }
    __device__ __forceinline__ void a_ready(const Unit&) const {}
    __device__ __forceinline__ void done(const Unit&) const {}
};
__device__ __forceinline__ unsigned cvt_pk_bf16(float lo, float hi) { unsigned r; asm volatile("v_cvt_pk_bf16_f32 %0, %1, %2" : "=v"(r) : "v"(lo), "v"(hi)); return r; }

struct NoPre {};
struct EpiRawBf16 {
    static constexpr bool PERM = true, AFTER_DRAIN = false; typedef NoPre Pre;
    __device__ __forceinline__ Pre pre(const Unit&, int, int, int, int) const { return Pre{}; }
    bf16_t* O; int ldc;
    __device__ __forceinline__ void operator()(const f32x4 (&acc)[2][2][4][2], const Unit& u, const Pre&, int wr, int wc, int fr, int fq) const {
        const int row0 = u.pm * BM + wr * 64 + fr, col0 = u.pn * BM + wc * 32 + 8 * fq;
#pragma unroll
        for (int ai = 0; ai < 2; ++ai)
#pragma unroll
            for (int m = 0; m < 4; ++m) { bf16_t* rowp = O + (size_t)(row0 + ai * HALF + m * 16) * ldc + col0;
#pragma unroll
                for (int bj = 0; bj < 2; ++bj) { const f32x4 v0 = acc[ai][bj][m][0], v1 = acc[ai][bj][m][1];
                    u32x4 w; w.x = cvt_pk_bf16(v0[0], v0[1]); w.y = cvt_pk_bf16(v0[2], v0[3]); w.z = cvt_pk_bf16(v1[0], v1[1]); w.w = cvt_pk_bf16(v1[2], v1[3]);
                    *(u32x4*)(rowp + bj * HALF) = w; } }
    }
};
struct EpiResGateN {
    static constexpr bool PERM = true, AFTER_DRAIN = false; typedef NoPre Pre;
    __device__ __forceinline__ Pre pre(const Unit&, int, int, int, int) const { return Pre{}; }
    const void* base; void* out; int base_bf16, out_bf16;
    const float* gate; bf16_t* XA; const float* gain; const float* scn; float* SSQ; LAS unsigned char* lds;
    __device__ __forceinline__ void operator()(const f32x4 (&acc)[2][2][4][2], const Unit& u, const Pre&, int wr, int wc, int fr, int fq) const {
        const int row0 = u.pm * BM + wr * 64 + fr, col0 = u.pn * BM + wc * 32 + 8 * fq, b = (u.pm * BM) / SEQ;
        f32x4 g[2][2], gs[2][2];
#pragma unroll
        for (int bj = 0; bj < 2; ++bj)
#pragma unroll
            for (int n = 0; n < 2; ++n) { g[bj][n] = *(const f32x4*)(gate + (size_t)b * MODN + col0 + bj * HALF + 4 * n);
                if (XA) gs[bj][n] = *(const f32x4*)(gain + col0 + bj * HALF + 4 * n) * (1.f + *(const f32x4*)(scn + (size_t)b * MODN + col0 + bj * HALF + 4 * n)); }
        LAS float* part = (LAS float*)(lds + 131072);
#pragma unroll
        for (int ai = 0; ai < 2; ++ai)
#pragma unroll
            for (int m = 0; m < 4; ++m) { const size_t off = (size_t)(row0 + ai * HALF + m * 16) * D + col0; float ss = 0.f;
#pragma unroll
                for (int bj = 0; bj < 2; ++bj) { f32x4 o[2];
                    if (base_bf16) { const u32x4 w = *(const u32x4*)((const bf16_t*)base + off + bj * HALF);
                        o[0] = (f32x4){__uint_as_float(w[0] << 16), __uint_as_float(w[0] & 0xffff0000u), __uint_as_float(w[1] << 16), __uint_as_float(w[1] & 0xffff0000u)};
                        o[1] = (f32x4){__uint_as_float(w[2] << 16), __uint_as_float(w[2] & 0xffff0000u), __uint_as_float(w[3] << 16), __uint_as_float(w[3] & 0xffff0000u)}; }
                    else { o[0] = *(const f32x4*)((const float*)base + off + bj * HALF); o[1] = *(const f32x4*)((const float*)base + off + bj * HALF + 4); }
#pragma unroll
                    for (int n = 0; n < 2; ++n) { o[n] = o[n] + g[bj][n] * acc[ai][bj][m][n]; ss += o[n][0] * o[n][0] + o[n][1] * o[n][1] + o[n][2] * o[n][2] + o[n][3] * o[n][3]; }
                    if (out_bf16) { u32x4 w; w.x = cvt_pk_bf16(o[0][0], o[0][1]); w.y = cvt_pk_bf16(o[0][2], o[0][3]); w.z = cvt_pk_bf16(o[1][0], o[1][1]); w.w = cvt_pk_bf16(o[1][2], o[1][3]);
                        *(u32x4*)((bf16_t*)out + off + bj * HALF) = w; }
                    else { *(f32x4*)((float*)out + off + bj * HALF) = o[0]; *(f32x4*)((float*)out + off + bj * HALF + 4) = o[1]; }
                    if (XA) { const f32x4 a0 = o[0] * gs[bj][0], a1 = o[1] * gs[bj][1];
                        u32x4 w; w.x = cvt_pk_bf16(a0[0], a0[1]); w.y = cvt_pk_bf16(a0[2], a0[3]); w.z = cvt_pk_bf16(a1[0], a1[1]); w.w = cvt_pk_bf16(a1[2], a1[3]);
                        *(u32x4*)(XA + off + bj * HALF) = w; } }
                if (XA) { ss += __shfl_xor(ss, 16); ss += __shfl_xor(ss, 32);
                    if (fq == 0) part[wc * 256 + ai * HALF + wr * 64 + m * 16 + fr] = ss; } }
        if (XA) {
            asm volatile("s_waitcnt lgkmcnt(0)\n\ts_barrier" ::: "memory");
            const int t = threadIdx.x;
            if (t < 256) atomicAdd(SSQ + (size_t)(u.pm * BM + t), part[t] + part[256 + t] + part[512 + t] + part[768 + t]);
            asm volatile("s_waitcnt lgkmcnt(0)\n\ts_barrier" ::: "memory");
        }
    }
};
struct PreRB { float sq[8]; u32x4 bv[2]; };
struct EpiRawBf16S {
    static constexpr bool PERM = true, AFTER_DRAIN = false; typedef PreRB Pre;
    bf16_t* O; int ldc; const float* SSQ; const bf16_t* bias; int nb;
    __device__ __forceinline__ Pre pre(const Unit& u, int wr, int wc, int fr, int fq) const {
        Pre p; const int row0 = u.pm * BM + wr * 64 + fr, col0 = u.pn * BM + wc * 32 + 8 * fq, b = (u.pm * BM) / SEQ;
#pragma unroll
        for (int i = 0; i < 8; ++i) p.sq[i] = SSQ[row0 + (i >> 2) * HALF + (i & 3) * 16];
#pragma unroll
        for (int bj = 0; bj < 2; ++bj) p.bv[bj] = *(const u32x4*)(bias + (size_t)b * nb + col0 + bj * HALF);
        return p;
    }
    __device__ __forceinline__ void operator()(const f32x4 (&acc)[2][2][4][2], const Unit& u, const Pre& p, int wr, int wc, int fr, int fq) const {
        const int row0 = u.pm * BM + wr * 64 + fr, col0 = u.pn * BM + wc * 32 + 8 * fq;
#pragma unroll
        for (int ai = 0; ai < 2; ++ai)
#pragma unroll
            for (int m = 0; m < 4; ++m) { const int row = row0 + ai * HALF + m * 16; bf16_t* rowp = O + (size_t)row * ldc + col0;
                const float rs = __builtin_amdgcn_rsqf(p.sq[ai * 4 + m] * (1.f / D) + EPS);
#pragma unroll
                for (int bj = 0; bj < 2; ++bj) { const u32x4 bw = p.bv[bj];
                    const f32x4 b0 = (f32x4){__uint_as_float(bw[0] << 16), __uint_as_float(bw[0] & 0xffff0000u), __uint_as_float(bw[1] << 16), __uint_as_float(bw[1] & 0xffff0000u)};
                    const f32x4 b1 = (f32x4){__uint_as_float(bw[2] << 16), __uint_as_float(bw[2] & 0xffff0000u), __uint_as_float(bw[3] << 16), __uint_as_float(bw[3] & 0xffff0000u)};
                    const f32x4 v0 = acc[ai][bj][m][0] * rs + b0, v1 = acc[ai][bj][m][1] * rs + b1;
                    u32x4 w; w.x = cvt_pk_bf16(v0[0], v0[1]); w.y = cvt_pk_bf16(v0[2], v0[3]); w.z = cvt_pk_bf16(v1[0], v1[1]); w.w = cvt_pk_bf16(v1[2], v1[3]);
                    *(u32x4*)(rowp + bj * HALF) = w; } }
    }
};
struct EpiSwigluS {
    static constexpr bool PERM = true, AFTER_DRAIN = false; typedef PreRB Pre;
    bf16_t* H; const float* SSQ; const bf16_t* bias;
    __device__ __forceinline__ Pre pre(const Unit& u, int wr, int wc, int fr, int fq) const {
        Pre p; const int row0 = u.pm * BM + wr * 64 + fr, gc0 = u.pn * BM + wc * 32 + 8 * fq, b = (u.pm * BM) / SEQ;
#pragma unroll
        for (int i = 0; i < 8; ++i) p.sq[i] = SSQ[row0 + (i >> 2) * HALF + (i & 3) * 16];
#pragma unroll
        for (int bj = 0; bj < 2; ++bj) p.bv[bj] = *(const u32x4*)(bias + (size_t)b * (2 * FF) + gc0 + bj * HALF);
        return p;
    }
    __device__ __forceinline__ void operator()(const f32x4 (&acc)[2][2][4][2], const Unit& u, const Pre& p, int wr, int wc, int fr, int fq) const {
        const int row0 = u.pm * BM + wr * 64 + fr, col0 = u.pn * HALF + wc * 32 + 8 * fq;
#pragma unroll
        for (int ai = 0; ai < 2; ++ai)
#pragma unroll
            for (int m = 0; m < 4; ++m) { const int row = row0 + ai * HALF + m * 16; bf16_t* rowp = H + (size_t)row * FF + col0;
                const float rs = __builtin_amdgcn_rsqf(p.sq[ai * 4 + m] * (1.f / D) + EPS);
                float hv[8];
#pragma unroll
                for (int n = 0; n < 2; ++n)
#pragma unroll
                    for (int e = 0; e < 4; ++e) { const unsigned gw_ = p.bv[0][n * 2 + (e >> 1)], uw_ = p.bv[1][n * 2 + (e >> 1)];
                        const float gb = (e & 1) ? __uint_as_float(gw_ & 0xffff0000u) : __uint_as_float(gw_ << 16), ub = (e & 1) ? __uint_as_float(uw_ & 0xffff0000u) : __uint_as_float(uw_ << 16);
                        const float gv = acc[ai][0][m][n][e] * rs + gb, uv = acc[ai][1][m][n][e] * rs + ub;
                        hv[n * 4 + e] = gv * __builtin_amdgcn_rcpf(1.f + __builtin_amdgcn_exp2f(-gv * LOG2E)) * uv; }
                u32x4 w; w.x = cvt_pk_bf16(hv[0], hv[1]); w.y = cvt_pk_bf16(hv[2], hv[3]); w.z = cvt_pk_bf16(hv[4], hv[5]); w.w = cvt_pk_bf16(hv[6], hv[7]);
                *(u32x4*)rowp = w; }
    }
};

template <class Epi, class Sched, bool ALIGN_EPI = false, bool SP2 = false>
__device__ __forceinline__ void gemm_phase(LAS unsigned char* lds, const Gemm g, const Sched& S, const Epi& E) {
    int tid_ = threadIdx.x; asm volatile("" : "+v"(tid_));
    const int tid = tid_, wid = __builtin_amdgcn_readfirstlane(tid >> 6), lane = tid & 63, wr = wid >> 2, wc = wid & 3, fr = lane & 15, fq = lane >> 4;
    const int K = g.K, nt = K / BK;
    unsigned voffA[2], voffB[2];
#pragma unroll
    for (int i = 0; i < 2; ++i) { int R, C; stage_rc(tid * 16 + i * 8192, R, C); const int Rb = Epi::PERM ? ((R & ~31) + perm32(R & 31)) : R;
        voffA[i] = (unsigned)(R * K + C) * 2u; voffB[i] = (unsigned)(Rb * K + C) * 2u; }
    const size_t kstep = (size_t)(BK * 2);
    const size_t hstep = (size_t)HALF * K * 2;
    const size_t tstep = 2 * hstep;
    const unsigned ldsw = (unsigned)wid * 1024u;
    const int aoff = lds_byte(wr * 64 + fr, fq * 8), boff = lds_byte(wc * 32 + fr, fq * 8);
#define PG8_SA(b, h) (((b) * 2 + (h)) * HTB)
#define PG8_SB(b, h) ((4 + (b) * 2 + (h)) * HTB)
#define PG8_STAGE(bufoff, gbase, voff) do { _Pragma("unroll") for (int _i = 0; _i < 2; ++_i) \
        __builtin_amdgcn_global_load_lds((const unsigned*)((const char*)(gbase) + (voff)[_i]), (LAS unsigned*)(lds + (bufoff) + ldsw + _i * 8192), 16, 0, 0); } while (0)
#define PG8_LDA(dst, b, h) do { _Pragma("unroll") for (int m = 0; m < 4; ++m) _Pragma("unroll") for (int k = 0; k < 2; ++k) dst[m][k] = *(const LAS bf16x8*)(lds + PG8_SA(b, h) + aoff + m * 2048 + k * 1024); } while (0)
#define PG8_LDB(dst, b, h) do { _Pragma("unroll") for (int n = 0; n < 2; ++n) _Pragma("unroll") for (int k = 0; k < 2; ++k) dst[n][k] = *(const LAS bf16x8*)(lds + PG8_SB(b, h) + boff + n * 2048 + k * 1024); } while (0)
#define PG8_MMA(ai, bj, At, Bt) do { __builtin_amdgcn_s_setprio(1); _Pragma("unroll") for (int m = 0; m < 4; ++m) _Pragma("unroll") for (int n = 0; n < 2; ++n) _Pragma("unroll") for (int k = 0; k < 2; ++k) \
        acc[ai][bj][m][n] = __builtin_amdgcn_mfma_f32_16x16x32_bf16(Bt[n][k], At[m][k], acc[ai][bj][m][n], 0, 0, 0); __builtin_amdgcn_s_setprio(0); } while (0)
#define PG8_WAIT_V(n) asm volatile("s_waitcnt vmcnt(" #n ")" ::: "memory")
#define PG8_WAIT_L(n) asm volatile("s_waitcnt lgkmcnt(" #n ")" ::: "memory")
#define PG8_BAR __builtin_amdgcn_s_barrier()
#define PG8_SCHED __builtin_amdgcn_sched_barrier(0)
    Unit cur, nxt; int ui = 0;
    if (!S.next(0, cur)) return;
    f32x4 acc[2][2][4][2];
#pragma unroll
    for (int a = 0; a < 2; ++a)
#pragma unroll
        for (int b = 0; b < 2; ++b)
#pragma unroll
            for (int m = 0; m < 4; ++m)
#pragma unroll
                for (int n = 0; n < 2; ++n) acc[a][b][m][n] = (f32x4){0.f, 0.f, 0.f, 0.f};
    bf16x8 At[4][2], B0[2][2], B1[2][2];
    const char* cA = (const char*)g.A + (size_t)cur.pm * tstep; const char* cB = (const char*)g.Bt + (size_t)cur.pn * tstep;
    S.a_ready(cur);
    typename Epi::Pre pre = E.pre(cur, wr, wc, fr, fq);
    if constexpr (SP2) {
        PG8_STAGE(PG8_SB(0, 0), cB, voffB); PG8_STAGE(PG8_SB(0, 1), cB + hstep, voffB); PG8_STAGE(PG8_SA(0, 0), cA, voffA); PG8_STAGE(PG8_SA(0, 1), cA + hstep, voffA);
        if (wr == 1) PG8_BAR;
        PG8_WAIT_V(2); PG8_BAR;
        PG8_STAGE(PG8_SB(1, 0), cB + kstep, voffB); PG8_STAGE(PG8_SA(1, 0), cA + kstep, voffA); PG8_STAGE(PG8_SB(1, 1), cB + hstep + kstep, voffB);
        PG8_WAIT_V(6); PG8_BAR;
    } else {
        PG8_STAGE(PG8_SB(0, 0), cB, voffB); PG8_STAGE(PG8_SA(0, 0), cA, voffA); PG8_STAGE(PG8_SB(0, 1), cB + hstep, voffB); PG8_STAGE(PG8_SA(0, 1), cA + hstep, voffA);
        if (wr == 1) PG8_BAR;
        PG8_WAIT_V(4); PG8_BAR;
        PG8_STAGE(PG8_SB(1, 0), cB + kstep, voffB); PG8_STAGE(PG8_SA(1, 0), cA + kstep, voffA); PG8_STAGE(PG8_SB(1, 1), cB + hstep + kstep, voffB);
        PG8_WAIT_V(6); PG8_BAR;
    }
    for (;;) {
        const bool has_next = S.next(ui + 1, nxt);
        const char* nA = has_next ? (const char*)g.A + (size_t)nxt.pm * tstep : cA; const char* nB = has_next ? (const char*)g.Bt + (size_t)nxt.pn * tstep : cB;
        for (int t = 0; t < nt; t += 2) {
            const bool last = (t == nt - 2);
            const char* a1 = cA + (size_t)(t + 1) * kstep;
            const char* a2 = last ? nA : cA + (size_t)(t + 2) * kstep; const char* b2 = last ? nB : cB + (size_t)(t + 2) * kstep;
            const char* a3 = a2 + kstep; const char* b3 = b2 + kstep;
            if (last && has_next) S.a_ready(nxt);
            if constexpr (SP2) {
            PG8_LDB(B0, 0, 0); PG8_LDB(B1, 0, 1); PG8_SCHED; PG8_LDA(At, 0, 0); PG8_STAGE(PG8_SA(1, 1), a1 + hstep, voffA);
            PG8_WAIT_V(8); PG8_WAIT_L(0); PG8_BAR; PG8_MMA(0, 0, At, B0); PG8_MMA(0, 1, At, B1); PG8_BAR; PG8_SCHED;
            PG8_LDA(At, 0, 1); PG8_STAGE(PG8_SB(0, 0), b2, voffB); PG8_STAGE(PG8_SB(0, 1), b2 + hstep, voffB); PG8_STAGE(PG8_SA(0, 0), a2, voffA);
            PG8_WAIT_V(8); PG8_WAIT_L(0); PG8_BAR; PG8_MMA(1, 0, At, B0); PG8_MMA(1, 1, At, B1); PG8_BAR; PG8_SCHED;
            PG8_LDB(B0, 1, 0); PG8_LDB(B1, 1, 1); PG8_SCHED; PG8_LDA(At, 1, 0); PG8_STAGE(PG8_SA(0, 1), a2 + hstep, voffA);
            PG8_WAIT_V(8); PG8_WAIT_L(0); PG8_BAR; PG8_MMA(0, 0, At, B0); PG8_MMA(0, 1, At, B1); PG8_BAR; PG8_SCHED;
            PG8_LDA(At, 1, 1); PG8_STAGE(PG8_SB(1, 0), b3, voffB); PG8_STAGE(PG8_SB(1, 1), b3 + hstep, voffB); PG8_STAGE(PG8_SA(1, 0), a3, voffA);
            PG8_WAIT_V(8); PG8_WAIT_L(0); PG8_BAR; PG8_MMA(1, 0, At, B0); PG8_MMA(1, 1, At, B1); PG8_BAR; PG8_SCHED;
            } else {
            PG8_LDB(B0, 0, 0); PG8_SCHED; PG8_LDA(At, 0, 0); PG8_STAGE(PG8_SA(1, 1), a1 + hstep, voffA);
            PG8_WAIT_L(8); PG8_BAR; PG8_WAIT_L(0); PG8_MMA(0, 0, At, B0); PG8_BAR; PG8_SCHED;
            PG8_LDB(B1, 0, 1); PG8_STAGE(PG8_SB(0, 0), b2, voffB);
            PG8_BAR; PG8_WAIT_L(0); PG8_MMA(0, 1, At, B1); PG8_BAR;
            PG8_LDA(At, 0, 1); PG8_STAGE(PG8_SA(0, 0), a2, voffA);
            PG8_BAR; PG8_WAIT_L(0); PG8_MMA(1, 0, At, B0); PG8_BAR; PG8_SCHED;
            PG8_STAGE(PG8_SB(0, 1), b2 + hstep, voffB);
            PG8_WAIT_V(6); PG8_BAR; PG8_MMA(1, 1, At, B1); PG8_BAR;
            PG8_LDB(B0, 1, 0); PG8_SCHED; PG8_LDA(At, 1, 0); PG8_STAGE(PG8_SA(0, 1), a2 + hstep, voffA);
            PG8_WAIT_L(8); PG8_BAR; PG8_WAIT_L(0); PG8_MMA(0, 0, At, B0); PG8_BAR; PG8_SCHED;
            PG8_LDB(B1, 1, 1); PG8_STAGE(PG8_SB(1, 0), b3, voffB);
            PG8_BAR; PG8_WAIT_L(0); PG8_MMA(0, 1, At, B1); PG8_BAR;
            PG8_LDA(At, 1, 1); PG8_STAGE(PG8_SA(1, 0), a3, voffA);
            PG8_BAR; PG8_WAIT_L(0); PG8_MMA(1, 0, At, B0); PG8_BAR; PG8_SCHED;
            PG8_STAGE(PG8_SB(1, 1), b3 + hstep, voffB);
            PG8_WAIT_V(6); PG8_BAR; PG8_MMA(1, 1, At, B1); PG8_BAR;
            }
        }
        if constexpr (ALIGN_EPI) { if (wr == 0) PG8_BAR; }
        if constexpr (!Epi::AFTER_DRAIN) { E(acc, cur, pre, wr, wc, fr, fq); S.done(cur); }
        if (!has_next) break;
#pragma unroll
        for (int a = 0; a < 2; ++a)
#pragma unroll
            for (int b = 0; b < 2; ++b)
#pragma unroll
                for (int m = 0; m < 4; ++m)
#pragma unroll
                    for (int n = 0; n < 2; ++n) acc[a][b][m][n] = (f32x4){0.f, 0.f, 0.f, 0.f};
        cur = nxt; cA = nA; cB = nB; ++ui;
        pre = E.pre(cur, wr, wc, fr, fq);
        if constexpr (ALIGN_EPI) { if (wr == 1) PG8_BAR; }
    }
    PG8_WAIT_V(0);
    if constexpr (!ALIGN_EPI) { if (wr == 0) PG8_BAR; }
    PG8_BAR;
#undef PG8_SA
#undef PG8_SB
#undef PG8_STAGE
#undef PG8_LDA
#undef PG8_LDB
#undef PG8_MMA
#undef PG8_WAIT_V
#undef PG8_WAIT_L
#undef PG8_BAR
#undef PG8_SCHED
}
}

__device__ __forceinline__ void qk_tile(f32x16& p0, f32x16& p1, lds_cptr Kt, const bf16x8 (&qr)[4], int r32, int hi) {
    lds_cptr kb = Kt + hi * 1024 + r32 * 16;
#pragma unroll
    for (int d0 = 0; d0 < 4; ++d0) {
        const bf16x8 b0 = *(const LAS bf16x8*)(kb + d0 * 2048);
        const bf16x8 b1 = *(const LAS bf16x8*)(kb + d0 * 2048 + 512);
        p0 = __builtin_amdgcn_mfma_f32_32x32x16_bf16(b0, qr[d0], p0, 0, 0, 0);
        p1 = __builtin_amdgcn_mfma_f32_32x32x16_bf16(b1, qr[d0], p1, 0, 0, 0);
    }
}
__device__ __forceinline__ float max32(const f32x16& p0, const f32x16& p1) {
    float a = fmaxf(p0[0], p1[0]), b = fmaxf(p0[1], p1[1]);
#pragma unroll
    for (int r = 2; r < 16; r += 2) { a = fmaxf(a, fmaxf(p0[r], p1[r])); b = fmaxf(b, fmaxf(p0[r + 1], p1[r + 1])); }
    return fmaxf(a, b);
}
template <int NDB>
__device__ __forceinline__ void softmax_pv(f32x16 (&o)[NDB], float& mref, float& lrun, f32x16& p0, f32x16& p1, lds_cptr Vt, LAS float* wsf, int r32, int hi, int lane) {
    float rm = xhalf_max(max32(p0, p1));
    if (__any(rm > 8.f)) {
        const float dl = fmaxf(rm, 0.f); mref += dl;
#pragma unroll
        for (int r = 0; r < 16; ++r) { p0[r] -= dl; p1[r] -= dl; }
        const float f = __builtin_amdgcn_exp2f(-dl); lrun *= f;
        if (hi == 0) wsf[r32] = f;
#pragma unroll
        for (int r = 0; r < 16; ++r) { const float fr_ = wsf[crow(r, hi)];
#pragma unroll
            for (int db = 0; db < NDB; ++db) o[db][r] *= fr_; }
    }
    float s = 0.f;
#pragma unroll
    for (int r = 0; r < 16; ++r) { p0[r] = __builtin_amdgcn_exp2f(p0[r]); p1[r] = __builtin_amdgcn_exp2f(p1[r]); s += p0[r] + p1[r]; }
    lrun += s;
    u32x4 pw[4];
#pragma unroll
    for (int k = 0; k < 4; ++k) {
        pw[0][k] = cvtpk(p0[2 * k], p0[2 * k + 1]); pw[1][k] = cvtpk(p0[8 + 2 * k], p0[8 + 2 * k + 1]);
        pw[2][k] = cvtpk(p1[2 * k], p1[2 * k + 1]); pw[3][k] = cvtpk(p1[8 + 2 * k], p1[8 + 2 * k + 1]);
    }
    lds_cptr vp = Vt + ((lane >> 4) & 1) * 32 + (lane & 3) * 8 + (4 * hi + ((lane & 15) >> 2)) * 64;
#pragma unroll
    for (int db = 0; db < NDB; ++db) {
#pragma unroll
        for (int ks = 0; ks < 4; ++ks) {
            const s16x4 lo = vtr(vp + db * 4096 + ks * 1024), hh = vtr(vp + db * 4096 + ks * 1024 + 512);
            const bf16x8 vf = (bf16x8){lo[0], lo[1], lo[2], lo[3], hh[0], hh[1], hh[2], hh[3]};
            o[db] = __builtin_amdgcn_mfma_f32_32x32x16_bf16(__builtin_bit_cast(bf16x8, pw[ks]), vf, o[db], 0, 0, 0);
        }
    }
}

constexpr int AT_STAGE = 32768, AT_XCHG = 65536, AT_WSF = 131072;
__device__ __forceinline__ void attnA_unit(const int b, const int h, const int qb, const int t0, const bf16_t* __restrict__ E, bf16_t* __restrict__ Y, const float lam, const float* __restrict__ subln, unsigned char* lds) {
    int tid_ = threadIdx.x; asm volatile("" : "+v"(tid_));
    const int tid = tid_, lane = tid & 63, r32 = lane & 31, hi = lane >> 5; const int wid = __builtin_amdgcn_readfirstlane(tid >> 6);
    const int mm = wid >> 2, rb = wid & 3;
    const int q0w = 128 * qb + 32 * rb, iq = q0w + r32, NT = 2 * (qb + 1);
    const bf16_t* Eb = E + (size_t)b * SEQ * EP;
    const unsigned lds0 = (unsigned)(uintptr_t)(LAS unsigned char*)lds;
    lds_cptr L = (lds_cptr)(LAS unsigned char*)lds;
    LAS float* wsf = (LAS float*)((LAS unsigned char*)lds + AT_WSF) + wid * 64;
    const bf16_t* src[4]; unsigned dsto[4];
#pragma unroll
    for (int i4 = 0; i4 < 4; ++i4) {
        if (wid < 4) { const int pidx = wid * 4 + i4, m_ = pidx >> 3, c = pidx & 7;
            src[i4] = Eb + (size_t)lane * EP + C_AK + h * 128 + m_ * 64 + c * 8; dsto[i4] = m_ * 8192 + c * 1024; }
        else { const int pidx = (wid - 4) * 4 + i4, db = pidx >> 2, rg = pidx & 3;
            src[i4] = Eb + (size_t)(16 * rg + (lane >> 2)) * EP + C_AV + h * 128 + db * 32 + (lane & 3) * 8; dsto[i4] = 16384 + db * 4096 + rg * 1024; }
    }
#define AT_DMA(t, stg) do { _Pragma("unroll") for (int i4 = 0; i4 < 4; ++i4) glds16(src[i4] + (size_t)(t) * 64 * EP, (unsigned)__builtin_amdgcn_readfirstlane(lds0 + (stg) * AT_STAGE + dsto[i4])); } while (0)
    AT_DMA(t0, 0);
    bf16x8 qr[4];
    { const bf16_t* Qw = Eb + (size_t)iq * EP + C_AQ + h * 128 + mm * 64;
#pragma unroll
      for (int d0 = 0; d0 < 4; ++d0) qr[d0] = *(const bf16x8*)(Qw + d0 * 16 + hi * 8); }
    const float slope2 = __builtin_amdgcn_exp2f(-2.f * (float)(h + 1)) * LOG2E;
    f32x16 o[4];
#pragma unroll
    for (int db = 0; db < 4; ++db) o[db] = f32x16{};
    float mref = 0.f, lrun = 0.f;
    for (int t = t0; t < NT; ++t) {
        WAITV_BAR();
        if (t + 1 < NT) AT_DMA(t + 1, (t + 1 - t0) & 1);
        if (64 * t <= q0w + 31) {
            lds_cptr st = L + ((t - t0) & 1) * AT_STAGE;
            const float tbm = slope2 * (float)(64 * t - iq) - mref;
            f32x16 p0, p1;
#pragma unroll
            for (int r = 0; r < 16; ++r) { p0[r] = tbm + slope2 * (float)crow(r, hi); p1[r] = p0[r] + 32.f * slope2; }
            qk_tile(p0, p1, st + mm * 8192, qr, r32, hi);
            if (64 * t + 63 > q0w) {
                const int kb = 64 * t + 4 * hi;
#pragma unroll
                for (int r = 0; r < 16; ++r) { const int kv = kb + (r & 3) + 8 * (r >> 2); if (kv > iq) p0[r] = -1e30f; if (kv + 32 > iq) p1[r] = -1e30f; }
            }
            softmax_pv<4>(o, mref, lrun, p0, p1, st + 16384, wsf, r32, hi, lane);
        }
    }
#undef AT_DMA
    lrun = xhalf_sum(lrun);
    if (hi == 0) wsf[r32] = lrun;
    float rli[16];
#pragma unroll
    for (int r = 0; r < 16; ++r) rli[r] = __builtin_amdgcn_rcpf(wsf[crow(r, hi)]);
    LAS float* xb = (LAS float*)((LAS unsigned char*)lds + AT_XCHG) + rb * 4096;
    if (mm == 1) {
#pragma unroll
        for (int db = 0; db < 4; ++db)
#pragma unroll
            for (int r = 0; r < 16; ++r) xb[(db * 16 + r) * 64 + lane] = o[db][r] * rli[r] * lam;
    }
    WAITL_BAR();
    if (mm == 0) {
        float ss[16];
#pragma unroll
        for (int r = 0; r < 16; ++r) ss[r] = 0.f;
#pragma unroll
        for (int db = 0; db < 4; ++db)
#pragma unroll
            for (int r = 0; r < 16; ++r) { const float dv = o[db][r] * rli[r] - xb[(db * 16 + r) * 64 + lane]; o[db][r] = dv; ss[r] += dv * dv; }
#pragma unroll
        for (int r = 0; r < 16; ++r) { float s = ss[r]; s += __shfl_xor(s, 1); s += __shfl_xor(s, 2); s += __shfl_xor(s, 4); s += __shfl_xor(s, 8); s += __shfl_xor(s, 16);
            ss[r] = __builtin_amdgcn_rsqf(s * (1.f / 128.f) + EPS) * 0.8f; }
        LAS bf16_t* stg = (LAS bf16_t*)((LAS unsigned char*)lds) + rb * 4096;
#pragma unroll
        for (int db = 0; db < 4; ++db) { const float gsub = subln[db * 32 + r32];
#pragma unroll
            for (int r = 0; r < 16; ++r) stg[crow(r, hi) * 128 + db * 32 + r32] = f2bf(o[db][r] * ss[r] * gsub); }
        bf16_t* Yw = Y + (size_t)(b * SEQ + q0w) * D + h * 128;
#pragma unroll
        for (int i8 = 0; i8 < 8; ++i8) { const int row = i8 * 4 + (lane >> 4), ch = lane & 15; const u32x4 v = *(const LAS u32x4*)(stg + row * 128 + ch * 8);
            *(u32x4*)(Yw + (size_t)row * D + ch * 8) = v; }
    }
    WAITL_BAR();
}

constexpr int SW_V = 32768, SW_OST = 65536;
__device__ __forceinline__ void swa_unit(const int b, const int kvh, const int nb, const bf16_t* __restrict__ E1, bf16_t* __restrict__ Y, const float* __restrict__ qn_c, const float* __restrict__ kn_c,
                                         const float* __restrict__ sinks, unsigned char* lds) {
    int tid_ = threadIdx.x; asm volatile("" : "+v"(tid_));
    const int tid = tid_, lane = tid & 63, r32 = lane & 31, hi = lane >> 5; const int wid = __builtin_amdgcn_readfirstlane(tid >> 6);
    const bf16_t* Eb = E1 + (size_t)b * SEQ * OP;
    LAS unsigned char* l3 = (LAS unsigned char*)lds;
    lds_cptr L = (lds_cptr)l3;
    LAS float* wsf = (LAS float*)(l3 + AT_WSF) + wid * 64;
    const int kt0 = (nb == 0) ? 2 : 0;
    {
        const int sub = lane & 7, rowi = tid >> 3;
        float kg[8];
#pragma unroll
        for (int i = 0; i < 8; ++i) kg[i] = kn_c[sub * 8 + i];
        for (int kt = kt0; kt < 4; ++kt) {
            const int key = 128 * (nb - 1) + 64 * kt + rowi;
            const u32x4 kr = *(const u32x4*)(Eb + (size_t)key * OP + C1_K + kvh * 64 + sub * 8);
            const u32x4 vr = *(const u32x4*)(Eb + (size_t)key * OP + C1_V + kvh * 64 + sub * 8);
            float v[8];
            v[0] = __uint_as_float(kr.x << 16); v[1] = __uint_as_float(kr.x & 0xffff0000u); v[2] = __uint_as_float(kr.y << 16); v[3] = __uint_as_float(kr.y & 0xffff0000u);
            v[4] = __uint_as_float(kr.z << 16); v[5] = __uint_as_float(kr.z & 0xffff0000u); v[6] = __uint_as_float(kr.w << 16); v[7] = __uint_as_float(kr.w & 0xffff0000u);
            float ss = 0.f;
#pragma unroll
            for (int i = 0; i < 8; ++i) ss += v[i] * v[i];
            ss += __shfl_xor(ss, 1); ss += __shfl_xor(ss, 2); ss += __shfl_xor(ss, 4);
            const float rr = __builtin_amdgcn_rsqf(ss * (1.f / 64.f) + EPS);
            u32x4 kw;
            kw.x = cvtpk(v[0] * rr * kg[0], v[1] * rr * kg[1]); kw.y = cvtpk(v[2] * rr * kg[2], v[3] * rr * kg[3]);
            kw.z = cvtpk(v[4] * rr * kg[4], v[5] * rr * kg[5]); kw.w = cvtpk(v[6] * rr * kg[6], v[7] * rr * kg[7]);
            *(LAS u32x4*)(l3 + kt * 8192 + sub * 1024 + rowi * 16) = kw;
            *(LAS u32x4*)(l3 + SW_V + kt * 8192 + (sub >> 2) * 4096 + (rowi >> 4) * 1024 + (rowi & 15) * 64 + (sub & 3) * 16) = vr;
        }
    }
    WAITL_BAR();
    const int g = wid >> 1, head = kvh * 4 + g;
    const float slope2 = __builtin_amdgcn_exp2f(-0.5f * (float)(head + 1)) * LOG2E;
    const float sink2 = sinks[head] * LOG2E;
    float qg[4][8];
#pragma unroll
    for (int d0 = 0; d0 < 4; ++d0)
#pragma unroll
        for (int i = 0; i < 8; ++i) qg[d0][i] = qn_c[d0 * 16 + hi * 8 + i] * QS;
    for (int rbi = 0; rbi < 2; ++rbi) {
        const int rb = 2 * (wid & 1) + rbi, rloc = 32 * rb + r32;
        const int tok = b * SEQ + 128 * nb + rloc;
        bf16x8 qr[4];
        { const bf16_t* Qw = E1 + (size_t)tok * OP + C1_Q + head * 64; u32x4 raw[4]; float ss = 0.f;
#pragma unroll
          for (int d0 = 0; d0 < 4; ++d0) { raw[d0] = *(const u32x4*)(Qw + d0 * 16 + hi * 8);
#pragma unroll
              for (int k = 0; k < 4; ++k) { const float a = __uint_as_float(raw[d0][k] << 16), c = __uint_as_float(raw[d0][k] & 0xffff0000u); ss += a * a + c * c; } }
          ss = xhalf_sum(ss);
          const float rr = __builtin_amdgcn_rsqf(ss * (1.f / 64.f) + EPS);
#pragma unroll
          for (int d0 = 0; d0 < 4; ++d0) { u32x4 w;
#pragma unroll
              for (int k = 0; k < 4; ++k) { const float a = __uint_as_float(raw[d0][k] << 16), c = __uint_as_float(raw[d0][k] & 0xffff0000u);
                  w[k] = cvtpk(a * rr * qg[d0][2 * k], c * rr * qg[d0][2 * k + 1]); }
              qr[d0] = __builtin_bit_cast(bf16x8, w); } }
        f32x16 o[2]; o[0] = f32x16{}; o[1] = f32x16{};
        float mref = 0.f, lrun = 0.f;
        const int ktlo = (rb < 2) ? 0 : 1, kthi = (rb < 2) ? 2 : 3;
        for (int kt = ktlo; kt <= kthi; ++kt) {
            if (kt < kt0) continue;
            const float tbm = slope2 * (float)(64 * kt - 128 - rloc) - mref;
            f32x16 p0, p1;
#pragma unroll
            for (int r = 0; r < 16; ++r) { p0[r] = tbm + slope2 * (float)crow(r, hi); p1[r] = p0[r] + 32.f * slope2; }
            qk_tile(p0, p1, L + kt * 8192, qr, r32, hi);
            const int jb = 64 * kt + 4 * hi;
#pragma unroll
            for (int r = 0; r < 16; ++r) { const int jj = jb + (r & 3) + 8 * (r >> 2);
                if (jj < rloc + 1 || jj > rloc + 128) p0[r] = -1e30f;
                if (jj + 32 < rloc + 1 || jj + 32 > rloc + 128) p1[r] = -1e30f; }
            softmax_pv<2>(o, mref, lrun, p0, p1, L + SW_V + kt * 8192, wsf, r32, hi, lane);
        }
        lrun = xhalf_sum(lrun) + __builtin_amdgcn_exp2f(sink2 - mref);
        if (hi == 0) wsf[r32] = lrun;
        LAS bf16_t* stg = (LAS bf16_t*)(l3 + SW_OST) + wid * 2048;
#pragma unroll
        for (int r = 0; r < 16; ++r) { const float rl = __builtin_amdgcn_rcpf(wsf[crow(r, hi)]);
#pragma unroll
            for (int db = 0; db < 2; ++db) stg[crow(r, hi) * 64 + db * 32 + r32] = f2bf(o[db][r] * rl); }
        bf16_t* Yw = Y + (size_t)(b * SEQ + 128 * nb + 32 * rb) * D + head * 64;
#pragma unroll
        for (int i4 = 0; i4 < 4; ++i4) { const int row = i4 * 8 + (lane >> 3), ch = lane & 7; const u32x4 v = *(const LAS u32x4*)(stg + row * 64 + ch * 8);
            *(u32x4*)(Yw + (size_t)row * D + ch * 8) = v; }
    }
    WAITL_BAR();
}

constexpr int DS_KSTR = 4100, DS_QROW = DS_KSTR * 4;
constexpr int DS_HIST = 131584, DS_LIST = 139776;
#define MFMA16(a, b, c) __builtin_amdgcn_mfma_f32_16x16x32_bf16((a), (b), (c), 0, 0, 0)
#ifndef DSA_REP1
#define DSA_REP1 1
#endif
#ifndef DSA_REP2
#define DSA_REP2 1
#endif
#ifndef DSA_REP3
#define DSA_REP3 1
#endif
__device__ __forceinline__ int pick_digit(const u32x4 hv, int& remaining, int lane) {
    const int s = (int)(hv[0] + hv[1] + hv[2] + hv[3]);
    int suf = s;
#pragma unroll
    for (int off = 1; off < 64; off <<= 1) { const int tv = __shfl_down(suf, off); if (lane + off < 64) suf += tv; }
    int cum = suf - s, found = -1, remn = 0;
#pragma unroll
    for (int d = 3; d >= 0; --d) { const int c = (int)hv[d]; if (found < 0 && cum < remaining && cum + c >= remaining) { found = 4 * lane + d; remn = remaining - cum; } cum += c; }
    const unsigned long long bal = __ballot(found >= 0);
    const int srcl = (int)__ffsll((long long)bal) - 1;
    remaining = __shfl(remn, srcl);
    return __shfl(found, srcl);
}
__device__ __forceinline__ void dsa_unit(const int b, const int i0, const bf16_t* __restrict__ E, const bf16_t* __restrict__ KC3, const unsigned* __restrict__ SGN, bf16_t* __restrict__ Y, unsigned char* lds) {
    int tid_ = threadIdx.x; asm volatile("" : "+v"(tid_));
    const int tid = tid_, lane = tid & 63, kq = lane >> 4, c16 = lane & 15; const int wid = __builtin_amdgcn_readfirstlane(tid >> 6);
    LAS unsigned char* l3 = (LAS unsigned char*)lds;
    LAS unsigned* keys = (LAS unsigned*)l3;
    const bf16_t* Eb = E + (size_t)b * SEQ * EP;
    const int nt16 = (i0 + 8 + 15) >> 4, n16 = nt16 * 16;
    const int nblk = (n16 + 511) >> 9;
    for (int rep1 = 0; rep1 < DSA_REP1; ++rep1)
    {
        for (int x4 = (n16 >> 2) + tid; x4 < 128 * nblk; x4 += 512) {
#pragma unroll
            for (int qq = 0; qq < 8; ++qq) *(LAS u32x4*)(keys + qq * DS_KSTR + 4 * x4) = (u32x4){0u, 0u, 0u, 0u};
        }
        const int q = c16 & 7, hg = c16 >> 3; const size_t tokq = (size_t)b * SEQ + i0 + q;
        bf16x8 Bq[4][2];
#pragma unroll
        for (int hh = 0; hh < 4; ++hh)
#pragma unroll
            for (int ks = 0; ks < 2; ++ks) Bq[hh][ks] = *(const bf16x8*)(E + tokq * EP + C_IQ + (4 * hg + hh) * 64 + ks * 32 + kq * 8);
        const unsigned sg = SGN[tokq] >> (4 * hg);
        float sm[4];
#pragma unroll
        for (int hh = 0; hh < 4; ++hh) sm[hh] = ((sg >> hh) & 1u) ? -1.f : 1.f;
        const char* kbase = (const char*)(KC3 + ((size_t)b * SEQ + c16) * 64 + kq * 8);
        bf16x8 a0[4], a1[4], n0[4], n1[4];
#pragma unroll
        for (int j = 0; j < 4; ++j) { int t = wid + 8 * j; t = t < nt16 ? t : nt16 - 1; const char* kr = kbase + (unsigned)(t * (16 * 64 * 2)); n0[j] = *(const bf16x8*)kr; n1[j] = *(const bf16x8*)(kr + 64); }
        for (int tg = wid; tg < nt16; tg += 32) {
#pragma unroll
            for (int j = 0; j < 4; ++j) { a0[j] = n0[j]; a1[j] = n1[j]; }
            if (tg + 32 < nt16) {
#pragma unroll
                for (int j = 0; j < 4; ++j) { int t = tg + 32 + 8 * j; t = t < nt16 ? t : nt16 - 1; const char* kr = kbase + (unsigned)(t * (16 * 64 * 2)); n0[j] = *(const bf16x8*)kr; n1[j] = *(const bf16x8*)(kr + 64); }
            }
#pragma unroll
            for (int j = 0; j < 4; ++j) {
                const int t = tg + 8 * j;
                f32x4 sc = (f32x4){0.f, 0.f, 0.f, 0.f};
#pragma unroll
                for (int hh = 0; hh < 4; ++hh) { f32x4 acc = MFMA16(a0[j], Bq[hh][0], ((f32x4){0.f, 0.f, 0.f, 0.f})); acc = MFMA16(a1[j], Bq[hh][1], acc);
#pragma unroll
                    for (int r = 0; r < 4; ++r) { const float rl = __builtin_amdgcn_fmed3f(acc[r], 0.f, __builtin_inff()); sc[r] = __builtin_fmaf(sm[hh], rl, sc[r]); } }
                u32x4 kv;
#pragma unroll
                for (int r = 0; r < 4; ++r) { const float oth = __shfl_xor(sc[r], 8);
                    float s = sc[r] + oth; s += 0.0f;
                    const unsigned u = __float_as_uint(s); kv[r] = u ^ ((unsigned)((int)u >> 31) | 0x80000000u); }
                if (16 * t + 15 > i0) {
#pragma unroll
                    for (int r = 0; r < 4; ++r) kv[r] = (16 * t + 4 * kq + r <= i0 + q) ? kv[r] : 0u;
                }
                if (hg == 0 && t < nt16) *(LAS u32x4*)(keys + q * DS_KSTR + 16 * t + 4 * kq) = kv;
            }
        }
    }
    WAITL_BAR();
    const int qi = i0 + wid, nq = qi + 1;
    LAS unsigned short* list = (LAS unsigned short*)(l3 + DS_LIST) + wid * 320;
    int cnt = 0;
    {
        LAS unsigned* myk = keys + wid * DS_KSTR;
        unsigned kreg[64];
#pragma unroll
        for (int blk = 0; blk < 8; ++blk) {
            if (blk < nblk) {
#pragma unroll
                for (int i = 8 * blk; i < 8 * blk + 8; ++i) kreg[i] = myk[64 * i + lane];
            } else {
#pragma unroll
                for (int i = 8 * blk; i < 8 * blk + 8; ++i) kreg[i] = 0u;
            }
        }
        unsigned T = 0u; int need = 0;
        if (nq > 256) {
            asm volatile("s_waitcnt lgkmcnt(0)" ::: "memory");
            constexpr int TB = 10, SH = 32 - TB;
            unsigned d0 = 0u; int cabove = 0;
#pragma unroll 1
            for (int bit = TB - 1; bit >= 0; --bit) {
                const unsigned cand = d0 | (1u << bit), lim = cand << SH; int c = 0;
#pragma unroll
                for (int blk = 0; blk < 8; ++blk) {
                    if (blk < nblk) {
                        unsigned long long bm[8];
#pragma unroll
                        for (int j = 0; j < 8; ++j) bm[j] = __ballot(kreg[8 * blk + j] >= lim);
#pragma unroll
                        for (int j = 0; j < 8; ++j) c += __popcll(bm[j]);
                    }
                }
                if (c >= 256) d0 = cand; else cabove = c;
            }
            int remaining = 256 - cabove;
            int ncand = 0;
#pragma unroll
            for (int blk = 0; blk < 8; ++blk) {
                if (blk < nblk) {
                    unsigned long long bm[8]; int off[8];
#pragma unroll
                    for (int j = 0; j < 8; ++j) bm[j] = __ballot((kreg[8 * blk + j] >> SH) == d0);
                    __builtin_amdgcn_sched_barrier(0);
#pragma unroll
                    for (int j = 0; j < 8; ++j) { off[j] = ncand; ncand += __popcll(bm[j]); }
                    __builtin_amdgcn_sched_barrier(0);
#pragma unroll
                    for (int j = 0; j < 8; ++j) { const unsigned k = kreg[8 * blk + j];
                        const int pos = (int)__builtin_amdgcn_mbcnt_hi((unsigned)(bm[j] >> 32), __builtin_amdgcn_mbcnt_lo((unsigned)bm[j], (unsigned)off[j]));
                        myk[((k >> SH) == d0) ? pos : 4099] = k; }
                    __builtin_amdgcn_sched_barrier(0);
                }
            }
            LAS unsigned* hist = (LAS unsigned*)(l3 + DS_HIST) + wid * 256;
            unsigned prefix = d0 << SH, msk = ~0u << SH;
#pragma unroll 1
            for (int pass = 0; pass < 3; ++pass) {
                const int shift = (pass == 0) ? 14 : (pass == 1) ? 6 : 0; const unsigned dm = (pass == 2) ? 63u : 255u;
                *(LAS u32x4*)(hist + 4 * lane) = (u32x4){0u, 0u, 0u, 0u};
                asm volatile("s_waitcnt lgkmcnt(0)" ::: "memory");
                for (int j = lane; j < ncand; j += 64) { const unsigned k = myk[j];
                    if ((k & msk) == prefix) __hip_atomic_fetch_add(hist + ((k >> shift) & dm), 1u, __ATOMIC_RELAXED, __HIP_MEMORY_SCOPE_WAVEFRONT); }
                asm volatile("s_waitcnt lgkmcnt(0)" ::: "memory");
                const u32x4 hv2 = *(const LAS u32x4*)(hist + 4 * lane);
                const int digit = pick_digit(hv2, remaining, lane);
                prefix |= (unsigned)digit << shift; msk |= dm << shift;
            }
            T = prefix; need = remaining;
        }
        int basep = 0;
#pragma unroll
        for (int blk = 0; blk < 8; ++blk) {
            if (blk < nblk) {
                unsigned long long bs[8]; int off[8];
#pragma unroll
                for (int j = 0; j < 8; ++j) bs[j] = __ballot(kreg[8 * blk + j] > T);
                __builtin_amdgcn_sched_barrier(0);
#pragma unroll
                for (int j = 0; j < 8; ++j) { off[j] = basep; basep += __popcll(bs[j]); }
                __builtin_amdgcn_sched_barrier(0);
#pragma unroll
                for (int j = 0; j < 8; ++j) {
                    const int pos = (int)__builtin_amdgcn_mbcnt_hi((unsigned)(bs[j] >> 32), __builtin_amdgcn_mbcnt_lo((unsigned)bs[j], (unsigned)off[j]));
                    list[(kreg[8 * blk + j] > T) ? pos : 319] = (unsigned short)(64 * (8 * blk + j) + lane); }
                __builtin_amdgcn_sched_barrier(0);
            }
        }
        if (nq > 256) {
#pragma unroll
            for (int blk = 0; blk < 8; ++blk) {
                if (blk < nblk) {
                    unsigned long long any = 0ull;
#pragma unroll
                    for (int i = 8 * blk; i < 8 * blk + 8; ++i) any |= __ballot(kreg[i] == T);
                    if (any != 0ull) {
#pragma unroll
                        for (int i = 8 * blk; i < 8 * blk + 8; ++i) {
                            const bool eq = kreg[i] == T;
                            const unsigned long long be = __ballot(eq);
                            const int rank = (int)__builtin_amdgcn_mbcnt_hi((unsigned)(be >> 32), __builtin_amdgcn_mbcnt_lo((unsigned)be, 0u));
                            const bool sel = eq && rank < need;
                            list[sel ? basep + rank : 319] = (unsigned short)(64 * i + lane);
                            int c = __popcll(be); c = c < need ? c : need;
                            basep += c; need -= c;
                        }
                    }
                }
            }
        }
        cnt = basep < 256 ? basep : 256;
        for (int s2 = cnt + lane; s2 < 256; s2 += 64) list[s2] = (unsigned short)0;
    }
    asm volatile("s_waitcnt lgkmcnt(0)" ::: "memory");
    for (int rep3 = 0; rep3 < DSA_REP3; ++rep3)
    {
        const size_t tok = (size_t)b * SEQ + qi; const int hd = c16 & 7;
        bf16x8 Bb[2];
#pragma unroll
        for (int ks = 0; ks < 2; ++ks) Bb[ks] = *(const bf16x8*)(E + tok * EP + C_BQ + hd * 64 + ks * 32 + kq * 8);
        const float slope2 = __builtin_amdgcn_exp2f(-(float)(hd + 1)) * LOG2E;
        LAS unsigned char* vst = l3 + wid * DS_QROW;
        const char* Ebk = (const char*)(KC3 + (size_t)M * 64 + (size_t)b * SEQ * 64) + kq * 16;
        const char* Ebv = (const char*)(KC3 + (size_t)2 * M * 64 + (size_t)b * SEQ * 64) + (lane & 7) * 16;
        u32x4 vreg[8];
#define DS_VLOAD(c4_) do { _Pragma("unroll") for (int it = 0; it < 8; ++it) { const unsigned j_ = list[64 * (c4_) + 8 * it + (lane >> 3)]; \
            vreg[it] = *(const u32x4*)(Ebv + j_ * 128u); } } while (0)
        DS_VLOAD(0);
        f32x4 lg[4][4];
#pragma unroll
        for (int hf = 0; hf < 2; ++hf) {
            bf16x8 ka0[8], ka1[8];
#pragma unroll
            for (int e = 0; e < 8; ++e) { const unsigned j = list[128 * hf + 16 * e + c16];
                const char* kr = Ebk + j * 128u; ka0[e] = *(const bf16x8*)kr; ka1[e] = *(const bf16x8*)(kr + 64); }
#pragma unroll
            for (int e = 0; e < 8; ++e) { const int c4 = 2 * hf + (e >> 2), tt = e & 3;
                f32x4 acc = MFMA16(ka0[e], Bb[0], ((f32x4){0.f, 0.f, 0.f, 0.f})); acc = MFMA16(ka1[e], Bb[1], acc);
                const int s0 = 64 * c4 + 16 * tt + 4 * kq;
                const u32x2 jl = *(const LAS u32x2*)(list + s0);
                const int j0 = jl[0] & 0xffff, j1 = jl[0] >> 16, j2 = jl[1] & 0xffff, j3 = jl[1] >> 16;
                lg[c4][tt][0] = (s0 + 0 < cnt) ? acc[0] + slope2 * (float)(j0 - qi) : -1e30f;
                lg[c4][tt][1] = (s0 + 1 < cnt) ? acc[1] + slope2 * (float)(j1 - qi) : -1e30f;
                lg[c4][tt][2] = (s0 + 2 < cnt) ? acc[2] + slope2 * (float)(j2 - qi) : -1e30f;
                lg[c4][tt][3] = (s0 + 3 < cnt) ? acc[3] + slope2 * (float)(j3 - qi) : -1e30f; }
        }
        float mx = -1e30f;
#pragma unroll
        for (int c4 = 0; c4 < 4; ++c4)
#pragma unroll
            for (int tt = 0; tt < 4; ++tt)
#pragma unroll
                for (int r = 0; r < 4; ++r) mx = fmaxf(mx, lg[c4][tt][r]);
        mx = fmaxf(mx, __shfl_xor(mx, 16)); mx = fmaxf(mx, __shfl_xor(mx, 32));
        float sum = 0.f;
#pragma unroll
        for (int c4 = 0; c4 < 4; ++c4)
#pragma unroll
            for (int tt = 0; tt < 4; ++tt)
#pragma unroll
                for (int r = 0; r < 4; ++r) { const float e = __builtin_amdgcn_exp2f(lg[c4][tt][r] - mx); lg[c4][tt][r] = e; sum += e; }
        sum += __shfl_xor(sum, 16); sum += __shfl_xor(sum, 32);
        const float inv = __builtin_amdgcn_rcpf(sum);
        f32x4 oacc[4];
#pragma unroll
        for (int dt = 0; dt < 4; ++dt) oacc[dt] = (f32x4){0.f, 0.f, 0.f, 0.f};
        const int qp = c16 >> 2, pp4 = c16 & 3;
#pragma unroll
        for (int c4 = 0; c4 < 4; ++c4) {
#pragma unroll
            for (int it = 0; it < 8; ++it) { const int row = 8 * it + (lane >> 3), ch = lane & 7; *(LAS u32x4*)(vst + row * 128 + ((ch ^ (row & 7)) * 16)) = vreg[it]; }
            if (c4 < 3) DS_VLOAD(c4 + 1);
            asm volatile("" ::: "memory");
#pragma unroll
            for (int pp = 0; pp < 2; ++pp) {
                const f32x4 l0 = lg[c4][2 * pp] * inv, l1 = lg[c4][2 * pp + 1] * inv;
                u32x4 pw; pw[0] = cvtpk(l0[0], l0[1]); pw[1] = cvtpk(l0[2], l0[3]); pw[2] = cvtpk(l1[0], l1[1]); pw[3] = cvtpk(l1[2], l1[3]);
                const int rlo = 32 * pp + 4 * kq + qp, rhi = rlo + 16;
#pragma unroll
                for (int dt = 0; dt < 4; ++dt) { const int chunk = 2 * dt + (pp4 >> 1);
                    const s16x4 lo = vtr((lds_cptr)(vst + rlo * 128 + ((chunk ^ (rlo & 7)) * 16) + (pp4 & 1) * 8));
                    const s16x4 hh = vtr((lds_cptr)(vst + rhi * 128 + ((chunk ^ (rhi & 7)) * 16) + (pp4 & 1) * 8));
                    const bf16x8 vf = (bf16x8){lo[0], lo[1], lo[2], lo[3], hh[0], hh[1], hh[2], hh[3]};
                    oacc[dt] = MFMA16(vf, __builtin_bit_cast(bf16x8, pw), oacc[dt]); }
            }
            asm volatile("" ::: "memory");
        }
#undef DS_VLOAD
        if (c16 < 8) {
            bf16_t* yo = Y + tok * D + 512 + hd * 64 + 4 * kq;
#pragma unroll
            for (int dt = 0; dt < 4; ++dt) { u32x2 w; w[0] = cvtpk(oacc[dt][0], oacc[dt][1]); w[1] = cvtpk(oacc[dt][2], oacc[dt][3]); *(u32x2*)(yo + 16 * dt) = w; }
        }
    }
    WAITL_BAR();
}

#define XB_TMO      128
#define XB_XCNT(j)  (256  + 64 * (j))
#define XB_XSUB(j)  (1280 + 64 * (j))
#define XB_XGEN(j)  (2304 + 64 * (j))
#define XB_TOP      3328
#define XB_TOPGEN   3392
#define XCD_BAR_WORDS 3456
#define XB_SPIN_CAP (1u << 18)
__device__ __forceinline__ unsigned xb_ld(unsigned* p)              { return __hip_atomic_load(p, __ATOMIC_RELAXED, __HIP_MEMORY_SCOPE_AGENT); }
__device__ __forceinline__ unsigned xb_add(unsigned* p, unsigned v) { return __hip_atomic_fetch_add(p, v, __ATOMIC_RELAXED, __HIP_MEMORY_SCOPE_AGENT); }
__device__ __forceinline__ unsigned xb_xcc_id() { return (unsigned)__builtin_amdgcn_s_getreg((3 << 11) | 20) & 0xFu; }
#define XB_SPIN(cond, bar) do { unsigned _sp = 0; while (cond) { __builtin_amdgcn_s_sleep(1); \
    if ((++_sp & 255u) == 0u) { if (xb_ld(&(bar)[XB_TMO])) break; if (_sp > XB_SPIN_CAP) { atomicAdd(&(bar)[XB_TMO], 1u); break; } } } } while (0)
struct XcdBarrier { unsigned* bar; unsigned x; volatile LAS unsigned* st; };
__device__ __forceinline__ XcdBarrier xcd_barrier_post(unsigned* bar, volatile LAS unsigned* st) {
    XcdBarrier b; b.bar = bar; b.x = xb_xcc_id(); b.st = st;
    if (threadIdx.x == 0) (void)xb_add(&bar[XB_XCNT(b.x)], 1u);
    return b;
}
__device__ __forceinline__ void xcd_barrier_complete(unsigned* bar, unsigned x, unsigned& nloc, unsigned& nx) {
    const unsigned G = gridDim.x * gridDim.y * gridDim.z;
    unsigned sum, cnt, mine, sp = 0u;
    for (;;) {
        sum = 0u; cnt = 0u; mine = 0u;
#pragma unroll
        for (unsigned j = 0; j < 16; ++j) { const unsigned c = xb_ld(&bar[XB_XCNT(j)]); sum += c; cnt += (c > 0u) ? 1u : 0u; mine = (j == x) ? c : mine; }
        if (sum == G) break;
        __builtin_amdgcn_s_sleep(1);
        if ((++sp & 255u) == 0u) { if (xb_ld(&bar[XB_TMO])) break; if (sp > XB_SPIN_CAP) { atomicAdd(&bar[XB_TMO], 1u); break; } }
    }
    nloc = mine > 0u ? mine : 1u; nx = cnt > 0u ? cnt : 1u;
}
__device__ __forceinline__ void xcd_barrier(const XcdBarrier& b) {
    asm volatile("s_waitcnt vmcnt(0)" ::: "memory");
    __syncthreads();
    if (threadIdx.x == 0) {
        unsigned* bar = b.bar;
        __builtin_amdgcn_s_waitcnt(0);
        unsigned nloc = b.st[0], nx = b.st[1];
        if (nloc == 0u) { xcd_barrier_complete(bar, b.x, nloc, nx); b.st[0] = nloc; b.st[1] = nx; }
        const unsigned old = xb_add(&bar[XB_XSUB(b.x)], 1u);
        const unsigned gen = old / nloc;
        if (old + 1u == (gen + 1u) * nloc) {
            __builtin_amdgcn_fence(__ATOMIC_RELEASE, "agent");
            asm volatile("s_waitcnt vmcnt(0)" ::: "memory");
            const unsigned og = xb_add(&bar[XB_TOP], 1u);
            const unsigned tg = og / nx;
            if (og + 1u == (tg + 1u) * nx) xb_add(&bar[XB_TOPGEN], 1u);
            else XB_SPIN(xb_ld(&bar[XB_TOPGEN]) == tg, bar);
            __builtin_amdgcn_fence(__ATOMIC_ACQUIRE, "agent");
            xb_add(&bar[XB_XGEN(b.x)], 1u);
            asm volatile("s_waitcnt vmcnt(0)" ::: "memory");
        } else {
            XB_SPIN(xb_ld(&bar[XB_XGEN(b.x)]) == gen, bar);
            __builtin_amdgcn_fence(__ATOMIC_ACQUIRE, "agent");
            asm volatile("s_waitcnt vmcnt(0)" ::: "memory");
        }
    }
    __syncthreads();
}

struct Params {
    const float* in[24]; float* out; unsigned char* ws; int ph_lo, ph_hi;
};
constexpr int LDS_BYTES = 163840, MISC_OFF = LDS_BYTES - 512;

__device__ __forceinline__ void tr_item(const float* __restrict__ W, int ldsrc, int ncol0, int nvalid, int K, int k0, bf16_t* __restrict__ WT, LAS float* scr, int lane) {
    const int c = lane & 31;
#pragma unroll 8
    for (int i = 0; i < 32; ++i) { const int kk = 2 * i + (lane >> 5); scr[kk * 33 + c] = (c < nvalid) ? W[(size_t)(k0 + kk) * ldsrc + ncol0 + c] : 0.f; }
    asm volatile("s_waitcnt lgkmcnt(0)" ::: "memory");
    const int c8 = lane & 7;
#pragma unroll
    for (int j = 0; j < 4; ++j) { const int n = (lane >> 3) + 8 * j; const LAS float* s = scr + (8 * c8) * 33 + n;
        u32x4 o; o.x = pk2(s[0 * 33], s[1 * 33]); o.y = pk2(s[2 * 33], s[3 * 33]); o.z = pk2(s[4 * 33], s[5 * 33]); o.w = pk2(s[6 * 33], s[7 * 33]);
        *(u32x4*)(WT + (size_t)n * K + k0 + 8 * c8) = o; }
    asm volatile("s_waitcnt lgkmcnt(0)" ::: "memory");
}

__device__ __forceinline__ void phase_prologue(const Params& p, unsigned char* lds, int G) {
    int tid_ = threadIdx.x; asm volatile("" : "+v"(tid_));
    const int tid = tid_, lane = tid & 63; const int wid = __builtin_amdgcn_readfirstlane(tid >> 6);
    LAS unsigned char* l3 = (LAS unsigned char*)lds;
    {
        LAS float* sc = (LAS float*)l3; LAS float* part = (LAS float*)(l3 + 16384);
        const float* c = p.in[1]; const float* ada_w = p.in[2]; const float* ada_b = p.in[3]; float* mod = (float*)(p.ws + WS_MOD);
        if ((int)blockIdx.x < 192) {
            for (int i = tid; i < 4096; i += 512) { const float v = c[i]; sc[i] = v / (1.f + expf(-v)); }
            __syncthreads();
            for (int item = blockIdx.x; item < 192; item += G) {
                const int l = item / 96, n0 = (item % 96) * 64;
                const float* W = ada_w + (size_t)l * 1024 * MODN + n0 + lane;
                float a0 = 0.f, a1 = 0.f, a2 = 0.f, a3 = 0.f;
#pragma unroll 8
                for (int k = wid * 128; k < wid * 128 + 128; ++k) { const float wv = W[(size_t)k * MODN]; a0 += sc[k] * wv; a1 += sc[1024 + k] * wv; a2 += sc[2048 + k] * wv; a3 += sc[3072 + k] * wv; }
                part[(wid * 4 + 0) * 64 + lane] = a0; part[(wid * 4 + 1) * 64 + lane] = a1; part[(wid * 4 + 2) * 64 + lane] = a2; part[(wid * 4 + 3) * 64 + lane] = a3;
                __syncthreads();
                if (tid < 256) { const int b = tid >> 6, col = tid & 63; float s = 0.f;
#pragma unroll
                    for (int ww = 0; ww < 8; ++ww) s += part[(ww * 4 + b) * 64 + col];
                    mod[(size_t)(l * 4 + b) * MODN + n0 + col] = s + ada_b[l * MODN + n0 + col]; }
                __syncthreads();
            }
        }
        __syncthreads();
    }
    LAS float* scr = (LAS float*)(l3 + wid * 16384);
    const int gw = blockIdx.x * 8 + wid, NGW = G * 8;
    constexpr int I0 = 88 * 16, I1 = 2 * 32 * 16, I2 = 2 * 176 * 16, I3 = 2 * 32 * 44, I4 = 48 * 16, NIT = I0 + I1 + I2 + I3 + I4;
    for (int it = gw; it < NIT; it += NGW) {
        int r = it;
        if (r < I0) { const int g = r / 16, kb = r % 16; int nv = ECOLS - 32 * g; nv = nv < 0 ? 0 : (nv > 32 ? 32 : nv);
            tr_item(p.in[10], ECOLS, 32 * g, nv, D, 64 * kb, (bf16_t*)(p.ws + WS_WIN0) + (size_t)(32 * g) * D, scr, lane); continue; }
        r -= I0;
        if (r < I1) { const int l = r / 512, g = (r % 512) / 16, kb = r % 16;
            tr_item(p.in[6] + (size_t)l * D * D, D, 32 * g, 32, D, 64 * kb, (bf16_t*)(p.ws + WS_WOUT) + (size_t)l * D * D + (size_t)(32 * g) * D, scr, lane); continue; }
        r -= I1;
        if (r < I2) { const int l = r / (176 * 16), g = (r % (176 * 16)) / 16, kb = r % 16; const int tile = g >> 3, cg = g & 7;
            const float* src = (cg < 4 ? p.in[7] : p.in[8]) + (size_t)l * D * FF;
            tr_item(src, FF, tile * 128 + (cg & 3) * 32, 32, D, 64 * kb, (bf16_t*)(p.ws + WS_WGU) + (size_t)l * GU * D + (size_t)(32 * g) * D, scr, lane); continue; }
        r -= I2;
        if (r < I3) { const int l = r / (32 * 44), g = (r % (32 * 44)) / 44, kb = r % 44;
            tr_item(p.in[9] + (size_t)l * FF * D, D, 32 * g, 32, FF, 64 * kb, (bf16_t*)(p.ws + WS_WDN) + (size_t)l * D * FF + (size_t)(32 * g) * FF, scr, lane); continue; }
        r -= I3;
        { const int g = r / 16, kb = r % 16;
            tr_item(p.in[20], OP, 32 * g, 32, D, 64 * kb, (bf16_t*)(p.ws + WS_WIN1) + (size_t)(32 * g) * D, scr, lane); }
    }
}

__device__ __forceinline__ void phase_norm(const float* __restrict__ x, const float* __restrict__ gain, const float* __restrict__ modl, int sh_off, int sc_off, bf16_t* __restrict__ XN, int G) {
    int tid_ = threadIdx.x; asm volatile("" : "+v"(tid_));
    const int lane = tid_ & 63; const int gw = blockIdx.x * 8 + (tid_ >> 6), NGW = G * 8;
    for (int row = gw; row < M; row += NGW) {
        const int b = row / SEQ;
        const f32x4* xr = (const f32x4*)(x + (size_t)row * D);
        f32x4 v[4]; float s = 0.f;
#pragma unroll
        for (int j = 0; j < 4; ++j) { v[j] = xr[64 * j + lane]; s += v[j][0] * v[j][0] + v[j][1] * v[j][1] + v[j][2] * v[j][2] + v[j][3] * v[j][3]; }
        s = wave_sum(s);
        const float r = __builtin_amdgcn_rsqf(s * (1.f / D) + EPS);
        const float* mb = modl + (size_t)b * MODN;
#pragma unroll
        for (int j = 0; j < 4; ++j) {
            const int col = 4 * (64 * j + lane);
            const f32x4 g = *(const f32x4*)(gain + col), scv = *(const f32x4*)(mb + sc_off + col), shv = *(const f32x4*)(mb + sh_off + col);
            const f32x4 y = v[j] * r * g * (1.f + scv) + shv;
            u32x2 o; o[0] = pk2(y[0], y[1]); o[1] = pk2(y[2], y[3]);
            *(u32x2*)(XN + (size_t)row * D + col) = o;
        }
    }
}

__device__ __forceinline__ void phase_post0(bf16_t* E, bf16_t* __restrict__ KC3, unsigned* __restrict__ SGN, const float* __restrict__ qn_a, const float* __restrict__ kn_a, const float* __restrict__ qn_b, const float* __restrict__ kn_b, int G) {
    int tid_ = threadIdx.x; asm volatile("" : "+v"(tid_));
    const int lane = tid_ & 63; const int gw = blockIdx.x * 8 + (tid_ >> 6), NGW = G * 8;
    const int sub = (lane & 7) * 8;
    for (int row = gw; row < M; row += NGW) {
        bf16_t* e = E + (size_t)row * EP;
        float w[8]; unsigned sgn = 0;
        { const u32x4 wr_ = *(const u32x4*)(e + C_IW);
          w[0] = __uint_as_float(wr_[0] << 16); w[1] = __uint_as_float(wr_[0] & 0xffff0000u); w[2] = __uint_as_float(wr_[1] << 16); w[3] = __uint_as_float(wr_[1] & 0xffff0000u);
          w[4] = __uint_as_float(wr_[2] << 16); w[5] = __uint_as_float(wr_[2] & 0xffff0000u); w[6] = __uint_as_float(wr_[3] << 16); w[7] = __uint_as_float(wr_[3] & 0xffff0000u); }
#pragma unroll
        for (int h = 0; h < 8; ++h) if (w[h] < 0.f) sgn |= 1u << h;
        if (lane == 0) SGN[row] = sgn;
#pragma unroll 1
        for (int it = 0; it < 6; ++it) {
            const int grp = it * 8 + (lane >> 3), col = grp * 64 + sub;
            const bool act = grp < 43;
            const u32x4 raw = act ? *(const u32x4*)(e + col) : (u32x4){0u, 0u, 0u, 0u};
            float v[8];
#pragma unroll
            for (int k = 0; k < 4; ++k) { v[2 * k] = __uint_as_float(raw[k] << 16); v[2 * k + 1] = __uint_as_float(raw[k] & 0xffff0000u); }
            float ss = 0.f;
#pragma unroll
            for (int i = 0; i < 8; ++i) ss += v[i] * v[i];
            ss += __shfl_xor(ss, 1); ss += __shfl_xor(ss, 2); ss += __shfl_xor(ss, 4);
            const float r = __builtin_amdgcn_rsqf(ss * (1.f / 64.f) + EPS);
            const float* gp = nullptr; float scale = 1.f; bool wrt = false;
            if (grp < 8) { gp = qn_a; scale = r * QS; wrt = true; }
            else if (grp < 16) { gp = kn_a; scale = r; wrt = true; }
            else if (grp < 24) { }
            else if (grp < 32) { gp = qn_b; scale = r * QS; wrt = true; }
            else if (grp == 32) { gp = kn_b; scale = r; wrt = true; }
            else if (grp == 33) { }
            else if (grp < 42) { float wsel = 0.f;
#pragma unroll
                for (int h = 0; h < 8; ++h) wsel = (grp - 34 == h) ? w[h] : wsel;
                scale = fabsf(wsel) * IS; wrt = true; }
            if (grp == 33) *(u32x4*)(KC3 + (size_t)2 * M * 64 + (size_t)row * 64 + sub) = raw;
            if (grp == 42) *(u32x4*)(KC3 + (size_t)row * 64 + sub) = raw;
            if (act && wrt) {
                u32x4 ov;
#pragma unroll
                for (int k = 0; k < 4; ++k) ov[k] = pk2(v[2 * k] * scale * (gp ? gp[sub + 2 * k] : 1.f), v[2 * k + 1] * scale * (gp ? gp[sub + 2 * k + 1] : 1.f));
                *(u32x4*)(e + col) = ov;
                if (grp == 32) *(u32x4*)(KC3 + (size_t)M * 64 + (size_t)row * 64 + sub) = ov;
            }
        }
    }
}

__device__ __forceinline__ void phase_bias(const unsigned char* ws, unsigned char* lds, int G) {
    int tid_ = threadIdx.x; asm volatile("" : "+v"(tid_));
    const int lane = tid_ & 63; const int gw = blockIdx.x * 8 + (tid_ >> 6), NGW = G * 8;
    LAS float* scr = (LAS float*)((LAS unsigned char*)lds) + (tid_ >> 6) * 256;
    const float* mod = (const float*)(ws + WS_MOD); bf16_t* bias = (bf16_t*)(ws + WS_BIAS);
    constexpr int N1 = OP, NT_ = OP + 2 * GU;
    for (int r = gw; r < NT_; r += NGW) {
        const bf16_t* wrow; const float* sh; bf16_t* dst; int nb;
        if (r < N1) { wrow = (const bf16_t*)(ws + WS_WIN1) + (size_t)r * D; sh = mod + (size_t)4 * MODN + 0; dst = bias + r; nb = OP; }
        else { const int l = (r - N1) / GU, n = (r - N1) % GU; wrow = (const bf16_t*)(ws + WS_WGU) + (size_t)l * GU * D + (size_t)n * D; sh = mod + (size_t)l * 4 * MODN + 3072; dst = bias + 4 * OP + (size_t)l * 4 * GU + n; nb = GU; }
        const u32x4 w0 = *(const u32x4*)(wrow + lane * 16), w1 = *(const u32x4*)(wrow + lane * 16 + 8);
        float wv[16];
#pragma unroll
        for (int k = 0; k < 4; ++k) { wv[2 * k] = __uint_as_float(w0[k] << 16); wv[2 * k + 1] = __uint_as_float(w0[k] & 0xffff0000u); wv[8 + 2 * k] = __uint_as_float(w1[k] << 16); wv[8 + 2 * k + 1] = __uint_as_float(w1[k] & 0xffff0000u); }
        float a4[4];
#pragma unroll
        for (int bb = 0; bb < 4; ++bb) { const float* sp = sh + (size_t)bb * MODN + lane * 16; float a = 0.f;
#pragma unroll
            for (int k4 = 0; k4 < 4; ++k4) { const f32x4 sv = *(const f32x4*)(sp + 4 * k4); a += sv[0] * wv[4 * k4] + sv[1] * wv[4 * k4 + 1] + sv[2] * wv[4 * k4 + 2] + sv[3] * wv[4 * k4 + 3]; }
            a4[bb] = a; }
#pragma unroll
        for (int bb = 0; bb < 4; ++bb) scr[bb * 64 + lane] = a4[bb];
        const f32x4 pv = *(const LAS f32x4*)(scr + (lane >> 4) * 64 + (lane & 15) * 4);
        float t = (pv[0] + pv[1]) + (pv[2] + pv[3]);
        t += __shfl_xor(t, 1); t += __shfl_xor(t, 2); t += __shfl_xor(t, 4); t += __shfl_xor(t, 8);
        if ((lane & 15) == 0) dst[(size_t)(lane >> 4) * nb] = f2bf(t);
    }
}

__global__ void __launch_bounds__(512, 2) mega_fwd(Params p) {
    extern __shared__ __attribute__((aligned(16))) unsigned char lds[];
    const int tid = threadIdx.x, lane = tid & 63; const int wid = __builtin_amdgcn_readfirstlane(tid >> 6);
    const int G = gridDim.x, cb = blockIdx.x;
    LAS unsigned char* l3 = (LAS unsigned char*)lds;
    volatile LAS unsigned* MISC = (volatile LAS unsigned*)(l3 + MISC_OFF);
    if (tid < 128) MISC[tid] = 0u;
    __syncthreads();
    unsigned* ctl = (unsigned*)(p.ws + WS_CTL);
    const bool multi = (p.ph_hi - p.ph_lo) > 1;
    XcdBarrier bar; bar.bar = ctl + 1024; bar.x = 0; bar.st = nullptr;
    if (multi) bar = xcd_barrier_post(ctl + 1024, MISC + 8);
    const float* x = p.in[0]; float* out = p.out;

    for (int ph = p.ph_lo; ph < p.ph_hi; ++ph) {
        GAS unsigned char* wsg_ = (GAS unsigned char*)p.ws; asm volatile("" : "+s"(wsg_)); unsigned char* ws = (unsigned char*)wsg_;
        int lane_o = tid; asm volatile("" : "+v"(lane_o)); lane_o &= 63;
        float* mod = (float*)(ws + WS_MOD); unsigned* SGN = (unsigned*)(ws + WS_SGN);
        bf16_t* XN = (bf16_t*)(ws + WS_XN); bf16_t* Yb = (bf16_t*)(ws + WS_Y); bf16_t* E = (bf16_t*)(ws + WS_E);
        const int l = ph >= 8 ? 1 : 0;
        int kind;
        { const int tab[13] = {0, 1, 2, 3, 4, 5, 7, 8, 2, 9, 5, 7, 8}; kind = tab[ph]; }
        float* SSQ0 = (float*)(ws + WS_SSQ); const bf16_t* BIAS = (const bf16_t*)(ws + WS_BIAS);
        const float* modl = mod + (size_t)l * 4 * MODN;
        if (kind == 0) phase_prologue(p, lds, G);
        else if (kind == 1) { phase_norm(x, p.in[4], modl, 0, 1024, XN, G); phase_bias(ws, lds, G); }
        else if (kind == 2) {
            pg8::Gemm g{XN, (const bf16_t*)(ws + (l == 0 ? WS_WIN0 : WS_WIN1)), M, l == 0 ? EP : OP, D};
            pg8::StaticOrder S; S.init(M, g.N, G, cb);
            if (l == 0) { pg8::EpiRawBf16 Ep{E, g.N}; pg8::gemm_phase<pg8::EpiRawBf16, pg8::StaticOrder, true, true>(l3, g, S, Ep); }
            else { pg8::EpiRawBf16S Ep{E, OP, SSQ0 + M, BIAS, OP}; pg8::gemm_phase<pg8::EpiRawBf16S, pg8::StaticOrder, true, true>(l3, g, S, Ep); }
        }
        else if (kind == 3) phase_post0(E, (bf16_t*)(ws + WS_IKC), SGN, p.in[11], p.in[12], p.in[18], p.in[19], G);
        else if (kind == 4) {
            const float t1 = wave_sum(p.in[13][lane_o] * p.in[14][lane_o]), t2 = wave_sum(p.in[15][lane_o] * p.in[16][lane_o]);
            const float lam = expf(t1) - expf(t2) + 0.2f;
            const float gq = wave_max(fabsf(p.in[11][lane_o])), gk = wave_max(fabsf(p.in[12][lane_o]));
            const float cut = 2.f * (8.f * gq * gk * 1.03f) + 30.f;
            unsigned* qctr = ctl + 64;
            if (tid == 0) MISC[16] = atomicAdd(qctr, 1u);
            __syncthreads();
            int item = (int)MISC[16];
            while (item < 512 + 2048) {
                unsigned nxt = 0u;
                if (tid == 0) nxt = atomicAdd(qctr, 1u);
                if (item < 512) {
                    const int hh = 3 - (item >> 7), r_ = item & 127, qb = 31 - (r_ >> 2), bb = r_ & 3;
                    const float dh = cut * __builtin_amdgcn_exp2f(2.f * (float)(hh + 1));
                    int t0 = (int)floorf(((float)(128 * qb) - dh) * (1.f / 64.f)); t0 = t0 < 0 ? 0 : t0;
                    attnA_unit(bb, hh, qb, t0, E, Yb, lam, p.in[17], lds);
                } else {
                    const int k = item - 512, bb = k & 3, ib = 511 - (k >> 2);
                    dsa_unit(bb, ib * 8, E, (const bf16_t*)(ws + WS_IKC), SGN, Yb, lds);
                }
                if (tid == 0) MISC[16] = nxt;
                __syncthreads();
                item = (int)MISC[16];
            }
        }
        else if (kind == 9) {
            for (int u = cb; u < 512; u += G) { const int bk = u & 15, nb = (u >> 4) & 31;
                swa_unit(bk >> 2, bk & 3, nb, E, Yb, p.in[21], p.in[22], p.in[23], lds); }
        }
        else if (kind == 5 || kind == 8) {
            const bool dn = (kind == 8);
            pg8::Gemm g{dn ? E : Yb, (const bf16_t*)(ws + (dn ? WS_WDN : WS_WOUT)) + (size_t)l * (dn ? D * FF : D * D), M, D, dn ? FF : D};
            pg8::StaticOrder S; S.init(M, D, G, cb);
            const bool last = dn && l == 1;
            const float* ngain = dn ? p.in[4] + D : p.in[5] + l * D;
            const float* nsc = dn ? mod + (size_t)4 * MODN + 1024 : modl + 4096;
            const bool first = (kind == 5 && l == 0);
            void* R = (void*)(ws + WS_R);
            pg8::EpiResGateN Ep{first ? (const void*)x : (const void*)R, last ? (void*)out : R, first ? 0 : 1, last ? 0 : 1,
                                modl + (dn ? 5120 : 2048), last ? nullptr : XN, ngain, nsc, SSQ0 + (size_t)(dn ? 1 : (l == 0 ? 0 : 2)) * M, l3};
            pg8::gemm_phase<pg8::EpiResGateN, pg8::StaticOrder, true, true>(l3, g, S, Ep);
        }
        else if (kind == 7) {
            pg8::Gemm g{XN, (const bf16_t*)(ws + WS_WGU) + (size_t)l * GU * D, M, GU, D};
            pg8::StaticOrder S; S.init(M, GU, G, cb);
            pg8::EpiSwigluS Ep{E, SSQ0 + (size_t)(l == 0 ? 0 : 2) * M, BIAS + 4 * OP + (size_t)l * 4 * GU};
            pg8::gemm_phase<pg8::EpiSwigluS, pg8::StaticOrder, true, true>(l3, g, S, Ep);
        }
        if (ph + 1 < p.ph_hi) xcd_barrier(bar);
    }
}

#ifndef MK_SPLIT
#define MK_SPLIT 0
#endif
extern "C" void kernel_launch(void* const* d_in, const int* in_sizes, int n_in, void* d_out, int out_size, void* d_ws, size_t ws_size, hipStream_t stream) {
    static int grid = 0;
    if (grid == 0) {
        int dev = 0, cus = 0, per_cu = 0;
        if (hipGetDevice(&dev) != hipSuccess || hipDeviceGetAttribute(&cus, hipDeviceAttributeMultiprocessorCount, dev) != hipSuccess) { fprintf(stderr, "kernel_launch: device query failed\n"); grid = -1; return; }
        if (hipFuncSetAttribute((const void*)mega_fwd, hipFuncAttributeMaxDynamicSharedMemorySize, LDS_BYTES) != hipSuccess) { fprintf(stderr, "kernel_launch: hipFuncSetAttribute failed\n"); grid = -1; return; }
        if (hipOccupancyMaxActiveBlocksPerMultiprocessor(&per_cu, (const void*)mega_fwd, 512, LDS_BYTES) != hipSuccess || per_cu < 1) { fprintf(stderr, "kernel_launch: occupancy query says %d\n", per_cu); (void)hipGetLastError(); per_cu = 1; }
        grid = cus;
    }
    if (grid < 0) return;
    (void)hipMemsetAsync((char*)d_ws + WS_CTL, 0, CTL_ZERO_BYTES, stream);
    Params p{};
    for (int i = 0; i < 24; ++i) p.in[i] = (const float*)d_in[i];
    p.out = (float*)d_out; p.ws = (unsigned char*)d_ws;
#if MK_SPLIT
    for (int ph = 0; ph < 13; ++ph) { p.ph_lo = ph; p.ph_hi = ph + 1; hipLaunchKernelGGL(mega_fwd, dim3(grid), dim3(512), LDS_BYTES, stream, p); }
#else
    p.ph_lo = 0; p.ph_hi = 13;
    void* args[] = {&p};
    hipError_t e = hipLaunchCooperativeKernel((const void*)mega_fwd, dim3(grid), dim3(512), args, LDS_BYTES, stream);
    if (e != hipSuccess) fprintf(stderr, "kernel_launch: cooperative launch failed: %s\n", hipGetErrorString(e));
#endif
}
```

```cpp
#include <hip/hip_runtime.h>
#include <cstdio>
#include <stdint.h>

#define LAS __attribute__((address_space(3)))
#define GAS __attribute__((address_space(1)))
typedef unsigned short bf16_t;
typedef short bf16x8 __attribute__((ext_vector_type(8)));
typedef short s16x4 __attribute__((ext_vector_type(4)));
typedef short v4i16_t __attribute__((ext_vector_type(4)));
typedef float f32x4 __attribute__((ext_vector_type(4)));
typedef float f32x16 __attribute__((ext_vector_type(16)));
typedef unsigned u32x4 __attribute__((ext_vector_type(4)));
typedef unsigned u32x2 __attribute__((ext_vector_type(2)));
typedef float f32x2_t __attribute__((ext_vector_type(2)));
typedef __bf16 bf16x2_t __attribute__((ext_vector_type(2)));
typedef LAS const char* lds_cptr;

constexpr int D = 1024, BATCH = 4, SEQ = 4096, M = BATCH * SEQ, FF = 2816, ECOLS = 2760, EP = 2816, OP = 1536, MODN = 6144, GU = 2 * FF;
constexpr float LOG2E = 1.4426950408889634f;
constexpr float QS = 0.125f * LOG2E;
constexpr float IS = 0.125f * 0.35355339059327373f;
constexpr float EPS = 1e-6f;
constexpr int C_AQ = 0, C_AK = 512, C_AV = 1024, C_BQ = 1536, C_BK = 2048, C_BV = 2112, C_IQ = 2176, C_IK = 2688, C_IW = 2752;
constexpr int C1_Q = 0, C1_K = 1024, C1_V = 1280;

constexpr size_t MiB = 1u << 20;
constexpr size_t WS_CTL = 0, CTL_ZERO_BYTES = 256 * 1024;
constexpr size_t WS_MOD = 1 * MiB, WS_SGN = 1 * MiB + 512 * 1024;
constexpr size_t WS_SSQ = 64 * 1024;
constexpr size_t WS_BIAS = 1 * MiB + 256 * 1024;
constexpr size_t WS_WIN0 = 2 * MiB;
constexpr size_t WS_WOUT = 8 * MiB;
constexpr size_t WS_WGU = 12 * MiB;
constexpr size_t WS_WDN = 34 * MiB;
constexpr size_t WS_WIN1 = 45 * MiB;
constexpr size_t WS_XN = 50 * MiB, WS_Y = 82 * MiB, WS_E = 114 * MiB, WS_END = 202 * MiB;
constexpr size_t WS_IKC = 202 * MiB, WS_BKC = 204 * MiB, WS_BVC = 206 * MiB;
constexpr size_t WS_R = 208 * MiB;

__device__ __forceinline__ float bf2f(bf16_t v) { return __uint_as_float((unsigned)v << 16); }
__device__ __forceinline__ bf16_t f2bf(float f) { unsigned u = __float_as_uint(f); return (bf16_t)((u + 0x7fffu + ((u >> 16) & 1u)) >> 16); }
__device__ __forceinline__ unsigned pk2(float lo, float hi) { return (unsigned)f2bf(lo) | ((unsigned)f2bf(hi) << 16); }
__device__ __forceinline__ unsigned cvtpk(float lo, float hi) { f32x2_t v = {lo, hi}; bf16x2_t b = __builtin_convertvector(v, bf16x2_t); return __builtin_bit_cast(unsigned, b); }
__device__ __forceinline__ float wave_sum(float v) {
#pragma unroll
    for (int o = 1; o < 64; o <<= 1) v += __shfl_xor(v, o);
    return v;
}
__device__ __forceinline__ float wave_max(float v) {
#pragma unroll
    for (int o = 1; o < 64; o <<= 1) v = fmaxf(v, __shfl_xor(v, o));
    return v;
}
__device__ __forceinline__ int crow(int r, int hi) { return (r & 3) + 8 * (r >> 2) + 4 * hi; }
__device__ __forceinline__ float xhalf_max(float m) { auto rr = __builtin_amdgcn_permlane32_swap(__float_as_uint(m), __float_as_uint(m), false, false); return fmaxf(__uint_as_float(rr[0]), __uint_as_float(rr[1])); }
__device__ __forceinline__ float xhalf_sum(float m) { auto rr = __builtin_amdgcn_permlane32_swap(__float_as_uint(m), __float_as_uint(m), false, false); return __uint_as_float(rr[0]) + __uint_as_float(rr[1]); }
__device__ __forceinline__ void glds16(const void* gsrc, unsigned lds_dst) { unsigned keep;
    asm volatile("s_mov_b32 %0, m0\n\ts_mov_b32 m0, %2\n\ts_nop 0\n\tglobal_load_lds_dwordx4 %1, off\n\ts_mov_b32 m0, %0" : "=&s"(keep) : "v"(gsrc), "s"(lds_dst) : "memory"); }
__device__ __forceinline__ s16x4 vtr(lds_cptr p) { return __builtin_bit_cast(s16x4, __builtin_amdgcn_ds_read_tr16_b64_v4i16((LAS v4i16_t*)p)); }
#define WAITV_BAR() asm volatile("s_waitcnt vmcnt(0) lgkmcnt(0)\n\ts_barrier" ::: "memory")
#define WAITL_BAR() asm volatile("s_waitcnt lgkmcnt(0)\n\ts_barrier" ::: "memory")

namespace pg8 {
constexpr int BM = 256, BK = 64, HALF = 128, HTB = HALF * BK * 2, STAGE_BYTES = 8 * HTB, NXCD = 8, WGM = 8;
__host__ __device__ __forceinline__ int lds_byte(int r, int c) { const int st = (r >> 4) * 2 + (c >> 5), rr = r & 15, cc = c & 31, ob = rr * 64 + cc * 2; return st * 1024 + (ob ^ (((ob >> 9) & 1) << 5)); }
__host__ __device__ __forceinline__ void stage_rc(int b, int& R, int& C) { const int st = b / 1024, sb = b % 1024, swz = sb ^ (((sb >> 9) & 1) << 5); R = (st >> 1) * 16 + swz / 64; C = (st & 1) * 32 + (swz % 64) / 2; }
__host__ __device__ __forceinline__ int perm32(int rho) { const int n = rho >> 4, i = rho & 15; return 8 * (i >> 2) + 4 * n + (i & 3); }
struct Unit { int pm, pn; };
struct Gemm { const bf16_t* A; const bf16_t* Bt; int M, N, K; };
struct StaticOrder {
    int nM, nN, nwg, G, c;
    __host__ __device__ void init(int M_, int N_, int G_, int c_) { nM = M_ / BM; nN = N_ / BM; nwg = nM * nN; G = G_; c = c_; }
    __host__ __device__ bool next(int i, Unit& u) const {
        const long L = (long)i * G + c; if (L >= nwg) return false;
        int wgid = (int)L; { const int q = nwg / NXCD, r = nwg % NXCD, xcd = wgid % NXCD, off = wgid / NXCD; wgid = (xcd < r ? xcd * (q + 1) : r * (q + 1) + (xcd - r) * q) + off; }
        const int nig = WGM * nN, gid = wgid / nig, fm = gid * WGM, gsz = (nM - fm) < WGM ? (nM - fm) : WGM;
        u.pm = fm + ((wgid % nig) % gsz); u.pn = (wgid % nig) / gsz; return true;
    }
    __device__ __forceinline__ void a_ready(const Unit&) const {}
    __device__ __forceinline__ void done(const Unit&) const {}
};
__device__ __forceinline__ unsigned cvt_pk_bf16(float lo, float hi) { unsigned r; asm volatile("v_cvt_pk_bf16_f32 %0, %1, %2" : "=v"(r) : "v"(lo), "v"(hi)); return r; }

struct NoPre {};
struct EpiRawBf16 {
    static constexpr bool PERM = true, AFTER_DRAIN = false; typedef NoPre Pre;
    __device__ __forceinline__ Pre pre(const Unit&, int, int, int, int) const { return Pre{}; }
    bf16_t* O; int ldc;
    __device__ __forceinline__ void operator()(const f32x4 (&acc)[2][2][4][2], const Unit& u, const Pre&, int wr, int wc, int fr, int fq) const {
        const int row0 = u.pm * BM + wr * 64 + fr, col0 = u.pn * BM + wc * 32 + 8 * fq;
#pragma unroll
        for (int ai = 0; ai < 2; ++ai)
#pragma unroll
            for (int m = 0; m < 4; ++m) { bf16_t* rowp = O + (size_t)(row0 + ai * HALF + m * 16) * ldc + col0;
#pragma unroll
                for (int bj = 0; bj < 2; ++bj) { const f32x4 v0 = acc[ai][bj][m][0], v1 = acc[ai][bj][m][1];
                    u32x4 w; w.x = cvt_pk_bf16(v0[0], v0[1]); w.y = cvt_pk_bf16(v0[2], v0[3]); w.z = cvt_pk_bf16(v1[0], v1[1]); w.w = cvt_pk_bf16(v1[2], v1[3]);
                    *(u32x4*)(rowp + bj * HALF) = w; } }
    }
};
struct EpiResGateN {
    static constexpr bool PERM = true, AFTER_DRAIN = false; typedef NoPre Pre;
    __device__ __forceinline__ Pre pre(const Unit&, int, int, int, int) const { return Pre{}; }
    const void* base; void* out; int base_bf16, out_bf16;
    const float* gate; bf16_t* XA; const float* gain; const float* scn; float* SSQ; LAS unsigned char* lds;
    __device__ __forceinline__ void operator()(const f32x4 (&acc)[2][2][4][2], const Unit& u, const Pre&, int wr, int wc, int fr, int fq) const {
        const int row0 = u.pm * BM + wr * 64 + fr, col0 = u.pn * BM + wc * 32 + 8 * fq, b = (u.pm * BM) / SEQ;
        f32x4 g[2][2], gs[2][2];
#pragma unroll
        for (int bj = 0; bj < 2; ++bj)
#pragma unroll
            for (int n = 0; n < 2; ++n) { g[bj][n] = *(const f32x4*)(gate + (size_t)b * MODN + col0 + bj * HALF + 4 * n);
                if (XA) gs[bj][n] = *(const f32x4*)(gain + col0 + bj * HALF + 4 * n) * (1.f + *(const f32x4*)(scn + (size_t)b * MODN + col0 + bj * HALF + 4 * n)); }
        LAS float* part = (LAS float*)(lds + 131072);
#pragma unroll
        for (int ai = 0; ai < 2; ++ai)
#pragma unroll
            for (int m = 0; m < 4; ++m) { const size_t off = (size_t)(row0 + ai * HALF + m * 16) * D + col0; float ss = 0.f;
#pragma unroll
                for (int bj = 0; bj < 2; ++bj) { f32x4 o[2];
                    if (base_bf16) { const u32x4 w = *(const u32x4*)((const bf16_t*)base + off + bj * HALF);
                        o[0] = (f32x4){__uint_as_float(w[0] << 16), __uint_as_float(w[0] & 0xffff0000u), __uint_as_float(w[1] << 16), __uint_as_float(w[1] & 0xffff0000u)};
                        o[1] = (f32x4){__uint_as_float(w[2] << 16), __uint_as_float(w[2] & 0xffff0000u), __uint_as_float(w[3] << 16), __uint_as_float(w[3] & 0xffff0000u)}; }
                    else { o[0] = *(const f32x4*)((const float*)base + off + bj * HALF); o[1] = *(const f32x4*)((const float*)base + off + bj * HALF + 4); }
#pragma unroll
                    for (int n = 0; n < 2; ++n) { o[n] = o[n] + g[bj][n] * acc[ai][bj][m][n]; ss += o[n][0] * o[n][0] + o[n][1] * o[n][1] + o[n][2] * o[n][2] + o[n][3] * o[n][3]; }
                    if (out_bf16) { u32x4 w; w.x = cvt_pk_bf16(o[0][0], o[0][1]); w.y = cvt_pk_bf16(o[0][2], o[0][3]); w.z = cvt_pk_bf16(o[1][0], o[1][1]); w.w = cvt_pk_bf16(o[1][2], o[1][3]);
                        *(u32x4*)((bf16_t*)out + off + bj * HALF) = w; }
                    else { *(f32x4*)((float*)out + off + bj * HALF) = o[0]; *(f32x4*)((float*)out + off + bj * HALF + 4) = o[1]; }
                    if (XA) { const f32x4 a0 = o[0] * gs[bj][0], a1 = o[1] * gs[bj][1];
                        u32x4 w; w.x = cvt_pk_bf16(a0[0], a0[1]); w.y = cvt_pk_bf16(a0[2], a0[3]); w.z = cvt_pk_bf16(a1[0], a1[1]); w.w = cvt_pk_bf16(a1[2], a1[3]);
                        *(u32x4*)(XA + off + bj * HALF) = w; } }
                if (XA) { ss += __shfl_xor(ss, 16); ss += __shfl_xor(ss, 32);
                    if (fq == 0) part[wc * 256 + ai * HALF + wr * 64 + m * 16 + fr] = ss; } }
        if (XA) {
            asm volatile("s_waitcnt lgkmcnt(0)\n\ts_barrier" ::: "memory");
            const int t = threadIdx.x;
            if (t < 256) atomicAdd(SSQ + (size_t)(u.pm * BM + t), part[t] + part[256 + t] + part[512 + t] + part[768 + t]);
            asm volatile("s_waitcnt lgkmcnt(0)\n\ts_barrier" ::: "memory");
        }
    }
};
struct PreRB { float sq[8]; u32x4 bv[2]; };
struct EpiRawBf16S {
    static constexpr bool PERM = true, AFTER_DRAIN = false; typedef PreRB Pre;
    bf16_t* O; int ldc; const float* SSQ; const bf16_t* bias; int nb;
    __device__ __forceinline__ Pre pre(const Unit& u, int wr, int wc, int fr, int fq) const {
        Pre p; const int row0 = u.pm * BM + wr * 64 + fr, col0 = u.pn * BM + wc * 32 + 8 * fq, b = (u.pm * BM) / SEQ;
#pragma unroll
        for (int i = 0; i < 8; ++i) p.sq[i] = SSQ[row0 + (i >> 2) * HALF + (i & 3) * 16];
#pragma unroll
        for (int bj = 0; bj < 2; ++bj) p.bv[bj] = *(const u32x4*)(bias + (size_t)b * nb + col0 + bj * HALF);
        return p;
    }
    __device__ __forceinline__ void operator()(const f32x4 (&acc)[2][2][4][2], const Unit& u, const Pre& p, int wr, int wc, int fr, int fq) const {
        const int row0 = u.pm * BM + wr * 64 + fr, col0 = u.pn * BM + wc * 32 + 8 * fq;
#pragma unroll
        for (int ai = 0; ai < 2; ++ai)
#pragma unroll
            for (int m = 0; m < 4; ++m) { const int row = row0 + ai * HALF + m * 16; bf16_t* rowp = O + (size_t)row * ldc + col0;
                const float rs = __builtin_amdgcn_rsqf(p.sq[ai * 4 + m] * (1.f / D) + EPS);
#pragma unroll
                for (int bj = 0; bj < 2; ++bj) { const u32x4 bw = p.bv[bj];
                    const f32x4 b0 = (f32x4){__uint_as_float(bw[0] << 16), __uint_as_float(bw[0] & 0xffff0000u), __uint_as_float(bw[1] << 16), __uint_as_float(bw[1] & 0xffff0000u)};
                    const f32x4 b1 = (f32x4){__uint_as_float(bw[2] << 16), __uint_as_float(bw[2] & 0xffff0000u), __uint_as_float(bw[3] << 16), __uint_as_float(bw[3] & 0xffff0000u)};
                    const f32x4 v0 = acc[ai][bj][m][0] * rs + b0, v1 = acc[ai][bj][m][1] * rs + b1;
                    u32x4 w; w.x = cvt_pk_bf16(v0[0], v0[1]); w.y = cvt_pk_bf16(v0[2], v0[3]); w.z = cvt_pk_bf16(v1[0], v1[1]); w.w = cvt_pk_bf16(v1[2], v1[3]);
                    *(u32x4*)(rowp + bj * HALF) = w; } }
    }
};
struct EpiSwigluS {
    static constexpr bool PERM = true, AFTER_DRAIN = false; typedef PreRB Pre;
    bf16_t* H; const float* SSQ; const bf16_t* bias;
    __device__ __forceinline__ Pre pre(const Unit& u, int wr, int wc, int fr, int fq) const {
        Pre p; const int row0 = u.pm * BM + wr * 64 + fr, gc0 = u.pn * BM + wc * 32 + 8 * fq, b = (u.pm * BM) / SEQ;
#pragma unroll
        for (int i = 0; i < 8; ++i) p.sq[i] = SSQ[row0 + (i >> 2) * HALF + (i & 3) * 16];
#pragma unroll
        for (int bj = 0; bj < 2; ++bj) p.bv[bj] = *(const u32x4*)(bias + (size_t)b * (2 * FF) + gc0 + bj * HALF);
        return p;
    }
    __device__ __forceinline__ void operator()(const f32x4 (&acc)[2][2][4][2], const Unit& u, const Pre& p, int wr, int wc, int fr, int fq) const {
        const int row0 = u.pm * BM + wr * 64 + fr, col0 = u.pn * HALF + wc * 32 + 8 * fq;
#pragma unroll
        for (int ai = 0; ai < 2; ++ai)
#pragma unroll
            for (int m = 0; m < 4; ++m) { const int row = row0 + ai * HALF + m * 16; bf16_t* rowp = H + (size_t)row * FF + col0;
                const float rs = __builtin_amdgcn_rsqf(p.sq[ai * 4 + m] * (1.f / D) + EPS);
                float hv[8];
#pragma unroll
                for (int n = 0; n < 2; ++n)
#pragma unroll
                    for (int e = 0; e < 4; ++e) { const unsigned gw_ = p.bv[0][n * 2 + (e >> 1)], uw_ = p.bv[1][n * 2 + (e >> 1)];
                        const float gb = (e & 1) ? __uint_as_float(gw_ & 0xffff0000u) : __uint_as_float(gw_ << 16), ub = (e & 1) ? __uint_as_float(uw_ & 0xffff0000u) : __uint_as_float(uw_ << 16);
                        const float gv = acc[ai][0][m][n][e] * rs + gb, uv = acc[ai][1][m][n][e] * rs + ub;
                        hv[n * 4 + e] = gv * __builtin_amdgcn_rcpf(1.f + __builtin_amdgcn_exp2f(-gv * LOG2E)) * uv; }
                u32x4 w; w.x = cvt_pk_bf16(hv[0], hv[1]); w.y = cvt_pk_bf16(hv[2], hv[3]); w.z = cvt_pk_bf16(hv[4], hv[5]); w.w = cvt_pk_bf16(hv[6], hv[7]);
                *(u32x4*)rowp = w; }
    }
};


struct EpiInProj0 {
    static constexpr bool PERM = true, AFTER_DRAIN = false; typedef NoPre Pre;
    __device__ __forceinline__ Pre pre(const Unit&, int, int, int, int) const { return Pre{}; }
    bf16_t* O; bf16_t* KC3; const float* qn_a; const float* kn_a; const float* qn_b; const float* kn_b; LAS unsigned char* lds;
    __device__ __forceinline__ void operator()(const f32x4 (&acc)[2][2][4][2], const Unit& u, const Pre&, int wr, int wc, int fr, int fq) const {
        const int row0 = u.pm * BM + wr * 64 + fr, col0 = u.pn * BM + wc * 32 + 8 * fq;
        LAS float* part = (LAS float*)(lds + 131072);
        float ssq[2][2][4];
#pragma unroll
        for (int ai = 0; ai < 2; ++ai)
#pragma unroll
            for (int bj = 0; bj < 2; ++bj)
#pragma unroll
                for (int m = 0; m < 4; ++m) { const f32x4 v0 = acc[ai][bj][m][0], v1 = acc[ai][bj][m][1];
                    float s = v0[0] * v0[0] + v0[1] * v0[1] + v0[2] * v0[2] + v0[3] * v0[3] + v1[0] * v1[0] + v1[1] * v1[1] + v1[2] * v1[2] + v1[3] * v1[3];
                    s += __shfl_xor(s, 16); s += __shfl_xor(s, 32); ssq[ai][bj][m] = s;
                    if (fq == 0) part[(bj * 4 + wc) * 256 + ai * HALF + wr * 64 + m * 16 + fr] = s; }
        asm volatile("s_waitcnt lgkmcnt(0)\n\ts_barrier" ::: "memory");
#pragma unroll
        for (int bj = 0; bj < 2; ++bj) {
            const int grp = (u.pn * BM + bj * HALF + wc * 32) >> 6;
            const float* gp = nullptr; float qs = 1.f;
            if (grp < 8) { gp = qn_a; qs = QS; } else if (grp < 16) gp = kn_a; else if (grp >= 24 && grp < 32) { gp = qn_b; qs = QS; } else if (grp == 32) gp = kn_b;
            f32x4 g0 = (f32x4){1.f, 1.f, 1.f, 1.f}, g1 = g0;
            if (gp) { g0 = *(const f32x4*)(gp + (wc & 1) * 32 + 8 * fq) * qs; g1 = *(const f32x4*)(gp + (wc & 1) * 32 + 8 * fq + 4) * qs; }
#pragma unroll
            for (int ai = 0; ai < 2; ++ai)
#pragma unroll
                for (int m = 0; m < 4; ++m) { const int rl = ai * HALF + wr * 64 + m * 16 + fr, row = u.pm * BM + rl;
                    float rs = 1.f;
                    if (gp) rs = __builtin_amdgcn_rsqf((ssq[ai][bj][m] + part[(bj * 4 + (wc ^ 1)) * 256 + rl]) * (1.f / 64.f) + EPS);
                    const f32x4 v0 = acc[ai][bj][m][0] * rs * g0, v1 = acc[ai][bj][m][1] * rs * g1;
                    u32x4 w; w.x = cvt_pk_bf16(v0[0], v0[1]); w.y = cvt_pk_bf16(v0[2], v0[3]); w.z = cvt_pk_bf16(v1[0], v1[1]); w.w = cvt_pk_bf16(v1[2], v1[3]);
                    *(u32x4*)(O + (size_t)row * EP + col0 + bj * HALF) = w;
                    if (grp == 32) *(u32x4*)(KC3 + (size_t)M * 64 + (size_t)row * 64 + (wc & 1) * 32 + 8 * fq) = w;
                    if (grp == 33) *(u32x4*)(KC3 + (size_t)2 * M * 64 + (size_t)row * 64 + (wc & 1) * 32 + 8 * fq) = w;
                    if (grp == 42) *(u32x4*)(KC3 + (size_t)row * 64 + (wc & 1) * 32 + 8 * fq) = w; }
        }
        asm volatile("s_waitcnt lgkmcnt(0)\n\ts_barrier" ::: "memory");
    }
};

template <class Epi, class Sched, bool ALIGN_EPI = false, bool SP2 = false>
__device__ __forceinline__ void gemm_phase(LAS unsigned char* lds, const Gemm g, const Sched& S, const Epi& E) {
    int tid_ = threadIdx.x; asm volatile("" : "+v"(tid_));
    const int tid = tid_, wid = __builtin_amdgcn_readfirstlane(tid >> 6), lane = tid & 63, wr = wid >> 2, wc = wid & 3, fr = lane & 15, fq = lane >> 4;
    const int K = g.K, nt = K / BK;
    unsigned voffA[2], voffB[2];
#pragma unroll
    for (int i = 0; i < 2; ++i) { int R, C; stage_rc(tid * 16 + i * 8192, R, C); const int Rb = Epi::PERM ? ((R & ~31) + perm32(R & 31)) : R;
        voffA[i] = (unsigned)(R * K + C) * 2u; voffB[i] = (unsigned)(Rb * K + C) * 2u; }
    const size_t kstep = (size_t)(BK * 2);
    const size_t hstep = (size_t)HALF * K * 2;
    const size_t tstep = 2 * hstep;
    const unsigned ldsw = (unsigned)wid * 1024u;
    const int aoff = lds_byte(wr * 64 + fr, fq * 8), boff = lds_byte(wc * 32 + fr, fq * 8);
#define PG8_SA(b, h) (((b) * 2 + (h)) * HTB)
#define PG8_SB(b, h) ((4 + (b) * 2 + (h)) * HTB)
#define PG8_STAGE(bufoff, gbase, voff) do { _Pragma("unroll") for (int _i = 0; _i < 2; ++_i) \
        __builtin_amdgcn_global_load_lds((const unsigned*)((const char*)(gbase) + (voff)[_i]), (LAS unsigned*)(lds + (bufoff) + ldsw + _i * 8192), 16, 0, 0); } while (0)
#define PG8_LDA(dst, b, h) do { _Pragma("unroll") for (int m = 0; m < 4; ++m) _Pragma("unroll") for (int k = 0; k < 2; ++k) dst[m][k] = *(const LAS bf16x8*)(lds + PG8_SA(b, h) + aoff + m * 2048 + k * 1024); } while (0)
#define PG8_LDB(dst, b, h) do { _Pragma("unroll") for (int n = 0; n < 2; ++n) _Pragma("unroll") for (int k = 0; k < 2; ++k) dst[n][k] = *(const LAS bf16x8*)(lds + PG8_SB(b, h) + boff + n * 2048 + k * 1024); } while (0)
#define PG8_MMA(ai, bj, At, Bt) do { __builtin_amdgcn_s_setprio(1); _Pragma("unroll") for (int m = 0; m < 4; ++m) _Pragma("unroll") for (int n = 0; n < 2; ++n) _Pragma("unroll") for (int k = 0; k < 2; ++k) \
        acc[ai][bj][m][n] = __builtin_amdgcn_mfma_f32_16x16x32_bf16(Bt[n][k], At[m][k], acc[ai][bj][m][n], 0, 0, 0); __builtin_amdgcn_s_setprio(0); } while (0)
#define PG8_WAIT_V(n) asm volatile("s_waitcnt vmcnt(" #n ")" ::: "memory")
#define PG8_WAIT_L(n) asm volatile("s_waitcnt lgkmcnt(" #n ")" ::: "memory")
#define PG8_BAR __builtin_amdgcn_s_barrier()
#define PG8_SCHED __builtin_amdgcn_sched_barrier(0)
    Unit cur, nxt; int ui = 0;
    if (!S.next(0, cur)) return;
    f32x4 acc[2][2][4][2];
#pragma unroll
    for (int a = 0; a < 2; ++a)
#pragma unroll
        for (int b = 0; b < 2; ++b)
#pragma unroll
            for (int m = 0; m < 4; ++m)
#pragma unroll
                for (int n = 0; n < 2; ++n) acc[a][b][m][n] = (f32x4){0.f, 0.f, 0.f, 0.f};
    bf16x8 At[4][2], B0[2][2], B1[2][2];
    const char* cA = (const char*)g.A + (size_t)cur.pm * tstep; const char* cB = (const char*)g.Bt + (size_t)cur.pn * tstep;
    S.a_ready(cur);
    typename Epi::Pre pre = E.pre(cur, wr, wc, fr, fq);
    if constexpr (SP2) {
        PG8_STAGE(PG8_SB(0, 0), cB, voffB); PG8_STAGE(PG8_SB(0, 1), cB + hstep, voffB); PG8_STAGE(PG8_SA(0, 0), cA, voffA); PG8_STAGE(PG8_SA(0, 1), cA + hstep, voffA);
        if (wr == 1) PG8_BAR;
        PG8_WAIT_V(2); PG8_BAR;
        PG8_STAGE(PG8_SB(1, 0), cB + kstep, voffB); PG8_STAGE(PG8_SA(1, 0), cA + kstep, voffA); PG8_STAGE(PG8_SB(1, 1), cB + hstep + kstep, voffB);
        PG8_WAIT_V(6); PG8_BAR;
    } else {
        PG8_STAGE(PG8_SB(0, 0), cB, voffB); PG8_STAGE(PG8_SA(0, 0), cA, voffA); PG8_STAGE(PG8_SB(0, 1), cB + hstep, voffB); PG8_STAGE(PG8_SA(0, 1), cA + hstep, voffA);
        if (wr == 1) PG8_BAR;
        PG8_WAIT_V(4); PG8_BAR;
        PG8_STAGE(PG8_SB(1, 0), cB + kstep, voffB); PG8_STAGE(PG8_SA(1, 0), cA + kstep, voffA); PG8_STAGE(PG8_SB(1, 1), cB + hstep + kstep, voffB);
        PG8_WAIT_V(6); PG8_BAR;
    }
    for (;;) {
        const bool has_next = S.next(ui + 1, nxt);
        const char* nA = has_next ? (const char*)g.A + (size_t)nxt.pm * tstep : cA; const char* nB = has_next ? (const char*)g.Bt + (size_t)nxt.pn * tstep : cB;
        for (int t = 0; t < nt; t += 2) {
            const bool last = (t == nt - 2);
            const char* a1 = cA + (size_t)(t + 1) * kstep;
            const char* a2 = last ? nA : cA + (size_t)(t + 2) * kstep; const char* b2 = last ? nB : cB + (size_t)(t + 2) * kstep;
            const char* a3 = a2 + kstep; const char* b3 = b2 + kstep;
            if (last && has_next) S.a_ready(nxt);
            if constexpr (SP2) {
            PG8_LDB(B0, 0, 0); PG8_LDB(B1, 0, 1); PG8_SCHED; PG8_LDA(At, 0, 0); PG8_STAGE(PG8_SA(1, 1), a1 + hstep, voffA);
            PG8_WAIT_V(8); PG8_WAIT_L(0); PG8_BAR; PG8_MMA(0, 0, At, B0); PG8_MMA(0, 1, At, B1); PG8_BAR; PG8_SCHED;
            PG8_LDA(At, 0, 1); PG8_STAGE(PG8_SB(0, 0), b2, voffB); PG8_STAGE(PG8_SB(0, 1), b2 + hstep, voffB); PG8_STAGE(PG8_SA(0, 0), a2, voffA);
            PG8_WAIT_V(8); PG8_WAIT_L(0); PG8_BAR; PG8_MMA(1, 0, At, B0); PG8_MMA(1, 1, At, B1); PG8_BAR; PG8_SCHED;
            PG8_LDB(B0, 1, 0); PG8_LDB(B1, 1, 1); PG8_SCHED; PG8_LDA(At, 1, 0); PG8_STAGE(PG8_SA(0, 1), a2 + hstep, voffA);
            PG8_WAIT_V(8); PG8_WAIT_L(0); PG8_BAR; PG8_MMA(0, 0, At, B0); PG8_MMA(0, 1, At, B1); PG8_BAR; PG8_SCHED;
            PG8_LDA(At, 1, 1); PG8_STAGE(PG8_SB(1, 0), b3, voffB); PG8_STAGE(PG8_SB(1, 1), b3 + hstep, voffB); PG8_STAGE(PG8_SA(1, 0), a3, voffA);
            PG8_WAIT_V(8); PG8_WAIT_L(0); PG8_BAR; PG8_MMA(1, 0, At, B0); PG8_MMA(1, 1, At, B1); PG8_BAR; PG8_SCHED;
            } else {
            PG8_LDB(B0, 0, 0); PG8_SCHED; PG8_LDA(At, 0, 0); PG8_STAGE(PG8_SA(1, 1), a1 + hstep, voffA);
            PG8_WAIT_L(8); PG8_BAR; PG8_WAIT_L(0); PG8_MMA(0, 0, At, B0); PG8_BAR; PG8_SCHED;
            PG8_LDB(B1, 0, 1); PG8_STAGE(PG8_SB(0, 0), b2, voffB);
            PG8_BAR; PG8_WAIT_L(0); PG8_MMA(0, 1, At, B1); PG8_BAR;
            PG8_LDA(At, 0, 1); PG8_STAGE(PG8_SA(0, 0), a2, voffA);
            PG8_BAR; PG8_WAIT_L(0); PG8_MMA(1, 0, At, B0); PG8_BAR; PG8_SCHED;
            PG8_STAGE(PG8_SB(0, 1), b2 + hstep, voffB);
            PG8_WAIT_V(6); PG8_BAR; PG8_MMA(1, 1, At, B1); PG8_BAR;
            PG8_LDB(B0, 1, 0); PG8_SCHED; PG8_LDA(At, 1, 0); PG8_STAGE(PG8_SA(0, 1), a2 + hstep, voffA);
            PG8_WAIT_L(8); PG8_BAR; PG8_WAIT_L(0); PG8_MMA(0, 0, At, B0); PG8_BAR; PG8_SCHED;
            PG8_LDB(B1, 1, 1); PG8_STAGE(PG8_SB(1, 0), b3, voffB);
            PG8_BAR; PG8_WAIT_L(0); PG8_MMA(0, 1, At, B1); PG8_BAR;
            PG8_LDA(At, 1, 1); PG8_STAGE(PG8_SA(1, 0), a3, voffA);
            PG8_BAR; PG8_WAIT_L(0); PG8_MMA(1, 0, At, B0); PG8_BAR; PG8_SCHED;
            PG8_STAGE(PG8_SB(1, 1), b3 + hstep, voffB);
            PG8_WAIT_V(6); PG8_BAR; PG8_MMA(1, 1, At, B1); PG8_BAR;
            }
        }
        if constexpr (ALIGN_EPI) { if (wr == 0) PG8_BAR; }
        if constexpr (!Epi::AFTER_DRAIN) { E(acc, cur, pre, wr, wc, fr, fq); S.done(cur); }
        if (!has_next) break;
#pragma unroll
        for (int a = 0; a < 2; ++a)
#pragma unroll
            for (int b = 0; b < 2; ++b)
#pragma unroll
                for (int m = 0; m < 4; ++m)
#pragma unroll
                    for (int n = 0; n < 2; ++n) acc[a][b][m][n] = (f32x4){0.f, 0.f, 0.f, 0.f};
        cur = nxt; cA = nA; cB = nB; ++ui;
        pre = E.pre(cur, wr, wc, fr, fq);
        if constexpr (ALIGN_EPI) { if (wr == 1) PG8_BAR; }
    }
    PG8_WAIT_V(0);
    if constexpr (!ALIGN_EPI) { if (wr == 0) PG8_BAR; }
    PG8_BAR;
#undef PG8_SA
#undef PG8_SB
#undef PG8_STAGE
#undef PG8_LDA
#undef PG8_LDB
#undef PG8_MMA
#undef PG8_WAIT_V
#undef PG8_WAIT_L
#undef PG8_BAR
#undef PG8_SCHED
}
}

__device__ __forceinline__ void qk_tile(f32x16& p0, f32x16& p1, lds_cptr Kt, const bf16x8 (&qr)[4], int r32, int hi) {
    lds_cptr kb = Kt + hi * 1024 + r32 * 16;
#pragma unroll
    for (int d0 = 0; d0 < 4; ++d0) {
        const bf16x8 b0 = *(const LAS bf16x8*)(kb + d0 * 2048);
        const bf16x8 b1 = *(const LAS bf16x8*)(kb + d0 * 2048 + 512);
        p0 = __builtin_amdgcn_mfma_f32_32x32x16_bf16(b0, qr[d0], p0, 0, 0, 0);
        p1 = __builtin_amdgcn_mfma_f32_32x32x16_bf16(b1, qr[d0], p1, 0, 0, 0);
    }
}
__device__ __forceinline__ float max32(const f32x16& p0, const f32x16& p1) {
    float a = fmaxf(p0[0], p1[0]), b = fmaxf(p0[1], p1[1]);
#pragma unroll
    for (int r = 2; r < 16; r += 2) { a = fmaxf(a, fmaxf(p0[r], p1[r])); b = fmaxf(b, fmaxf(p0[r + 1], p1[r + 1])); }
    return fmaxf(a, b);
}
template <int NDB>
__device__ __forceinline__ void softmax_pv(f32x16 (&o)[NDB], float& mref, float& lrun, f32x16& p0, f32x16& p1, lds_cptr Vt, LAS float* wsf, int r32, int hi, int lane) {
    float rm = xhalf_max(max32(p0, p1));
    if (__any(rm > 8.f)) {
        const float dl = fmaxf(rm, 0.f); mref += dl;
#pragma unroll
        for (int r = 0; r < 16; ++r) { p0[r] -= dl; p1[r] -= dl; }
        const float f = __builtin_amdgcn_exp2f(-dl); lrun *= f;
        if (hi == 0) wsf[r32] = f;
#pragma unroll
        for (int r = 0; r < 16; ++r) { const float fr_ = wsf[crow(r, hi)];
#pragma unroll
            for (int db = 0; db < NDB; ++db) o[db][r] *= fr_; }
    }
    float s = 0.f;
#pragma unroll
    for (int r = 0; r < 16; ++r) { p0[r] = __builtin_amdgcn_exp2f(p0[r]); p1[r] = __builtin_amdgcn_exp2f(p1[r]); s += p0[r] + p1[r]; }
    lrun += s;
    u32x4 pw[4];
#pragma unroll
    for (int k = 0; k < 4; ++k) {
        pw[0][k] = cvtpk(p0[2 * k], p0[2 * k + 1]); pw[1][k] = cvtpk(p0[8 + 2 * k], p0[8 + 2 * k + 1]);
        pw[2][k] = cvtpk(p1[2 * k], p1[2 * k + 1]); pw[3][k] = cvtpk(p1[8 + 2 * k], p1[8 + 2 * k + 1]);
    }
    lds_cptr vp = Vt + ((lane >> 4) & 1) * 32 + (lane & 3) * 8 + (4 * hi + ((lane & 15) >> 2)) * 64;
#pragma unroll
    for (int db = 0; db < NDB; ++db) {
#pragma unroll
        for (int ks = 0; ks < 4; ++ks) {
            const s16x4 lo = vtr(vp + db * 4096 + ks * 1024), hh = vtr(vp + db * 4096 + ks * 1024 + 512);
            const bf16x8 vf = (bf16x8){lo[0], lo[1], lo[2], lo[3], hh[0], hh[1], hh[2], hh[3]};
            o[db] = __builtin_amdgcn_mfma_f32_32x32x16_bf16(__builtin_bit_cast(bf16x8, pw[ks]), vf, o[db], 0, 0, 0);
        }
    }
}

constexpr int AT_STAGE = 32768, AT_XCHG = 65536, AT_WSF = 131072;
__device__ __forceinline__ void attnA_unit(const int b, const int h, const int qb, const int t0, const bf16_t* __restrict__ E, bf16_t* __restrict__ Y, const float lam, const float* __restrict__ subln, unsigned char* lds) {
    int tid_ = threadIdx.x; asm volatile("" : "+v"(tid_));
    const int tid = tid_, lane = tid & 63, r32 = lane & 31, hi = lane >> 5; const int wid = __builtin_amdgcn_readfirstlane(tid >> 6);
    const int mm = wid >> 2, rb = wid & 3;
    const int q0w = 128 * qb + 32 * rb, iq = q0w + r32, NT = 2 * (qb + 1);
    const bf16_t* Eb = E + (size_t)b * SEQ * EP;
    const unsigned lds0 = (unsigned)(uintptr_t)(LAS unsigned char*)lds;
    lds_cptr L = (lds_cptr)(LAS unsigned char*)lds;
    LAS float* wsf = (LAS float*)((LAS unsigned char*)lds + AT_WSF) + wid * 64;
    const bf16_t* src[4]; unsigned dsto[4];
#pragma unroll
    for (int i4 = 0; i4 < 4; ++i4) {
        if (wid < 4) { const int pidx = wid * 4 + i4, m_ = pidx >> 3, c = pidx & 7;
            src[i4] = Eb + (size_t)lane * EP + C_AK + h * 128 + m_ * 64 + c * 8; dsto[i4] = m_ * 8192 + c * 1024; }
        else { const int pidx = (wid - 4) * 4 + i4, db = pidx >> 2, rg = pidx & 3;
            src[i4] = Eb + (size_t)(16 * rg + (lane >> 2)) * EP + C_AV + h * 128 + db * 32 + (lane & 3) * 8; dsto[i4] = 16384 + db * 4096 + rg * 1024; }
    }
#define AT_DMA(t, stg) do { _Pragma("unroll") for (int i4 = 0; i4 < 4; ++i4) glds16(src[i4] + (size_t)(t) * 64 * EP, (unsigned)__builtin_amdgcn_readfirstlane(lds0 + (stg) * AT_STAGE + dsto[i4])); } while (0)
    AT_DMA(t0, 0);
    bf16x8 qr[4];
    { const bf16_t* Qw = Eb + (size_t)iq * EP + C_AQ + h * 128 + mm * 64;
#pragma unroll
      for (int d0 = 0; d0 < 4; ++d0) qr[d0] = *(const bf16x8*)(Qw + d0 * 16 + hi * 8); }
    const float slope2 = __builtin_amdgcn_exp2f(-2.f * (float)(h + 1)) * LOG2E;
    f32x16 o[4];
#pragma unroll
    for (int db = 0; db < 4; ++db) o[db] = f32x16{};
    float mref = 0.f, lrun = 0.f;
    for (int t = t0; t < NT; ++t) {
        WAITV_BAR();
        if (t + 1 < NT) AT_DMA(t + 1, (t + 1 - t0) & 1);
        if (64 * t <= q0w + 31) {
            lds_cptr st = L + ((t - t0) & 1) * AT_STAGE;
            const float tbm = slope2 * (float)(64 * t - iq) - mref;
            f32x16 p0, p1;
#pragma unroll
            for (int r = 0; r < 16; ++r) { p0[r] = tbm + slope2 * (float)crow(r, hi); p1[r] = p0[r] + 32.f * slope2; }
            qk_tile(p0, p1, st + mm * 8192, qr, r32, hi);
            if (64 * t + 63 > q0w) {
                const int kb = 64 * t + 4 * hi;
#pragma unroll
                for (int r = 0; r < 16; ++r) { const int kv = kb + (r & 3) + 8 * (r >> 2); if (kv > iq) p0[r] = -1e30f; if (kv + 32 > iq) p1[r] = -1e30f; }
            }
            softmax_pv<4>(o, mref, lrun, p0, p1, st + 16384, wsf, r32, hi, lane);
        }
    }
#undef AT_DMA
    lrun = xhalf_sum(lrun);
    if (hi == 0) wsf[r32] = lrun;
    float rli[16];
#pragma unroll
    for (int r = 0; r < 16; ++r) rli[r] = __builtin_amdgcn_rcpf(wsf[crow(r, hi)]);
    LAS float* xb = (LAS float*)((LAS unsigned char*)lds + AT_XCHG) + rb * 4096;
    if (mm == 1) {
#pragma unroll
        for (int db = 0; db < 4; ++db)
#pragma unroll
            for (int r = 0; r < 16; ++r) xb[(db * 16 + r) * 64 + lane] = o[db][r] * rli[r] * lam;
    }
    WAITL_BAR();
    if (mm == 0) {
        float ss[16];
#pragma unroll
        for (int r = 0; r < 16; ++r) ss[r] = 0.f;
#pragma unroll
        for (int db = 0; db < 4; ++db)
#pragma unroll
            for (int r = 0; r < 16; ++r) { const float dv = o[db][r] * rli[r] - xb[(db * 16 + r) * 64 + lane]; o[db][r] = dv; ss[r] += dv * dv; }
#pragma unroll
        for (int r = 0; r < 16; ++r) { float s = ss[r]; s += __shfl_xor(s, 1); s += __shfl_xor(s, 2); s += __shfl_xor(s, 4); s += __shfl_xor(s, 8); s += __shfl_xor(s, 16);
            ss[r] = __builtin_amdgcn_rsqf(s * (1.f / 128.f) + EPS) * 0.8f; }
        LAS bf16_t* stg = (LAS bf16_t*)((LAS unsigned char*)lds) + rb * 4096;
#pragma unroll
        for (int db = 0; db < 4; ++db) { const float gsub = subln[db * 32 + r32];
#pragma unroll
            for (int r = 0; r < 16; ++r) stg[crow(r, hi) * 128 + db * 32 + r32] = f2bf(o[db][r] * ss[r] * gsub); }
        bf16_t* Yw = Y + (size_t)(b * SEQ + q0w) * D + h * 128;
#pragma unroll
        for (int i8 = 0; i8 < 8; ++i8) { const int row = i8 * 4 + (lane >> 4), ch = lane & 15; const u32x4 v = *(const LAS u32x4*)(stg + row * 128 + ch * 8);
            *(u32x4*)(Yw + (size_t)row * D + ch * 8) = v; }
    }
    WAITL_BAR();
}

constexpr int SW_V = 32768, SW_OST = 65536;
__device__ __forceinline__ void swa_unit(const int b, const int kvh, const int nb, const bf16_t* __restrict__ E1, bf16_t* __restrict__ Y, const float* __restrict__ qn_c, const float* __restrict__ kn_c,
                                         const float* __restrict__ sinks, unsigned char* lds) {
    int tid_ = threadIdx.x; asm volatile("" : "+v"(tid_));
    const int tid = tid_, lane = tid & 63, r32 = lane & 31, hi = lane >> 5; const int wid = __builtin_amdgcn_readfirstlane(tid >> 6);
    const bf16_t* Eb = E1 + (size_t)b * SEQ * OP;
    LAS unsigned char* l3 = (LAS unsigned char*)lds;
    lds_cptr L = (lds_cptr)l3;
    LAS float* wsf = (LAS float*)(l3 + AT_WSF) + wid * 64;
    const int kt0 = (nb == 0) ? 2 : 0;
    {
        const int sub = lane & 7, rowi = tid >> 3;
        float kg[8];
#pragma unroll
        for (int i = 0; i < 8; ++i) kg[i] = kn_c[sub * 8 + i];
        for (int kt = kt0; kt < 4; ++kt) {
            const int key = 128 * (nb - 1) + 64 * kt + rowi;
            const u32x4 kr = *(const u32x4*)(Eb + (size_t)key * OP + C1_K + kvh * 64 + sub * 8);
            const u32x4 vr = *(const u32x4*)(Eb + (size_t)key * OP + C1_V + kvh * 64 + sub * 8);
            float v[8];
            v[0] = __uint_as_float(kr.x << 16); v[1] = __uint_as_float(kr.x & 0xffff0000u); v[2] = __uint_as_float(kr.y << 16); v[3] = __uint_as_float(kr.y & 0xffff0000u);
            v[4] = __uint_as_float(kr.z << 16); v[5] = __uint_as_float(kr.z & 0xffff0000u); v[6] = __uint_as_float(kr.w << 16); v[7] = __uint_as_float(kr.w & 0xffff0000u);
            float ss = 0.f;
#pragma unroll
            for (int i = 0; i < 8; ++i) ss += v[i] * v[i];
            ss += __shfl_xor(ss, 1); ss += __shfl_xor(ss, 2); ss += __shfl_xor(ss, 4);
            const float rr = __builtin_amdgcn_rsqf(ss * (1.f / 64.f) + EPS);
            u32x4 kw;
            kw.x = cvtpk(v[0] * rr * kg[0], v[1] * rr * kg[1]); kw.y = cvtpk(v[2] * rr * kg[2], v[3] * rr * kg[3]);
            kw.z = cvtpk(v[4] * rr * kg[4], v[5] * rr * kg[5]); kw.w = cvtpk(v[6] * rr * kg[6], v[7] * rr * kg[7]);
            *(LAS u32x4*)(l3 + kt * 8192 + sub * 1024 + rowi * 16) = kw;
            *(LAS u32x4*)(l3 + SW_V + kt * 8192 + (sub >> 2) * 4096 + (rowi >> 4) * 1024 + (rowi & 15) * 64 + (sub & 3) * 16) = vr;
        }
    }
    WAITL_BAR();
    const int g = wid >> 1, head = kvh * 4 + g;
    const float slope2 = __builtin_amdgcn_exp2f(-0.5f * (float)(head + 1)) * LOG2E;
    const float sink2 = sinks[head] * LOG2E;
    float qg[4][8];
#pragma unroll
    for (int d0 = 0; d0 < 4; ++d0)
#pragma unroll
        for (int i = 0; i < 8; ++i) qg[d0][i] = qn_c[d0 * 16 + hi * 8 + i] * QS;
    for (int rbi = 0; rbi < 2; ++rbi) {
        const int rb = 2 * (wid & 1) + rbi, rloc = 32 * rb + r32;
        const int tok = b * SEQ + 128 * nb + rloc;
        bf16x8 qr[4];
        { const bf16_t* Qw = E1 + (size_t)tok * OP + C1_Q + head * 64; u32x4 raw[4]; float ss = 0.f;
#pragma unroll
          for (int d0 = 0; d0 < 4; ++d0) { raw[d0] = *(const u32x4*)(Qw + d0 * 16 + hi * 8);
#pragma unroll
              for (int k = 0; k < 4; ++k) { const float a = __uint_as_float(raw[d0][k] << 16), c = __uint_as_float(raw[d0][k] & 0xffff0000u); ss += a * a + c * c; } }
          ss = xhalf_sum(ss);
          const float rr = __builtin_amdgcn_rsqf(ss * (1.f / 64.f) + EPS);
#pragma unroll
          for (int d0 = 0; d0 < 4; ++d0) { u32x4 w;
#pragma unroll
              for (int k = 0; k < 4; ++k) { const float a = __uint_as_float(raw[d0][k] << 16), c = __uint_as_float(raw[d0][k] & 0xffff0000u);
                  w[k] = cvtpk(a * rr * qg[d0][2 * k], c * rr * qg[d0][2 * k + 1]); }
              qr[d0] = __builtin_bit_cast(bf16x8, w); } }
        f32x16 o[2]; o[0] = f32x16{}; o[1] = f32x16{};
        float mref = 0.f, lrun = 0.f;
        const int ktlo = (rb < 2) ? 0 : 1, kthi = (rb < 2) ? 2 : 3;
        for (int kt = ktlo; kt <= kthi; ++kt) {
            if (kt < kt0) continue;
            const float tbm = slope2 * (float)(64 * kt - 128 - rloc) - mref;
            f32x16 p0, p1;
#pragma unroll
            for (int r = 0; r < 16; ++r) { p0[r] = tbm + slope2 * (float)crow(r, hi); p1[r] = p0[r] + 32.f * slope2; }
            qk_tile(p0, p1, L + kt * 8192, qr, r32, hi);
            const int jb = 64 * kt + 4 * hi;
#pragma unroll
            for (int r = 0; r < 16; ++r) { const int jj = jb + (r & 3) + 8 * (r >> 2);
                if (jj < rloc + 1 || jj > rloc + 128) p0[r] = -1e30f;
                if (jj + 32 < rloc + 1 || jj + 32 > rloc + 128) p1[r] = -1e30f; }
            softmax_pv<2>(o, mref, lrun, p0, p1, L + SW_V + kt * 8192, wsf, r32, hi, lane);
        }
        lrun = xhalf_sum(lrun) + __builtin_amdgcn_exp2f(sink2 - mref);
        if (hi == 0) wsf[r32] = lrun;
        LAS bf16_t* stg = (LAS bf16_t*)(l3 + SW_OST) + wid * 2048;
#pragma unroll
        for (int r = 0; r < 16; ++r) { const float rl = __builtin_amdgcn_rcpf(wsf[crow(r, hi)]);
#pragma unroll
            for (int db = 0; db < 2; ++db) stg[crow(r, hi) * 64 + db * 32 + r32] = f2bf(o[db][r] * rl); }
        bf16_t* Yw = Y + (size_t)(b * SEQ + 128 * nb + 32 * rb) * D + head * 64;
#pragma unroll
        for (int i4 = 0; i4 < 4; ++i4) { const int row = i4 * 8 + (lane >> 3), ch = lane & 7; const u32x4 v = *(const LAS u32x4*)(stg + row * 64 + ch * 8);
            *(u32x4*)(Yw + (size_t)row * D + ch * 8) = v; }
    }
    WAITL_BAR();
}

constexpr int DS_KSTR = 4100, DS_QROW = DS_KSTR * 4;
constexpr int DS_HIST = 131584, DS_LIST = 139776;
#define MFMA16(a, b, c) __builtin_amdgcn_mfma_f32_16x16x32_bf16((a), (b), (c), 0, 0, 0)
#ifndef DSA_REP1
#define DSA_REP1 1
#endif
#ifndef DSA_REP2
#define DSA_REP2 1
#endif
#ifndef DSA_REP3
#define DSA_REP3 1
#endif
__device__ __forceinline__ int pick_digit(const u32x4 hv, int& remaining, int lane) {
    const int s = (int)(hv[0] + hv[1] + hv[2] + hv[3]);
    int suf = s;
#pragma unroll
    for (int off = 1; off < 64; off <<= 1) { const int tv = __shfl_down(suf, off); if (lane + off < 64) suf += tv; }
    int cum = suf - s, found = -1, remn = 0;
#pragma unroll
    for (int d = 3; d >= 0; --d) { const int c = (int)hv[d]; if (found < 0 && cum < remaining && cum + c >= remaining) { found = 4 * lane + d; remn = remaining - cum; } cum += c; }
    const unsigned long long bal = __ballot(found >= 0);
    const int srcl = (int)__ffsll((long long)bal) - 1;
    remaining = __shfl(remn, srcl);
    return __shfl(found, srcl);
}
__device__ __forceinline__ void dsa_unit(const int b, const int i0, const bf16_t* __restrict__ E, const bf16_t* __restrict__ KC3, const unsigned* __restrict__ SGN, bf16_t* __restrict__ Y, unsigned char* lds) {
    int tid_ = threadIdx.x; asm volatile("" : "+v"(tid_));
    const int tid = tid_, lane = tid & 63, kq = lane >> 4, c16 = lane & 15; const int wid = __builtin_amdgcn_readfirstlane(tid >> 6);
    LAS unsigned char* l3 = (LAS unsigned char*)lds;
    LAS unsigned* keys = (LAS unsigned*)l3;
    const bf16_t* Eb = E + (size_t)b * SEQ * EP;
    const int nt32 = (i0 + 8 + 31) >> 5, n16 = nt32 * 32;
    const int nblk = (n16 + 511) >> 9;
    for (int rep1 = 0; rep1 < DSA_REP1; ++rep1)
    {
        const int r32 = lane & 31, hi = lane >> 5;
        for (int x4 = (n16 >> 2) + tid; x4 < 128 * nblk; x4 += 512) {
#pragma unroll
            for (int qq = 0; qq < 8; ++qq) *(LAS u32x4*)(keys + qq * DS_KSTR + 4 * x4) = (u32x4){0u, 0u, 0u, 0u};
        }
        bf16x8 Aq[2][4];
        { const int qa = r32 >> 3, ha = r32 & 7;
#pragma unroll
          for (int rb = 0; rb < 2; ++rb)
#pragma unroll
            for (int d0 = 0; d0 < 4; ++d0) Aq[rb][d0] = *(const bf16x8*)(E + ((size_t)b * SEQ + i0 + 4 * rb + qa) * EP + C_IQ + ha * 64 + d0 * 16 + hi * 8); }
        float wq[8][4];
#pragma unroll
        for (int q = 0; q < 8; ++q) { const u32x2 wr_ = *(const u32x2*)(E + ((size_t)b * SEQ + i0 + q) * EP + C_IW + 4 * hi);
            wq[q][0] = __uint_as_float(wr_[0] << 16) * IS; wq[q][1] = __uint_as_float(wr_[0] & 0xffff0000u) * IS; wq[q][2] = __uint_as_float(wr_[1] << 16) * IS; wq[q][3] = __uint_as_float(wr_[1] & 0xffff0000u) * IS; }
        const char* kbase = (const char*)(KC3 + ((size_t)b * SEQ + r32) * 64 + hi * 8);
        LAS unsigned* kout = keys + (4 * (1 - hi)) * DS_KSTR + r32;
        bf16x8 nk[4];
        { const int t = wid < nt32 ? wid : nt32 - 1; const char* kr = kbase + (unsigned)(t * (32 * 64 * 2));
#pragma unroll
          for (int d0 = 0; d0 < 4; ++d0) nk[d0] = *(const bf16x8*)(kr + d0 * 32); }
        for (int t = wid; t < nt32; t += 8) {
            bf16x8 bk_[4];
#pragma unroll
            for (int d0 = 0; d0 < 4; ++d0) bk_[d0] = nk[d0];
            { int tn = t + 8; tn = tn < nt32 ? tn : nt32 - 1; const char* kr = kbase + (unsigned)(tn * (32 * 64 * 2));
#pragma unroll
              for (int d0 = 0; d0 < 4; ++d0) nk[d0] = *(const bf16x8*)(kr + d0 * 32); }
            float part[2][4];
#pragma unroll
            for (int rb = 0; rb < 2; ++rb) {
                f32x16 dacc = f32x16{};
#pragma unroll
                for (int d0 = 0; d0 < 4; ++d0) dacc = __builtin_amdgcn_mfma_f32_32x32x16_bf16(Aq[rb][d0], bk_[d0], dacc, 0, 0, 0);
#pragma unroll
                for (int qq = 0; qq < 4; ++qq) { float a = 0.f;
#pragma unroll
                    for (int j = 0; j < 4; ++j) a = __builtin_fmaf(wq[4 * rb + qq][j], __builtin_amdgcn_fmed3f(dacc[4 * qq + j], 0.f, __builtin_inff()), a);
                    part[rb][qq] = a; }
            }
            const int key = 32 * t + r32;
#pragma unroll
            for (int qq = 0; qq < 4; ++qq) {
                auto rr = __builtin_amdgcn_permlane32_swap(__float_as_uint(part[1][qq]), __float_as_uint(part[0][qq]), false, false);
                float sv = __uint_as_float(rr[0]) + __uint_as_float(rr[1]); sv += 0.0f;
                const unsigned u = __float_as_uint(sv); unsigned kc = u ^ ((unsigned)((int)u >> 31) | 0x80000000u);
                if (32 * t + 31 > i0) kc = (key <= i0 + 4 * (1 - hi) + qq) ? kc : 0u;
                kout[qq * DS_KSTR + 32 * t] = kc; }
        }
    }
    WAITL_BAR();
    const int qi = i0 + wid, nq = qi + 1;
    LAS unsigned short* list = (LAS unsigned short*)(l3 + DS_LIST) + wid * 320;
    int cnt = 0;
    {
        LAS unsigned* myk = keys + wid * DS_KSTR;
        unsigned kreg[64];
#pragma unroll
        for (int blk = 0; blk < 8; ++blk) {
            if (blk < nblk) {
#pragma unroll
                for (int i = 8 * blk; i < 8 * blk + 8; ++i) kreg[i] = myk[64 * i + lane];
            } else {
#pragma unroll
                for (int i = 8 * blk; i < 8 * blk + 8; ++i) kreg[i] = 0u;
            }
        }
        unsigned T = 0u; int need = 0;
        if (nq > 256) {
            asm volatile("s_waitcnt lgkmcnt(0)" ::: "memory");
            constexpr int TB = 10, SH = 32 - TB;
            unsigned d0 = 0u; int cabove = 0;
#pragma unroll 1
            for (int bit = TB - 1; bit >= 0; --bit) {
                const unsigned cand = d0 | (1u << bit), lim = cand << SH; int c = 0;
#pragma unroll
                for (int blk = 0; blk < 8; ++blk) {
                    if (blk < nblk) {
                        unsigned long long bm[8];
#pragma unroll
                        for (int j = 0; j < 8; ++j) bm[j] = __ballot(kreg[8 * blk + j] >= lim);
#pragma unroll
                        for (int j = 0; j < 8; ++j) c += __popcll(bm[j]);
                    }
                }
                if (c >= 256) d0 = cand; else cabove = c;
            }
            int remaining = 256 - cabove;
            int ncand = 0;
#pragma unroll
            for (int blk = 0; blk < 8; ++blk) {
                if (blk < nblk) {
                    unsigned long long bm[8]; int off[8];
#pragma unroll
                    for (int j = 0; j < 8; ++j) bm[j] = __ballot((kreg[8 * blk + j] >> SH) == d0);
                    __builtin_amdgcn_sched_barrier(0);
#pragma unroll
                    for (int j = 0; j < 8; ++j) { off[j] = ncand; ncand += __popcll(bm[j]); }
                    __builtin_amdgcn_sched_barrier(0);
#pragma unroll
                    for (int j = 0; j < 8; ++j) { const unsigned k = kreg[8 * blk + j];
                        const int pos = (int)__builtin_amdgcn_mbcnt_hi((unsigned)(bm[j] >> 32), __builtin_amdgcn_mbcnt_lo((unsigned)bm[j], (unsigned)off[j]));
                        myk[((k >> SH) == d0) ? pos : 4099] = k; }
                    __builtin_amdgcn_sched_barrier(0);
                }
            }
            LAS unsigned* hist = (LAS unsigned*)(l3 + DS_HIST) + wid * 256;
            unsigned prefix = d0 << SH, msk = ~0u << SH;
#pragma unroll 1
            for (int pass = 0; pass < 3; ++pass) {
                const int shift = (pass == 0) ? 14 : (pass == 1) ? 6 : 0; const unsigned dm = (pass == 2) ? 63u : 255u;
                *(LAS u32x4*)(hist + 4 * lane) = (u32x4){0u, 0u, 0u, 0u};
                asm volatile("s_waitcnt lgkmcnt(0)" ::: "memory");
                for (int j = lane; j < ncand; j += 64) { const unsigned k = myk[j];
                    if ((k & msk) == prefix) __hip_atomic_fetch_add(hist + ((k >> shift) & dm), 1u, __ATOMIC_RELAXED, __HIP_MEMORY_SCOPE_WAVEFRONT); }
                asm volatile("s_waitcnt lgkmcnt(0)" ::: "memory");
                const u32x4 hv2 = *(const LAS u32x4*)(hist + 4 * lane);
                const int digit = pick_digit(hv2, remaining, lane);
                prefix |= (unsigned)digit << shift; msk |= dm << shift;
            }
            T = prefix; need = remaining;
        }
        int basep = 0;
#pragma unroll
        for (int blk = 0; blk < 8; ++blk) {
            if (blk < nblk) {
                unsigned long long bs[8]; int off[8];
#pragma unroll
                for (int j = 0; j < 8; ++j) bs[j] = __ballot(kreg[8 * blk + j] > T);
                __builtin_amdgcn_sched_barrier(0);
#pragma unroll
                for (int j = 0; j < 8; ++j) { off[j] = basep; basep += __popcll(bs[j]); }
                __builtin_amdgcn_sched_barrier(0);
#pragma unroll
                for (int j = 0; j < 8; ++j) {
                    const int pos = (int)__builtin_amdgcn_mbcnt_hi((unsigned)(bs[j] >> 32), __builtin_amdgcn_mbcnt_lo((unsigned)bs[j], (unsigned)off[j]));
                    list[(kreg[8 * blk + j] > T) ? pos : 319] = (unsigned short)(64 * (8 * blk + j) + lane); }
                __builtin_amdgcn_sched_barrier(0);
            }
        }
        if (nq > 256) {
#pragma unroll
            for (int blk = 0; blk < 8; ++blk) {
                if (blk < nblk) {
                    unsigned long long any = 0ull;
#pragma unroll
                    for (int i = 8 * blk; i < 8 * blk + 8; ++i) any |= __ballot(kreg[i] == T);
                    if (any != 0ull) {
#pragma unroll
                        for (int i = 8 * blk; i < 8 * blk + 8; ++i) {
                            const bool eq = kreg[i] == T;
                            const unsigned long long be = __ballot(eq);
                            const int rank = (int)__builtin_amdgcn_mbcnt_hi((unsigned)(be >> 32), __builtin_amdgcn_mbcnt_lo((unsigned)be, 0u));
                            const bool sel = eq && rank < need;
                            list[sel ? basep + rank : 319] = (unsigned short)(64 * i + lane);
                            int c = __popcll(be); c = c < need ? c : need;
                            basep += c; need -= c;
                        }
                    }
                }
            }
        }
        cnt = basep < 256 ? basep : 256;
        for (int s2 = cnt + lane; s2 < 256; s2 += 64) list[s2] = (unsigned short)0;
    }
    asm volatile("s_waitcnt lgkmcnt(0)" ::: "memory");
    for (int rep3 = 0; rep3 < DSA_REP3; ++rep3)
    {
        const size_t tok = (size_t)b * SEQ + qi; const int hd = c16 & 7;
        bf16x8 Bb[2];
#pragma unroll
        for (int ks = 0; ks < 2; ++ks) Bb[ks] = *(const bf16x8*)(E + tok * EP + C_BQ + hd * 64 + ks * 32 + kq * 8);
        const float slope2 = __builtin_amdgcn_exp2f(-(float)(hd + 1)) * LOG2E;
        LAS unsigned char* vst = l3 + wid * DS_QROW;
        const char* Ebk = (const char*)(KC3 + (size_t)M * 64 + (size_t)b * SEQ * 64) + kq * 16;
        const char* Ebv = (const char*)(KC3 + (size_t)2 * M * 64 + (size_t)b * SEQ * 64) + (lane & 7) * 16;
        u32x4 vreg[8];
#define DS_VLOAD(c4_) do { _Pragma("unroll") for (int it = 0; it < 8; ++it) { const unsigned j_ = list[64 * (c4_) + 8 * it + (lane >> 3)]; \
            vreg[it] = *(const u32x4*)(Ebv + j_ * 128u); } } while (0)
        DS_VLOAD(0);
        f32x4 lg[4][4];
#pragma unroll
        for (int hf = 0; hf < 2; ++hf) {
            bf16x8 ka0[8], ka1[8];
#pragma unroll
            for (int e = 0; e < 8; ++e) { const unsigned j = list[128 * hf + 16 * e + c16];
                const char* kr = Ebk + j * 128u; ka0[e] = *(const bf16x8*)kr; ka1[e] = *(const bf16x8*)(kr + 64); }
#pragma unroll
            for (int e = 0; e < 8; ++e) { const int c4 = 2 * hf + (e >> 2), tt = e & 3;
                f32x4 acc = MFMA16(ka0[e], Bb[0], ((f32x4){0.f, 0.f, 0.f, 0.f})); acc = MFMA16(ka1[e], Bb[1], acc);
                const int s0 = 64 * c4 + 16 * tt + 4 * kq;
                const u32x2 jl = *(const LAS u32x2*)(list + s0);
                const int j0 = jl[0] & 0xffff, j1 = jl[0] >> 16, j2 = jl[1] & 0xffff, j3 = jl[1] >> 16;
                lg[c4][tt][0] = (s0 + 0 < cnt) ? acc[0] + slope2 * (float)(j0 - qi) : -1e30f;
                lg[c4][tt][1] = (s0 + 1 < cnt) ? acc[1] + slope2 * (float)(j1 - qi) : -1e30f;
                lg[c4][tt][2] = (s0 + 2 < cnt) ? acc[2] + slope2 * (float)(j2 - qi) : -1e30f;
                lg[c4][tt][3] = (s0 + 3 < cnt) ? acc[3] + slope2 * (float)(j3 - qi) : -1e30f; }
        }
        float mx = -1e30f;
#pragma unroll
        for (int c4 = 0; c4 < 4; ++c4)
#pragma unroll
            for (int tt = 0; tt < 4; ++tt)
#pragma unroll
                for (int r = 0; r < 4; ++r) mx = fmaxf(mx, lg[c4][tt][r]);
        mx = fmaxf(mx, __shfl_xor(mx, 16)); mx = fmaxf(mx, __shfl_xor(mx, 32));
        float sum = 0.f;
#pragma unroll
        for (int c4 = 0; c4 < 4; ++c4)
#pragma unroll
            for (int tt = 0; tt < 4; ++tt)
#pragma unroll
                for (int r = 0; r < 4; ++r) { const float e = __builtin_amdgcn_exp2f(lg[c4][tt][r] - mx); lg[c4][tt][r] = e; sum += e; }
        sum += __shfl_xor(sum, 16); sum += __shfl_xor(sum, 32);
        const float inv = __builtin_amdgcn_rcpf(sum);
        f32x4 oacc[4];
#pragma unroll
        for (int dt = 0; dt < 4; ++dt) oacc[dt] = (f32x4){0.f, 0.f, 0.f, 0.f};
        const int qp = c16 >> 2, pp4 = c16 & 3;
#pragma unroll
        for (int c4 = 0; c4 < 4; ++c4) {
#pragma unroll
            for (int it = 0; it < 8; ++it) { const int row = 8 * it + (lane >> 3), ch = lane & 7; *(LAS u32x4*)(vst + row * 128 + ((ch ^ (row & 7)) * 16)) = vreg[it]; }
            if (c4 < 3) DS_VLOAD(c4 + 1);
            asm volatile("" ::: "memory");
#pragma unroll
            for (int pp = 0; pp < 2; ++pp) {
                const f32x4 l0 = lg[c4][2 * pp] * inv, l1 = lg[c4][2 * pp + 1] * inv;
                u32x4 pw; pw[0] = cvtpk(l0[0], l0[1]); pw[1] = cvtpk(l0[2], l0[3]); pw[2] = cvtpk(l1[0], l1[1]); pw[3] = cvtpk(l1[2], l1[3]);
                const int rlo = 32 * pp + 4 * kq + qp, rhi = rlo + 16;
#pragma unroll
                for (int dt = 0; dt < 4; ++dt) { const int chunk = 2 * dt + (pp4 >> 1);
                    const s16x4 lo = vtr((lds_cptr)(vst + rlo * 128 + ((chunk ^ (rlo & 7)) * 16) + (pp4 & 1) * 8));
                    const s16x4 hh = vtr((lds_cptr)(vst + rhi * 128 + ((chunk ^ (rhi & 7)) * 16) + (pp4 & 1) * 8));
                    const bf16x8 vf = (bf16x8){lo[0], lo[1], lo[2], lo[3], hh[0], hh[1], hh[2], hh[3]};
                    oacc[dt] = MFMA16(vf, __builtin_bit_cast(bf16x8, pw), oacc[dt]); }
            }
            asm volatile("" ::: "memory");
        }
#undef DS_VLOAD
        if (c16 < 8) {
            bf16_t* yo = Y + tok * D + 512 + hd * 64 + 4 * kq;
#pragma unroll
            for (int dt = 0; dt < 4; ++dt) { u32x2 w; w[0] = cvtpk(oacc[dt][0], oacc[dt][1]); w[1] = cvtpk(oacc[dt][2], oacc[dt][3]); *(u32x2*)(yo + 16 * dt) = w; }
        }
    }
    WAITL_BAR();
}

#define XB_TMO      128
#define XB_XCNT(j)  (256  + 64 * (j))
#define XB_XSUB(j)  (1280 + 64 * (j))
#define XB_XGEN(j)  (2304 + 64 * (j))
#define XB_TOP      3328
#define XB_TOPGEN   3392
#define XCD_BAR_WORDS 3456
#define XB_SPIN_CAP (1u << 18)
__device__ __forceinline__ unsigned xb_ld(unsigned* p)              { return __hip_atomic_load(p, __ATOMIC_RELAXED, __HIP_MEMORY_SCOPE_AGENT); }
__device__ __forceinline__ unsigned xb_add(unsigned* p, unsigned v) { return __hip_atomic_fetch_add(p, v, __ATOMIC_RELAXED, __HIP_MEMORY_SCOPE_AGENT); }
__device__ __forceinline__ unsigned xb_xcc_id() { return (unsigned)__builtin_amdgcn_s_getreg((3 << 11) | 20) & 0xFu; }
#define XB_SPIN(cond, bar) do { unsigned _sp = 0; while (cond) { __builtin_amdgcn_s_sleep(1); \
    if ((++_sp & 255u) == 0u) { if (xb_ld(&(bar)[XB_TMO])) break; if (_sp > XB_SPIN_CAP) { atomicAdd(&(bar)[XB_TMO], 1u); break; } } } } while (0)
struct XcdBarrier { unsigned* bar; unsigned x; volatile LAS unsigned* st; };
__device__ __forceinline__ XcdBarrier xcd_barrier_post(unsigned* bar, volatile LAS unsigned* st) {
    XcdBarrier b; b.bar = bar; b.x = xb_xcc_id(); b.st = st;
    if (threadIdx.x == 0) (void)xb_add(&bar[XB_XCNT(b.x)], 1u);
    return b;
}
__device__ __forceinline__ void xcd_barrier_complete(unsigned* bar, unsigned x, unsigned& nloc, unsigned& nx) {
    const unsigned G = gridDim.x * gridDim.y * gridDim.z;
    unsigned sum, cnt, mine, sp = 0u;
    for (;;) {
        sum = 0u; cnt = 0u; mine = 0u;
#pragma unroll
        for (unsigned j = 0; j < 16; ++j) { const unsigned c = xb_ld(&bar[XB_XCNT(j)]); sum += c; cnt += (c > 0u) ? 1u : 0u; mine = (j == x) ? c : mine; }
        if (sum == G) break;
        __builtin_amdgcn_s_sleep(1);
        if ((++sp & 255u) == 0u) { if (xb_ld(&bar[XB_TMO])) break; if (sp > XB_SPIN_CAP) { atomicAdd(&bar[XB_TMO], 1u); break; } }
    }
    nloc = mine > 0u ? mine : 1u; nx = cnt > 0u ? cnt : 1u;
}
__device__ __forceinline__ void xcd_barrier(const XcdBarrier& b) {
    asm volatile("s_waitcnt vmcnt(0)" ::: "memory");
    __syncthreads();
    if (threadIdx.x == 0) {
        unsigned* bar = b.bar;
        __builtin_amdgcn_s_waitcnt(0);
        unsigned nloc = b.st[0], nx = b.st[1];
        if (nloc == 0u) { xcd_barrier_complete(bar, b.x, nloc, nx); b.st[0] = nloc; b.st[1] = nx; }
        const unsigned old = xb_add(&bar[XB_XSUB(b.x)], 1u);
        const unsigned gen = old / nloc;
        if (old + 1u == (gen + 1u) * nloc) {
            __builtin_amdgcn_fence(__ATOMIC_RELEASE, "agent");
            asm volatile("s_waitcnt vmcnt(0)" ::: "memory");
            const unsigned og = xb_add(&bar[XB_TOP], 1u);
            const unsigned tg = og / nx;
            if (og + 1u == (tg + 1u) * nx) xb_add(&bar[XB_TOPGEN], 1u);
            else XB_SPIN(xb_ld(&bar[XB_TOPGEN]) == tg, bar);
            __builtin_amdgcn_fence(__ATOMIC_ACQUIRE, "agent");
            xb_add(&bar[XB_XGEN(b.x)], 1u);
            asm volatile("s_waitcnt vmcnt(0)" ::: "memory");
        } else {
            XB_SPIN(xb_ld(&bar[XB_XGEN(b.x)]) == gen, bar);
            __builtin_amdgcn_fence(__ATOMIC_ACQUIRE, "agent");
            asm volatile("s_waitcnt vmcnt(0)" ::: "memory");
        }
    }
    __syncthreads();
}

struct Params {
    const float* in[24]; float* out; unsigned char* ws; int ph_lo, ph_hi;
};
constexpr int LDS_BYTES = 163840, MISC_OFF = LDS_BYTES - 512;

__device__ __forceinline__ void tr_item(const float* __restrict__ W, int ldsrc, int ncol0, int nvalid, int K, int k0, bf16_t* __restrict__ WT, LAS float* scr, int lane) {
    const int c = lane & 31;
#pragma unroll 8
    for (int i = 0; i < 32; ++i) { const int kk = 2 * i + (lane >> 5); scr[kk * 33 + c] = (c < nvalid) ? W[(size_t)(k0 + kk) * ldsrc + ncol0 + c] : 0.f; }
    asm volatile("s_waitcnt lgkmcnt(0)" ::: "memory");
    const int c8 = lane & 7;
#pragma unroll
    for (int j = 0; j < 4; ++j) { const int n = (lane >> 3) + 8 * j; const LAS float* s = scr + (8 * c8) * 33 + n;
        u32x4 o; o.x = pk2(s[0 * 33], s[1 * 33]); o.y = pk2(s[2 * 33], s[3 * 33]); o.z = pk2(s[4 * 33], s[5 * 33]); o.w = pk2(s[6 * 33], s[7 * 33]);
        *(u32x4*)(WT + (size_t)n * K + k0 + 8 * c8) = o; }
    asm volatile("s_waitcnt lgkmcnt(0)" ::: "memory");
}

__device__ __forceinline__ void phase_prologue(const Params& p, unsigned char* lds, int G) {
    int tid_ = threadIdx.x; asm volatile("" : "+v"(tid_));
    const int tid = tid_, lane = tid & 63; const int wid = __builtin_amdgcn_readfirstlane(tid >> 6);
    LAS unsigned char* l3 = (LAS unsigned char*)lds;
    {
        LAS float* sc = (LAS float*)l3; LAS float* part = (LAS float*)(l3 + 16384);
        const float* c = p.in[1]; const float* ada_w = p.in[2]; const float* ada_b = p.in[3]; float* mod = (float*)(p.ws + WS_MOD);
        if ((int)blockIdx.x < 192) {
            for (int i = tid; i < 4096; i += 512) { const float v = c[i]; sc[i] = v / (1.f + expf(-v)); }
            __syncthreads();
            for (int item = blockIdx.x; item < 192; item += G) {
                const int l = item / 96, n0 = (item % 96) * 64;
                const float* W = ada_w + (size_t)l * 1024 * MODN + n0 + lane;
                float a0 = 0.f, a1 = 0.f, a2 = 0.f, a3 = 0.f;
#pragma unroll 8
                for (int k = wid * 128; k < wid * 128 + 128; ++k) { const float wv = W[(size_t)k * MODN]; a0 += sc[k] * wv; a1 += sc[1024 + k] * wv; a2 += sc[2048 + k] * wv; a3 += sc[3072 + k] * wv; }
                part[(wid * 4 + 0) * 64 + lane] = a0; part[(wid * 4 + 1) * 64 + lane] = a1; part[(wid * 4 + 2) * 64 + lane] = a2; part[(wid * 4 + 3) * 64 + lane] = a3;
                __syncthreads();
                if (tid < 256) { const int b = tid >> 6, col = tid & 63; float s = 0.f;
#pragma unroll
                    for (int ww = 0; ww < 8; ++ww) s += part[(ww * 4 + b) * 64 + col];
                    mod[(size_t)(l * 4 + b) * MODN + n0 + col] = s + ada_b[l * MODN + n0 + col]; }
                __syncthreads();
            }
        }
        __syncthreads();
    }
    LAS float* scr = (LAS float*)(l3 + wid * 16384);
    const int gw = blockIdx.x * 8 + wid, NGW = G * 8;
    constexpr int I0 = 88 * 16, I1 = 2 * 32 * 16, I2 = 2 * 176 * 16, I3 = 2 * 32 * 44, I4 = 48 * 16, NIT = I0 + I1 + I2 + I3 + I4;
    for (int it = gw; it < NIT; it += NGW) {
        int r = it;
        if (r < I0) { const int g = r / 16, kb = r % 16; int nv = ECOLS - 32 * g; nv = nv < 0 ? 0 : (nv > 32 ? 32 : nv);
            tr_item(p.in[10], ECOLS, 32 * g, nv, D, 64 * kb, (bf16_t*)(p.ws + WS_WIN0) + (size_t)(32 * g) * D, scr, lane); continue; }
        r -= I0;
        if (r < I1) { const int l = r / 512, g = (r % 512) / 16, kb = r % 16;
            tr_item(p.in[6] + (size_t)l * D * D, D, 32 * g, 32, D, 64 * kb, (bf16_t*)(p.ws + WS_WOUT) + (size_t)l * D * D + (size_t)(32 * g) * D, scr, lane); continue; }
        r -= I1;
        if (r < I2) { const int l = r / (176 * 16), g = (r % (176 * 16)) / 16, kb = r % 16; const int tile = g >> 3, cg = g & 7;
            const float* src = (cg < 4 ? p.in[7] : p.in[8]) + (size_t)l * D * FF;
            tr_item(src, FF, tile * 128 + (cg & 3) * 32, 32, D, 64 * kb, (bf16_t*)(p.ws + WS_WGU) + (size_t)l * GU * D + (size_t)(32 * g) * D, scr, lane); continue; }
        r -= I2;
        if (r < I3) { const int l = r / (32 * 44), g = (r % (32 * 44)) / 44, kb = r % 44;
            tr_item(p.in[9] + (size_t)l * FF * D, D, 32 * g, 32, FF, 64 * kb, (bf16_t*)(p.ws + WS_WDN) + (size_t)l * D * FF + (size_t)(32 * g) * FF, scr, lane); continue; }
        r -= I3;
        { const int g = r / 16, kb = r % 16;
            tr_item(p.in[20], OP, 32 * g, 32, D, 64 * kb, (bf16_t*)(p.ws + WS_WIN1) + (size_t)(32 * g) * D, scr, lane); }
    }
}

__device__ __forceinline__ void phase_norm(const float* __restrict__ x, const float* __restrict__ gain, const float* __restrict__ modl, int sh_off, int sc_off, bf16_t* __restrict__ XN, int G) {
    int tid_ = threadIdx.x; asm volatile("" : "+v"(tid_));
    const int lane = tid_ & 63; const int gw = blockIdx.x * 8 + (tid_ >> 6), NGW = G * 8;
    for (int row = gw; row < M; row += NGW) {
        const int b = row / SEQ;
        const f32x4* xr = (const f32x4*)(x + (size_t)row * D);
        f32x4 v[4]; float s = 0.f;
#pragma unroll
        for (int j = 0; j < 4; ++j) { v[j] = xr[64 * j + lane]; s += v[j][0] * v[j][0] + v[j][1] * v[j][1] + v[j][2] * v[j][2] + v[j][3] * v[j][3]; }
        s = wave_sum(s);
        const float r = __builtin_amdgcn_rsqf(s * (1.f / D) + EPS);
        const float* mb = modl + (size_t)b * MODN;
#pragma unroll
        for (int j = 0; j < 4; ++j) {
            const int col = 4 * (64 * j + lane);
            const f32x4 g = *(const f32x4*)(gain + col), scv = *(const f32x4*)(mb + sc_off + col), shv = *(const f32x4*)(mb + sh_off + col);
            const f32x4 y = v[j] * r * g * (1.f + scv) + shv;
            u32x2 o; o[0] = pk2(y[0], y[1]); o[1] = pk2(y[2], y[3]);
            *(u32x2*)(XN + (size_t)row * D + col) = o;
        }
    }
}

__device__ __forceinline__ void phase_post0(bf16_t* E, bf16_t* __restrict__ KC3, unsigned* __restrict__ SGN, const float* __restrict__ qn_a, const float* __restrict__ kn_a, const float* __restrict__ qn_b, const float* __restrict__ kn_b, int G) {
    int tid_ = threadIdx.x; asm volatile("" : "+v"(tid_));
    const int lane = tid_ & 63; const int gw = blockIdx.x * 8 + (tid_ >> 6), NGW = G * 8;
    const int sub = (lane & 7) * 8;
    for (int row = gw; row < M; row += NGW) {
        bf16_t* e = E + (size_t)row * EP;
        float w[8]; unsigned sgn = 0;
        { const u32x4 wr_ = *(const u32x4*)(e + C_IW);
          w[0] = __uint_as_float(wr_[0] << 16); w[1] = __uint_as_float(wr_[0] & 0xffff0000u); w[2] = __uint_as_float(wr_[1] << 16); w[3] = __uint_as_float(wr_[1] & 0xffff0000u);
          w[4] = __uint_as_float(wr_[2] << 16); w[5] = __uint_as_float(wr_[2] & 0xffff0000u); w[6] = __uint_as_float(wr_[3] << 16); w[7] = __uint_as_float(wr_[3] & 0xffff0000u); }
#pragma unroll
        for (int h = 0; h < 8; ++h) if (w[h] < 0.f) sgn |= 1u << h;
        if (lane == 0) SGN[row] = sgn;
#pragma unroll 1
        for (int it = 0; it < 6; ++it) {
            const int grp = it * 8 + (lane >> 3), col = grp * 64 + sub;
            const bool act = grp < 43;
            const u32x4 raw = act ? *(const u32x4*)(e + col) : (u32x4){0u, 0u, 0u, 0u};
            float v[8];
#pragma unroll
            for (int k = 0; k < 4; ++k) { v[2 * k] = __uint_as_float(raw[k] << 16); v[2 * k + 1] = __uint_as_float(raw[k] & 0xffff0000u); }
            float ss = 0.f;
#pragma unroll
            for (int i = 0; i < 8; ++i) ss += v[i] * v[i];
            ss += __shfl_xor(ss, 1); ss += __shfl_xor(ss, 2); ss += __shfl_xor(ss, 4);
            const float r = __builtin_amdgcn_rsqf(ss * (1.f / 64.f) + EPS);
            const float* gp = nullptr; float scale = 1.f; bool wrt = false;
            if (grp < 8) { gp = qn_a; scale = r * QS; wrt = true; }
            else if (grp < 16) { gp = kn_a; scale = r; wrt = true; }
            else if (grp < 24) { }
            else if (grp < 32) { gp = qn_b; scale = r * QS; wrt = true; }
            else if (grp == 32) { gp = kn_b; scale = r; wrt = true; }
            else if (grp == 33) { }
            if (grp == 33) *(u32x4*)(KC3 + (size_t)2 * M * 64 + (size_t)row * 64 + sub) = raw;
            if (grp == 42) *(u32x4*)(KC3 + (size_t)row * 64 + sub) = raw;
            if (act && wrt) {
                u32x4 ov;
#pragma unroll
                for (int k = 0; k < 4; ++k) ov[k] = pk2(v[2 * k] * scale * (gp ? gp[sub + 2 * k] : 1.f), v[2 * k + 1] * scale * (gp ? gp[sub + 2 * k + 1] : 1.f));
                *(u32x4*)(e + col) = ov;
                if (grp == 32) *(u32x4*)(KC3 + (size_t)M * 64 + (size_t)row * 64 + sub) = ov;
            }
        }
    }
}

__device__ __forceinline__ void phase_bias(const unsigned char* ws, unsigned char* lds, int G) {
    int tid_ = threadIdx.x; asm volatile("" : "+v"(tid_));
    const int lane = tid_ & 63; const int gw = blockIdx.x * 8 + (tid_ >> 6), NGW = G * 8;
    LAS float* scr = (LAS float*)((LAS unsigned char*)lds) + (tid_ >> 6) * 256;
    const float* mod = (const float*)(ws + WS_MOD); bf16_t* bias = (bf16_t*)(ws + WS_BIAS);
    constexpr int N1 = OP, NT_ = OP + 2 * GU;
    for (int r = gw; r < NT_; r += NGW) {
        const bf16_t* wrow; const float* sh; bf16_t* dst; int nb;
        if (r < N1) { wrow = (const bf16_t*)(ws + WS_WIN1) + (size_t)r * D; sh = mod + (size_t)4 * MODN + 0; dst = bias + r; nb = OP; }
        else { const int l = (r - N1) / GU, n = (r - N1) % GU; wrow = (const bf16_t*)(ws + WS_WGU) + (size_t)l * GU * D + (size_t)n * D; sh = mod + (size_t)l * 4 * MODN + 3072; dst = bias + 4 * OP + (size_t)l * 4 * GU + n; nb = GU; }
        const u32x4 w0 = *(const u32x4*)(wrow + lane * 16), w1 = *(const u32x4*)(wrow + lane * 16 + 8);
        float wv[16];
#pragma unroll
        for (int k = 0; k < 4; ++k) { wv[2 * k] = __uint_as_float(w0[k] << 16); wv[2 * k + 1] = __uint_as_float(w0[k] & 0xffff0000u); wv[8 + 2 * k] = __uint_as_float(w1[k] << 16); wv[8 + 2 * k + 1] = __uint_as_float(w1[k] & 0xffff0000u); }
        float a4[4];
#pragma unroll
        for (int bb = 0; bb < 4; ++bb) { const float* sp = sh + (size_t)bb * MODN + lane * 16; float a = 0.f;
#pragma unroll
            for (int k4 = 0; k4 < 4; ++k4) { const f32x4 sv = *(const f32x4*)(sp + 4 * k4); a += sv[0] * wv[4 * k4] + sv[1] * wv[4 * k4 + 1] + sv[2] * wv[4 * k4 + 2] + sv[3] * wv[4 * k4 + 3]; }
            a4[bb] = a; }
#pragma unroll
        for (int bb = 0; bb < 4; ++bb) scr[bb * 64 + lane] = a4[bb];
        const f32x4 pv = *(const LAS f32x4*)(scr + (lane >> 4) * 64 + (lane & 15) * 4);
        float t = (pv[0] + pv[1]) + (pv[2] + pv[3]);
        t += __shfl_xor(t, 1); t += __shfl_xor(t, 2); t += __shfl_xor(t, 4); t += __shfl_xor(t, 8);
        if ((lane & 15) == 0) dst[(size_t)(lane >> 4) * nb] = f2bf(t);
    }
}

__global__ void __launch_bounds__(512, 2) mega_fwd(Params p) {
    extern __shared__ __attribute__((aligned(16))) unsigned char lds[];
    const int tid = threadIdx.x, lane = tid & 63; const int wid = __builtin_amdgcn_readfirstlane(tid >> 6);
    const int G = gridDim.x, cb = blockIdx.x;
    LAS unsigned char* l3 = (LAS unsigned char*)lds;
    volatile LAS unsigned* MISC = (volatile LAS unsigned*)(l3 + MISC_OFF);
    if (tid < 128) MISC[tid] = 0u;
    __syncthreads();
    unsigned* ctl = (unsigned*)(p.ws + WS_CTL);
    const bool multi = (p.ph_hi - p.ph_lo) > 1;
    XcdBarrier bar; bar.bar = ctl + 1024; bar.x = 0; bar.st = nullptr;
    if (multi) bar = xcd_barrier_post(ctl + 1024, MISC + 8);
    const float* x = p.in[0]; float* out = p.out;

    for (int ph = p.ph_lo; ph < p.ph_hi; ++ph) {
        GAS unsigned char* wsg_ = (GAS unsigned char*)p.ws; asm volatile("" : "+s"(wsg_)); unsigned char* ws = (unsigned char*)wsg_;
        int lane_o = tid; asm volatile("" : "+v"(lane_o)); lane_o &= 63;
        float* mod = (float*)(ws + WS_MOD); unsigned* SGN = (unsigned*)(ws + WS_SGN);
        bf16_t* XN = (bf16_t*)(ws + WS_XN); bf16_t* Yb = (bf16_t*)(ws + WS_Y); bf16_t* E = (bf16_t*)(ws + WS_E);
        const int l = ph >= 7 ? 1 : 0;
        int kind;
        { const int tab[12] = {0, 1, 2, 4, 5, 7, 8, 2, 9, 5, 7, 8}; kind = tab[ph]; }
        float* SSQ0 = (float*)(ws + WS_SSQ); const bf16_t* BIAS = (const bf16_t*)(ws + WS_BIAS);
        const float* modl = mod + (size_t)l * 4 * MODN;
        if (kind == 0) phase_prologue(p, lds, G);
        else if (kind == 1) { phase_norm(x, p.in[4], modl, 0, 1024, XN, G); phase_bias(ws, lds, G); }
        else if (kind == 2) {
            pg8::Gemm g{XN, (const bf16_t*)(ws + (l == 0 ? WS_WIN0 : WS_WIN1)), M, l == 0 ? EP : OP, D};
            pg8::StaticOrder S; S.init(M, g.N, G, cb);
            if (l == 0) { pg8::EpiInProj0 Ep{E, (bf16_t*)(ws + WS_IKC), p.in[11], p.in[12], p.in[18], p.in[19], l3}; pg8::gemm_phase<pg8::EpiInProj0, pg8::StaticOrder, true, true>(l3, g, S, Ep); }
            else { pg8::EpiRawBf16S Ep{E, OP, SSQ0 + M, BIAS, OP}; pg8::gemm_phase<pg8::EpiRawBf16S, pg8::StaticOrder, true, true>(l3, g, S, Ep); }
        }
        else if (kind == 3) phase_post0(E, (bf16_t*)(ws + WS_IKC), SGN, p.in[11], p.in[12], p.in[18], p.in[19], G);
        else if (kind == 4) {
            const float t1 = wave_sum(p.in[13][lane_o] * p.in[14][lane_o]), t2 = wave_sum(p.in[15][lane_o] * p.in[16][lane_o]);
            const float lam = expf(t1) - expf(t2) + 0.2f;
            const float gq = wave_max(fabsf(p.in[11][lane_o])), gk = wave_max(fabsf(p.in[12][lane_o]));
            const float cut = 2.f * (8.f * gq * gk * 1.03f) + 30.f;
            unsigned* qctr = ctl + 64;
            if (tid == 0) MISC[16] = atomicAdd(qctr, 1u);
            __syncthreads();
            int item = (int)MISC[16];
            while (item < 512 + 2048) {
                unsigned nxt = 0u;
                if (tid == 0) nxt = atomicAdd(qctr, 1u);
                if (item < 512) {
                    const int hh = 3 - (item >> 7), r_ = item & 127, qb = 31 - (r_ >> 2), bb = r_ & 3;
                    const float dh = cut * __builtin_amdgcn_exp2f(2.f * (float)(hh + 1));
                    int t0 = (int)floorf(((float)(128 * qb) - dh) * (1.f / 64.f)); t0 = t0 < 0 ? 0 : t0;
                    attnA_unit(bb, hh, qb, t0, E, Yb, lam, p.in[17], lds);
                } else {
                    const int k = item - 512, bb = k & 3, ib = 511 - (k >> 2);
                    dsa_unit(bb, ib * 8, E, (const bf16_t*)(ws + WS_IKC), SGN, Yb, lds);
                }
                if (tid == 0) MISC[16] = nxt;
                __syncthreads();
                item = (int)MISC[16];
            }
        }
        else if (kind == 9) {
            for (int u = cb; u < 512; u += G) { const int bk = u & 15, nb = (u >> 4) & 31;
                swa_unit(bk >> 2, bk & 3, nb, E, Yb, p.in[21], p.in[22], p.in[23], lds); }
        }
        else if (kind == 5 || kind == 8) {
            const bool dn = (kind == 8);
            pg8::Gemm g{dn ? E : Yb, (const bf16_t*)(ws + (dn ? WS_WDN : WS_WOUT)) + (size_t)l * (dn ? D * FF : D * D), M, D, dn ? FF : D};
            pg8::StaticOrder S; S.init(M, D, G, cb);
            const bool last = dn && l == 1;
            const float* ngain = dn ? p.in[4] + D : p.in[5] + l * D;
            const float* nsc = dn ? mod + (size_t)4 * MODN + 1024 : modl + 4096;
            const bool first = (kind == 5 && l == 0);
            void* R = (void*)(ws + WS_R);
            pg8::EpiResGateN Ep{first ? (const void*)x : (const void*)R, last ? (void*)out : R, first ? 0 : 1, last ? 0 : 1,
                                modl + (dn ? 5120 : 2048), last ? nullptr : XN, ngain, nsc, SSQ0 + (size_t)(dn ? 1 : (l == 0 ? 0 : 2)) * M, l3};
            pg8::gemm_phase<pg8::EpiResGateN, pg8::StaticOrder, true, true>(l3, g, S, Ep);
        }
        else if (kind == 7) {
            pg8::Gemm g{XN, (const bf16_t*)(ws + WS_WGU) + (size_t)l * GU * D, M, GU, D};
            pg8::StaticOrder S; S.init(M, GU, G, cb);
            pg8::EpiSwigluS Ep{E, SSQ0 + (size_t)(l == 0 ? 0 : 2) * M, BIAS + 4 * OP + (size_t)l * 4 * GU};
            pg8::gemm_phase<pg8::EpiSwigluS, pg8::StaticOrder, true, true>(l3, g, S, Ep);
        }
        if (ph + 1 < p.ph_hi) xcd_barrier(bar);
    }
}

#ifndef MK_SPLIT
#define MK_SPLIT 0
#endif
extern "C" void kernel_launch(void* const* d_in, const int* in_sizes, int n_in, void* d_out, int out_size, void* d_ws, size_t ws_size, hipStream_t stream) {
    static int grid = 0;
    if (grid == 0) {
        int dev = 0, cus = 0, per_cu = 0;
        if (hipGetDevice(&dev) != hipSuccess || hipDeviceGetAttribute(&cus, hipDeviceAttributeMultiprocessorCount, dev) != hipSuccess) { fprintf(stderr, "kernel_launch: device query failed\n"); grid = -1; return; }
        if (hipFuncSetAttribute((const void*)mega_fwd, hipFuncAttributeMaxDynamicSharedMemorySize, LDS_BYTES) != hipSuccess) { fprintf(stderr, "kernel_launch: hipFuncSetAttribute failed\n"); grid = -1; return; }
        if (hipOccupancyMaxActiveBlocksPerMultiprocessor(&per_cu, (const void*)mega_fwd, 512, LDS_BYTES) != hipSuccess || per_cu < 1) { fprintf(stderr, "kernel_launch: occupancy query says %d\n", per_cu); (void)hipGetLastError(); per_cu = 1; }
        grid = cus;
    }
    if (grid < 0) return;
    (void)hipMemsetAsync((char*)d_ws + WS_CTL, 0, CTL_ZERO_BYTES, stream);
    Params p{};
    for (int i = 0; i < 24; ++i) p.in[i] = (const float*)d_in[i];
    p.out = (float*)d_out; p.ws = (unsigned char*)d_ws;
#if MK_SPLIT
    for (int ph = 0; ph < 12; ++ph) { p.ph_lo = ph; p.ph_hi = ph + 1; hipLaunchKernelGGL(mega_fwd, dim3(grid), dim3(512), LDS_BYTES, stream, p); }
#else
    p.ph_lo = 0; p.ph_hi = 12;
    void* args[] = {&p};
    hipError_t e = hipLaunchCooperativeKernel((const void*)mega_fwd, dim3(grid), dim3(512), args, LDS_BYTES, stream);
    if (e != hipSuccess) fprintf(stderr, "kernel_launch: cooperative launch failed: %s\n", hipGetErrorString(e));
#endif
}
```

```cpp
#include <hip/hip_runtime.h>
#include <cstdio>
#include <stdint.h>

#define LAS __attribute__((address_space(3)))
#define GAS __attribute__((address_space(1)))
typedef unsigned short bf16_t;
typedef short bf16x8 __attribute__((ext_vector_type(8)));
typedef short s16x4 __attribute__((ext_vector_type(4)));
typedef short v4i16_t __attribute__((ext_vector_type(4)));
typedef float f32x4 __attribute__((ext_vector_type(4)));
typedef float f32x16 __attribute__((ext_vector_type(16)));
typedef unsigned u32x4 __attribute__((ext_vector_type(4)));
typedef unsigned u32x2 __attribute__((ext_vector_type(2)));
typedef float f32x2_t __attribute__((ext_vector_type(2)));
typedef __bf16 bf16x2_t __attribute__((ext_vector_type(2)));
typedef LAS const char* lds_cptr;

constexpr int D = 1024, BATCH = 4, SEQ = 4096, M = BATCH * SEQ, FF = 2816, ECOLS = 2760, EP = 2816, OP = 1536, MODN = 6144, GU = 2 * FF;
constexpr float LOG2E = 1.4426950408889634f;
constexpr float QS = 0.125f * LOG2E;
constexpr float IS = 0.125f * 0.35355339059327373f;
constexpr float EPS = 1e-6f;
constexpr int C_AQ = 0, C_AK = 512, C_AV = 1024, C_BQ = 1536, C_BK = 2048, C_BV = 2112, C_IQ = 2176, C_IK = 2688, C_IW = 2752;
constexpr int C1_Q = 0, C1_K = 1024, C1_V = 1280;

constexpr size_t MiB = 1u << 20;
constexpr size_t WS_CTL = 0, CTL_ZERO_BYTES = 256 * 1024;
constexpr size_t WS_MOD = 1 * MiB, WS_SGN = 1 * MiB + 512 * 1024;
constexpr size_t WS_SSQ = 64 * 1024;
constexpr size_t WS_BIAS = 1 * MiB + 256 * 1024;
constexpr size_t WS_WIN0 = 2 * MiB;
constexpr size_t WS_WOUT = 8 * MiB;
constexpr size_t WS_WGU = 12 * MiB;
constexpr size_t WS_WDN = 34 * MiB;
constexpr size_t WS_WIN1 = 45 * MiB;
constexpr size_t WS_XN = 50 * MiB, WS_Y = 82 * MiB, WS_E = 114 * MiB, WS_END = 202 * MiB;
constexpr size_t WS_IKC = 202 * MiB, WS_BKC = 204 * MiB, WS_BVC = 206 * MiB;
constexpr size_t WS_R = 208 * MiB;

__device__ __forceinline__ float bf2f(bf16_t v) { return __uint_as_float((unsigned)v << 16); }
__device__ __forceinline__ bf16_t f2bf(float f) { unsigned u = __float_as_uint(f); return (bf16_t)((u + 0x7fffu + ((u >> 16) & 1u)) >> 16); }
__device__ __forceinline__ unsigned pk2(float lo, float hi) { return (unsigned)f2bf(lo) | ((unsigned)f2bf(hi) << 16); }
__device__ __forceinline__ unsigned cvtpk(float lo, float hi) { f32x2_t v = {lo, hi}; bf16x2_t b = __builtin_convertvector(v, bf16x2_t); return __builtin_bit_cast(unsigned, b); }
__device__ __forceinline__ float wave_sum(float v) {
#pragma unroll
    for (int o = 1; o < 64; o <<= 1) v += __shfl_xor(v, o);
    return v;
}
__device__ __forceinline__ float wave_max(float v) {
#pragma unroll
    for (int o = 1; o < 64; o <<= 1) v = fmaxf(v, __shfl_xor(v, o));
    return v;
}
__device__ __forceinline__ int crow(int r, int hi) { return (r & 3) + 8 * (r >> 2) + 4 * hi; }
__device__ __forceinline__ float xhalf_max(float m) { auto rr = __builtin_amdgcn_permlane32_swap(__float_as_uint(m), __float_as_uint(m), false, false); return fmaxf(__uint_as_float(rr[0]), __uint_as_float(rr[1])); }
__device__ __forceinline__ float xhalf_sum(float m) { auto rr = __builtin_amdgcn_permlane32_swap(__float_as_uint(m), __float_as_uint(m), false, false); return __uint_as_float(rr[0]) + __uint_as_float(rr[1]); }
__device__ __forceinline__ float x16_sum(float m) { auto rr = __builtin_amdgcn_permlane16_swap(__float_as_uint(m), __float_as_uint(m), false, false); return __uint_as_float(rr[0]) + __uint_as_float(rr[1]); }
__device__ __forceinline__ void glds16(const void* gsrc, unsigned lds_dst) { unsigned keep;
    asm volatile("s_mov_b32 %0, m0\n\ts_mov_b32 m0, %2\n\ts_nop 0\n\tglobal_load_lds_dwordx4 %1, off\n\ts_mov_b32 m0, %0" : "=&s"(keep) : "v"(gsrc), "s"(lds_dst) : "memory"); }
__device__ __forceinline__ s16x4 vtr(lds_cptr p) { return __builtin_bit_cast(s16x4, __builtin_amdgcn_ds_read_tr16_b64_v4i16((LAS v4i16_t*)p)); }
#ifdef PROBE_ID
#define TSTART(id) if ((id) == PROBE_ID && threadIdx.x == 0 && ctl) { if ((id) == 5100) { extern __shared__ __attribute__((aligned(16))) unsigned char lds_probe_[]; *(volatile LAS unsigned long long*)((LAS unsigned char*)lds_probe_ + 163328 + 128) = __builtin_amdgcn_s_memrealtime(); } else { __hip_atomic_store((unsigned long long*)(ctl + 512) + blockIdx.x, (unsigned long long)__builtin_amdgcn_s_memrealtime(), __ATOMIC_RELAXED, __HIP_MEMORY_SCOPE_AGENT); } }
#define TSTOP(id, ctl_) if ((id) == PROBE_ID && threadIdx.x == 0) { unsigned long long t0_; if ((id) == 5100) { extern __shared__ __attribute__((aligned(16))) unsigned char lds_probe_[]; t0_ = *(volatile LAS unsigned long long*)((LAS unsigned char*)lds_probe_ + 163328 + 128); } else { t0_ = __hip_atomic_load((unsigned long long*)((ctl_) + 512) + blockIdx.x, __ATOMIC_RELAXED, __HIP_MEMORY_SCOPE_AGENT); } atomicAdd((unsigned long long*)((ctl_) + 256), (unsigned long long)(__builtin_amdgcn_s_memrealtime() - t0_)); }
#else
#define TSTART(id)
#define TSTOP(id, ctl_)
#endif
#define WAITV_BAR() asm volatile("s_waitcnt vmcnt(0) lgkmcnt(0)\n\ts_barrier" ::: "memory")
#define WAITL_BAR() asm volatile("s_waitcnt lgkmcnt(0)\n\ts_barrier" ::: "memory")

namespace pg8 {
constexpr int BM = 256, BK = 64, HALF = 128, HTB = HALF * BK * 2, STAGE_BYTES = 8 * HTB, NXCD = 8, WGM = 8;
__host__ __device__ __forceinline__ int lds_byte(int r, int c) { const int st = (r >> 4) * 2 + (c >> 5), rr = r & 15, cc = c & 31, ob = rr * 64 + cc * 2; return st * 1024 + (ob ^ (((ob >> 9) & 1) << 5)); }
__host__ __device__ __forceinline__ void stage_rc(int b, int& R, int& C) { const int st = b / 1024, sb = b % 1024, swz = sb ^ (((sb >> 9) & 1) << 5); R = (st >> 1) * 16 + swz / 64; C = (st & 1) * 32 + (swz % 64) / 2; }
__host__ __device__ __forceinline__ int perm32(int rho) { const int n = rho >> 4, i = rho & 15; return 8 * (i >> 2) + 4 * n + (i & 3); }
struct Unit { int pm, pn; };
struct Gemm { const bf16_t* A; const bf16_t* Bt; int M, N, K; };
struct StaticOrder {
    int nM, nN, nwg, G, c;
    __host__ __device__ void init(int M_, int N_, int G_, int c_) { nM = M_ / BM; nN = N_ / BM; nwg = nM * nN; G = G_; c = c_; }
    __host__ __device__ bool next(int i, Unit& u) const {
        const long L = (long)i * G + c; if (L >= nwg) return false;
        int wgid = (int)L; { const int q = nwg / NXCD, r = nwg % NXCD, xcd = wgid % NXCD, off = wgid / NXCD; wgid = (xcd < r ? xcd * (q + 1) : r * (q + 1) + (xcd - r) * q) + off; }
        const int nig = WGM * nN, gid = wgid / nig, fm = gid * WGM, gsz = (nM - fm) < WGM ? (nM - fm) : WGM;
        u.pm = fm + ((wgid % nig) % gsz); u.pn = (wgid % nig) / gsz; return true;
    }
    __device__ __forceinline__ void a_ready(const Unit&) const {}
    __device__ __forceinline__ void done(const Unit&) const {}
};
__device__ __forceinline__ unsigned cvt_pk_bf16(float lo, float hi) { unsigned r; asm volatile("v_cvt_pk_bf16_f32 %0, %1, %2" : "=v"(r) : "v"(lo), "v"(hi)); return r; }

struct NoPre {};
struct EpiRawBf16 {
    static constexpr bool PERM = true, AFTER_DRAIN = false; typedef NoPre Pre;
    __device__ __forceinline__ unsigned* probe_ctl() const { return nullptr; }
    __device__ __forceinline__ Pre pre(const Unit&, int, int, int, int) const { return Pre{}; }
    bf16_t* O; int ldc;
    __device__ __forceinline__ void operator()(const f32x4 (&acc)[2][2][4][2], const Unit& u, const Pre&, int wr, int wc, int fr, int fq) const {
        const int row0 = u.pm * BM + wr * 64 + fr, col0 = u.pn * BM + wc * 32 + 8 * fq;
#pragma unroll
        for (int ai = 0; ai < 2; ++ai)
#pragma unroll
            for (int m = 0; m < 4; ++m) { bf16_t* rowp = O + (size_t)(row0 + ai * HALF + m * 16) * ldc + col0;
#pragma unroll
                for (int bj = 0; bj < 2; ++bj) { const f32x4 v0 = acc[ai][bj][m][0], v1 = acc[ai][bj][m][1];
                    u32x4 w; w.x = cvt_pk_bf16(v0[0], v0[1]); w.y = cvt_pk_bf16(v0[2], v0[3]); w.z = cvt_pk_bf16(v1[0], v1[1]); w.w = cvt_pk_bf16(v1[2], v1[3]);
                    *(u32x4*)(rowp + bj * HALF) = w; } }
    }
};
struct EpiResGateN {
    static constexpr bool PERM = true, AFTER_DRAIN = false; typedef NoPre Pre;
    unsigned* pctl;
    __device__ __forceinline__ unsigned* probe_ctl() const { return pctl; }
    __device__ __forceinline__ Pre pre(const Unit&, int, int, int, int) const { return Pre{}; }
    const void* base; void* out; int base_bf16, out_bf16;
    const float* gate; bf16_t* XA; const float* gain; const float* scn; float* SSQ; LAS unsigned char* lds;
    __device__ __forceinline__ void operator()(const f32x4 (&acc)[2][2][4][2], const Unit& u, const Pre&, int wr, int wc, int fr, int fq) const {
        const int row0 = u.pm * BM + wr * 64 + fr, col0 = u.pn * BM + wc * 32 + 8 * fq, b = (u.pm * BM) / SEQ;
        f32x4 g[2][2], gs[2][2];
#pragma unroll
        for (int bj = 0; bj < 2; ++bj)
#pragma unroll
            for (int n = 0; n < 2; ++n) { g[bj][n] = *(const f32x4*)(gate + (size_t)b * MODN + col0 + bj * HALF + 4 * n);
                if (XA) gs[bj][n] = *(const f32x4*)(gain + col0 + bj * HALF + 4 * n) * (1.f + *(const f32x4*)(scn + (size_t)b * MODN + col0 + bj * HALF + 4 * n)); }
        LAS float* part = (LAS float*)(lds + 131072);
#pragma unroll
        for (int ai = 0; ai < 2; ++ai)
#pragma unroll
            for (int m = 0; m < 4; ++m) { const size_t off = (size_t)(row0 + ai * HALF + m * 16) * D + col0; float ss = 0.f;
#pragma unroll
                for (int bj = 0; bj < 2; ++bj) { f32x4 o[2];
                    if (base_bf16) { const u32x4 w = *(const u32x4*)((const bf16_t*)base + off + bj * HALF);
                        o[0] = (f32x4){__uint_as_float(w[0] << 16), __uint_as_float(w[0] & 0xffff0000u), __uint_as_float(w[1] << 16), __uint_as_float(w[1] & 0xffff0000u)};
                        o[1] = (f32x4){__uint_as_float(w[2] << 16), __uint_as_float(w[2] & 0xffff0000u), __uint_as_float(w[3] << 16), __uint_as_float(w[3] & 0xffff0000u)}; }
                    else { o[0] = *(const f32x4*)((const float*)base + off + bj * HALF); o[1] = *(const f32x4*)((const float*)base + off + bj * HALF + 4); }
#pragma unroll
                    for (int n = 0; n < 2; ++n) { o[n] = o[n] + g[bj][n] * acc[ai][bj][m][n]; ss += o[n][0] * o[n][0] + o[n][1] * o[n][1] + o[n][2] * o[n][2] + o[n][3] * o[n][3]; }
                    if (out_bf16) { u32x4 w; w.x = cvt_pk_bf16(o[0][0], o[0][1]); w.y = cvt_pk_bf16(o[0][2], o[0][3]); w.z = cvt_pk_bf16(o[1][0], o[1][1]); w.w = cvt_pk_bf16(o[1][2], o[1][3]);
                        *(u32x4*)((bf16_t*)out + off + bj * HALF) = w; }
                    else { *(f32x4*)((float*)out + off + bj * HALF) = o[0]; *(f32x4*)((float*)out + off + bj * HALF + 4) = o[1]; }
                    if (XA) { const f32x4 a0 = o[0] * gs[bj][0], a1 = o[1] * gs[bj][1];
                        u32x4 w; w.x = cvt_pk_bf16(a0[0], a0[1]); w.y = cvt_pk_bf16(a0[2], a0[3]); w.z = cvt_pk_bf16(a1[0], a1[1]); w.w = cvt_pk_bf16(a1[2], a1[3]);
                        *(u32x4*)(XA + off + bj * HALF) = w; } }
                if (XA) { ss = x16_sum(ss); ss = xhalf_sum(ss);
                    if (fq == 0) part[wc * 256 + ai * HALF + wr * 64 + m * 16 + fr] = ss; } }
        if (XA) {
            asm volatile("s_waitcnt lgkmcnt(0)\n\ts_barrier" ::: "memory");
            const int t = threadIdx.x;
            if (t < 256) atomicAdd(SSQ + (size_t)(u.pm * BM + t), part[t] + part[256 + t] + part[512 + t] + part[768 + t]);
            asm volatile("s_waitcnt lgkmcnt(0)\n\ts_barrier" ::: "memory");
        }
    }
};
struct PreRB { float sq[8]; u32x4 bv[2]; };
struct EpiRawBf16S {
    static constexpr bool PERM = true, AFTER_DRAIN = false; typedef PreRB Pre;
    __device__ __forceinline__ unsigned* probe_ctl() const { return nullptr; }
    bf16_t* O; int ldc; const float* SSQ; const bf16_t* bias; int nb;
#ifdef PROBE_ID
    __device__ __forceinline__ Pre pre(const Unit&, int, int, int, int) const { return Pre{}; }
#else
    __device__ __forceinline__ Pre pre(const Unit& u, int wr, int wc, int fr, int fq) const { return ldpre(u, wr, wc, fr, fq); }
#endif
    __device__ __forceinline__ Pre ldpre(const Unit& u, int wr, int wc, int fr, int fq) const {
        Pre p; const int row0 = u.pm * BM + wr * 64 + fr, col0 = u.pn * BM + wc * 32 + 8 * fq, b = (u.pm * BM) / SEQ;
#pragma unroll
        for (int i = 0; i < 8; ++i) p.sq[i] = SSQ[row0 + (i >> 2) * HALF + (i & 3) * 16];
#pragma unroll
        for (int bj = 0; bj < 2; ++bj) p.bv[bj] = *(const u32x4*)(bias + (size_t)b * nb + col0 + bj * HALF);
        return p;
    }
    __device__ __forceinline__ void operator()(const f32x4 (&acc)[2][2][4][2], const Unit& u, const Pre& p_in, int wr, int wc, int fr, int fq) const {
#ifdef PROBE_ID
        const Pre p = ldpre(u, wr, wc, fr, fq);
#else
        const Pre& p = p_in;
#endif
        const int row0 = u.pm * BM + wr * 64 + fr, col0 = u.pn * BM + wc * 32 + 8 * fq;
#pragma unroll
        for (int ai = 0; ai < 2; ++ai)
#pragma unroll
            for (int m = 0; m < 4; ++m) { const int row = row0 + ai * HALF + m * 16; bf16_t* rowp = O + (size_t)row * ldc + col0;
                const float rs = __builtin_amdgcn_rsqf(p.sq[ai * 4 + m] * (1.f / D) + EPS);
#pragma unroll
                for (int bj = 0; bj < 2; ++bj) { const u32x4 bw = p.bv[bj];
                    const f32x4 b0 = (f32x4){__uint_as_float(bw[0] << 16), __uint_as_float(bw[0] & 0xffff0000u), __uint_as_float(bw[1] << 16), __uint_as_float(bw[1] & 0xffff0000u)};
                    const f32x4 b1 = (f32x4){__uint_as_float(bw[2] << 16), __uint_as_float(bw[2] & 0xffff0000u), __uint_as_float(bw[3] << 16), __uint_as_float(bw[3] & 0xffff0000u)};
                    const f32x4 v0 = acc[ai][bj][m][0] * rs + b0, v1 = acc[ai][bj][m][1] * rs + b1;
                    u32x4 w; w.x = cvt_pk_bf16(v0[0], v0[1]); w.y = cvt_pk_bf16(v0[2], v0[3]); w.z = cvt_pk_bf16(v1[0], v1[1]); w.w = cvt_pk_bf16(v1[2], v1[3]);
                    *(u32x4*)(rowp + bj * HALF) = w; } }
    }
};
struct EpiSwigluS {
    static constexpr bool PERM = true, AFTER_DRAIN = false; typedef PreRB Pre;
    __device__ __forceinline__ unsigned* probe_ctl() const { return nullptr; }
    bf16_t* H; const float* SSQ; const bf16_t* bias;
#ifdef PROBE_ID
    __device__ __forceinline__ Pre pre(const Unit&, int, int, int, int) const { return Pre{}; }
#else
    __device__ __forceinline__ Pre pre(const Unit& u, int wr, int wc, int fr, int fq) const { return ldpre(u, wr, wc, fr, fq); }
#endif
    __device__ __forceinline__ Pre ldpre(const Unit& u, int wr, int wc, int fr, int fq) const {
        Pre p; const int row0 = u.pm * BM + wr * 64 + fr, gc0 = u.pn * BM + wc * 32 + 8 * fq, b = (u.pm * BM) / SEQ;
#pragma unroll
        for (int i = 0; i < 8; ++i) p.sq[i] = SSQ[row0 + (i >> 2) * HALF + (i & 3) * 16];
#pragma unroll
        for (int bj = 0; bj < 2; ++bj) p.bv[bj] = *(const u32x4*)(bias + (size_t)b * (2 * FF) + gc0 + bj * HALF);
        return p;
    }
    __device__ __forceinline__ void operator()(const f32x4 (&acc)[2][2][4][2], const Unit& u, const Pre& p_in, int wr, int wc, int fr, int fq) const {
#ifdef PROBE_ID
        const Pre p = ldpre(u, wr, wc, fr, fq);
#else
        const Pre& p = p_in;
#endif
        const int row0 = u.pm * BM + wr * 64 + fr, col0 = u.pn * HALF + wc * 32 + 8 * fq;
#pragma unroll
        for (int ai = 0; ai < 2; ++ai)
#pragma unroll
            for (int m = 0; m < 4; ++m) { const int row = row0 + ai * HALF + m * 16; bf16_t* rowp = H + (size_t)row * FF + col0;
                const float rs = __builtin_amdgcn_rsqf(p.sq[ai * 4 + m] * (1.f / D) + EPS);
                float hv[8];
#pragma unroll
                for (int n = 0; n < 2; ++n)
#pragma unroll
                    for (int e = 0; e < 4; ++e) { const unsigned gw_ = p.bv[0][n * 2 + (e >> 1)], uw_ = p.bv[1][n * 2 + (e >> 1)];
                        const float gb = (e & 1) ? __uint_as_float(gw_ & 0xffff0000u) : __uint_as_float(gw_ << 16), ub = (e & 1) ? __uint_as_float(uw_ & 0xffff0000u) : __uint_as_float(uw_ << 16);
                        const float gv = acc[ai][0][m][n][e] * rs + gb, uv = acc[ai][1][m][n][e] * rs + ub;
                        hv[n * 4 + e] = gv * __builtin_amdgcn_rcpf(1.f + __builtin_amdgcn_exp2f(-gv * LOG2E)) * uv; }
                u32x4 w; w.x = cvt_pk_bf16(hv[0], hv[1]); w.y = cvt_pk_bf16(hv[2], hv[3]); w.z = cvt_pk_bf16(hv[4], hv[5]); w.w = cvt_pk_bf16(hv[6], hv[7]);
                *(u32x4*)rowp = w; }
    }
};


struct EpiInProj0 {
    static constexpr bool PERM = true, AFTER_DRAIN = false; typedef NoPre Pre;
    __device__ __forceinline__ unsigned* probe_ctl() const { return nullptr; }
    __device__ __forceinline__ Pre pre(const Unit&, int, int, int, int) const { return Pre{}; }
    bf16_t* O; bf16_t* KC3; const float* qn_a; const float* kn_a; const float* qn_b; const float* kn_b; LAS unsigned char* lds;
    __device__ __forceinline__ void operator()(const f32x4 (&acc)[2][2][4][2], const Unit& u, const Pre&, int wr, int wc, int fr, int fq) const {
        const int row0 = u.pm * BM + wr * 64 + fr, col0 = u.pn * BM + wc * 32 + 8 * fq;
        LAS float* part = (LAS float*)(lds + 131072);
        float ssq[2][2][4];
#pragma unroll
        for (int ai = 0; ai < 2; ++ai)
#pragma unroll
            for (int bj = 0; bj < 2; ++bj)
#pragma unroll
                for (int m = 0; m < 4; ++m) { const f32x4 v0 = acc[ai][bj][m][0], v1 = acc[ai][bj][m][1];
                    float s = v0[0] * v0[0] + v0[1] * v0[1] + v0[2] * v0[2] + v0[3] * v0[3] + v1[0] * v1[0] + v1[1] * v1[1] + v1[2] * v1[2] + v1[3] * v1[3];
                    s = x16_sum(s); s = xhalf_sum(s); ssq[ai][bj][m] = s;
                    if (fq == 0) part[(bj * 4 + wc) * 256 + ai * HALF + wr * 64 + m * 16 + fr] = s; }
        asm volatile("s_waitcnt lgkmcnt(0)\n\ts_barrier" ::: "memory");
#pragma unroll
        for (int bj = 0; bj < 2; ++bj) {
            const int grp = (u.pn * BM + bj * HALF + wc * 32) >> 6;
            const float* gp = nullptr; float qs = 1.f;
            if (grp < 8) { gp = qn_a; qs = QS; } else if (grp < 16) gp = kn_a; else if (grp >= 24 && grp < 32) { gp = qn_b; qs = QS; } else if (grp == 32) gp = kn_b;
            f32x4 g0 = (f32x4){1.f, 1.f, 1.f, 1.f}, g1 = g0;
            if (gp) { g0 = *(const f32x4*)(gp + (wc & 1) * 32 + 8 * fq) * qs; g1 = *(const f32x4*)(gp + (wc & 1) * 32 + 8 * fq + 4) * qs; }
#pragma unroll
            for (int ai = 0; ai < 2; ++ai)
#pragma unroll
                for (int m = 0; m < 4; ++m) { const int rl = ai * HALF + wr * 64 + m * 16 + fr, row = u.pm * BM + rl;
                    float rs = 1.f;
                    if (gp) rs = __builtin_amdgcn_rsqf((ssq[ai][bj][m] + part[(bj * 4 + (wc ^ 1)) * 256 + rl]) * (1.f / 64.f) + EPS);
                    const f32x4 v0 = acc[ai][bj][m][0] * rs * g0, v1 = acc[ai][bj][m][1] * rs * g1;
                    u32x4 w; w.x = cvt_pk_bf16(v0[0], v0[1]); w.y = cvt_pk_bf16(v0[2], v0[3]); w.z = cvt_pk_bf16(v1[0], v1[1]); w.w = cvt_pk_bf16(v1[2], v1[3]);
                    *(u32x4*)(O + (size_t)row * EP + col0 + bj * HALF) = w;
                    if (grp == 32) *(u32x4*)(KC3 + (size_t)M * 64 + (size_t)row * 64 + (wc & 1) * 32 + 8 * fq) = w;
                    if (grp == 33) *(u32x4*)(KC3 + (size_t)2 * M * 64 + (size_t)row * 64 + (wc & 1) * 32 + 8 * fq) = w;
                    if (grp == 42) *(u32x4*)(KC3 + (size_t)row * 64 + (wc & 1) * 32 + 8 * fq) = w; }
        }
        asm volatile("s_waitcnt lgkmcnt(0)\n\ts_barrier" ::: "memory");
    }
};

template <class Epi, class Sched, bool ALIGN_EPI = false, bool SP2 = false>
__device__ __forceinline__ void gemm_phase(LAS unsigned char* lds, const Gemm g, const Sched& S, const Epi& E) {
    int tid_ = threadIdx.x; asm volatile("" : "+v"(tid_));
    const int tid = tid_, wid = __builtin_amdgcn_readfirstlane(tid >> 6), lane = tid & 63, wr = wid >> 2, wc = wid & 3, fr = lane & 15, fq = lane >> 4;
    const int K = g.K, nt = K / BK;
    unsigned voffA[2], voffB[2];
#pragma unroll
    for (int i = 0; i < 2; ++i) { int R, C; stage_rc(tid * 16 + i * 8192, R, C); const int Rb = Epi::PERM ? ((R & ~31) + perm32(R & 31)) : R;
        voffA[i] = (unsigned)(R * K + C) * 2u; voffB[i] = (unsigned)(Rb * K + C) * 2u; }
    const size_t kstep = (size_t)(BK * 2);
    const size_t hstep = (size_t)HALF * K * 2;
    const size_t tstep = 2 * hstep;
    const unsigned ldsw = (unsigned)wid * 1024u;
    const int aoff = lds_byte(wr * 64 + fr, fq * 8), boff = lds_byte(wc * 32 + fr, fq * 8);
#define PG8_SA(b, h) (((b) * 2 + (h)) * HTB)
#define PG8_SB(b, h) ((4 + (b) * 2 + (h)) * HTB)
#define PG8_STAGE(bufoff, gbase, voff) do { _Pragma("unroll") for (int _i = 0; _i < 2; ++_i) \
        __builtin_amdgcn_global_load_lds((const unsigned*)((const char*)(gbase) + (voff)[_i]), (LAS unsigned*)(lds + (bufoff) + ldsw + _i * 8192), 16, 0, 0); } while (0)
#define PG8_LDA(dst, b, h) do { _Pragma("unroll") for (int m = 0; m < 4; ++m) _Pragma("unroll") for (int k = 0; k < 2; ++k) dst[m][k] = *(const LAS bf16x8*)(lds + PG8_SA(b, h) + aoff + m * 2048 + k * 1024); } while (0)
#define PG8_LDB(dst, b, h) do { _Pragma("unroll") for (int n = 0; n < 2; ++n) _Pragma("unroll") for (int k = 0; k < 2; ++k) dst[n][k] = *(const LAS bf16x8*)(lds + PG8_SB(b, h) + boff + n * 2048 + k * 1024); } while (0)
#define PG8_MMA(ai, bj, At, Bt) do { __builtin_amdgcn_s_setprio(1); _Pragma("unroll") for (int m = 0; m < 4; ++m) _Pragma("unroll") for (int n = 0; n < 2; ++n) _Pragma("unroll") for (int k = 0; k < 2; ++k) \
        acc[ai][bj][m][n] = __builtin_amdgcn_mfma_f32_16x16x32_bf16(Bt[n][k], At[m][k], acc[ai][bj][m][n], 0, 0, 0); __builtin_amdgcn_s_setprio(0); } while (0)
#define PG8_WAIT_V(n) asm volatile("s_waitcnt vmcnt(" #n ")" ::: "memory")
#define PG8_WAIT_L(n) asm volatile("s_waitcnt lgkmcnt(" #n ")" ::: "memory")
#define PG8_BAR __builtin_amdgcn_s_barrier()
#define PG8_SCHED __builtin_amdgcn_sched_barrier(0)
    Unit cur, nxt; int ui = 0;
    if (!S.next(0, cur)) return;
    f32x4 acc[2][2][4][2];
#pragma unroll
    for (int a = 0; a < 2; ++a)
#pragma unroll
        for (int b = 0; b < 2; ++b)
#pragma unroll
            for (int m = 0; m < 4; ++m)
#pragma unroll
                for (int n = 0; n < 2; ++n) acc[a][b][m][n] = (f32x4){0.f, 0.f, 0.f, 0.f};
    bf16x8 At[4][2], B0[2][2], B1[2][2];
    const char* cA = (const char*)g.A + (size_t)cur.pm * tstep; const char* cB = (const char*)g.Bt + (size_t)cur.pn * tstep;
    S.a_ready(cur);
    typename Epi::Pre pre = E.pre(cur, wr, wc, fr, fq);
    if constexpr (SP2) {
        PG8_STAGE(PG8_SB(0, 0), cB, voffB); PG8_STAGE(PG8_SB(0, 1), cB + hstep, voffB); PG8_STAGE(PG8_SA(0, 0), cA, voffA); PG8_STAGE(PG8_SA(0, 1), cA + hstep, voffA);
        if (wr == 1) PG8_BAR;
        PG8_WAIT_V(2); PG8_BAR;
        PG8_STAGE(PG8_SB(1, 0), cB + kstep, voffB); PG8_STAGE(PG8_SA(1, 0), cA + kstep, voffA); PG8_STAGE(PG8_SB(1, 1), cB + hstep + kstep, voffB);
        PG8_WAIT_V(6); PG8_BAR;
    } else {
        PG8_STAGE(PG8_SB(0, 0), cB, voffB); PG8_STAGE(PG8_SA(0, 0), cA, voffA); PG8_STAGE(PG8_SB(0, 1), cB + hstep, voffB); PG8_STAGE(PG8_SA(0, 1), cA + hstep, voffA);
        if (wr == 1) PG8_BAR;
        PG8_WAIT_V(4); PG8_BAR;
        PG8_STAGE(PG8_SB(1, 0), cB + kstep, voffB); PG8_STAGE(PG8_SA(1, 0), cA + kstep, voffA); PG8_STAGE(PG8_SB(1, 1), cB + hstep + kstep, voffB);
        PG8_WAIT_V(6); PG8_BAR;
    }
    for (;;) {
        const bool has_next = S.next(ui + 1, nxt);
        const char* nA = has_next ? (const char*)g.A + (size_t)nxt.pm * tstep : cA; const char* nB = has_next ? (const char*)g.Bt + (size_t)nxt.pn * tstep : cB;
        for (int t = 0; t < nt; t += 2) {
            const bool last = (t == nt - 2);
            const char* a1 = cA + (size_t)(t + 1) * kstep;
            const char* a2 = last ? nA : cA + (size_t)(t + 2) * kstep; const char* b2 = last ? nB : cB + (size_t)(t + 2) * kstep;
            const char* a3 = a2 + kstep; const char* b3 = b2 + kstep;
            if (last && has_next) S.a_ready(nxt);
            if constexpr (SP2) {
            PG8_LDB(B0, 0, 0); PG8_LDB(B1, 0, 1); PG8_SCHED; PG8_LDA(At, 0, 0); PG8_STAGE(PG8_SA(1, 1), a1 + hstep, voffA);
            PG8_WAIT_V(8); PG8_WAIT_L(0); PG8_BAR; PG8_MMA(0, 0, At, B0); PG8_MMA(0, 1, At, B1); PG8_BAR; PG8_SCHED;
            PG8_LDA(At, 0, 1); PG8_STAGE(PG8_SB(0, 0), b2, voffB); PG8_STAGE(PG8_SB(0, 1), b2 + hstep, voffB); PG8_STAGE(PG8_SA(0, 0), a2, voffA);
            PG8_WAIT_V(8); PG8_WAIT_L(0); PG8_BAR; PG8_MMA(1, 0, At, B0); PG8_MMA(1, 1, At, B1); PG8_BAR; PG8_SCHED;
            PG8_LDB(B0, 1, 0); PG8_LDB(B1, 1, 1); PG8_SCHED; PG8_LDA(At, 1, 0); PG8_STAGE(PG8_SA(0, 1), a2 + hstep, voffA);
            PG8_WAIT_V(8); PG8_WAIT_L(0); PG8_BAR; PG8_MMA(0, 0, At, B0); PG8_MMA(0, 1, At, B1); PG8_BAR; PG8_SCHED;
            PG8_LDA(At, 1, 1); PG8_STAGE(PG8_SB(1, 0), b3, voffB); PG8_STAGE(PG8_SB(1, 1), b3 + hstep, voffB); PG8_STAGE(PG8_SA(1, 0), a3, voffA);
            PG8_WAIT_V(8); PG8_WAIT_L(0); PG8_BAR; PG8_MMA(1, 0, At, B0); PG8_MMA(1, 1, At, B1); PG8_BAR; PG8_SCHED;
            } else {
            PG8_LDB(B0, 0, 0); PG8_SCHED; PG8_LDA(At, 0, 0); PG8_STAGE(PG8_SA(1, 1), a1 + hstep, voffA);
            PG8_WAIT_L(8); PG8_BAR; PG8_WAIT_L(0); PG8_MMA(0, 0, At, B0); PG8_BAR; PG8_SCHED;
            PG8_LDB(B1, 0, 1); PG8_STAGE(PG8_SB(0, 0), b2, voffB);
            PG8_BAR; PG8_WAIT_L(0); PG8_MMA(0, 1, At, B1); PG8_BAR;
            PG8_LDA(At, 0, 1); PG8_STAGE(PG8_SA(0, 0), a2, voffA);
            PG8_BAR; PG8_WAIT_L(0); PG8_MMA(1, 0, At, B0); PG8_BAR; PG8_SCHED;
            PG8_STAGE(PG8_SB(0, 1), b2 + hstep, voffB);
            PG8_WAIT_V(6); PG8_BAR; PG8_MMA(1, 1, At, B1); PG8_BAR;
            PG8_LDB(B0, 1, 0); PG8_SCHED; PG8_LDA(At, 1, 0); PG8_STAGE(PG8_SA(0, 1), a2 + hstep, voffA);
            PG8_WAIT_L(8); PG8_BAR; PG8_WAIT_L(0); PG8_MMA(0, 0, At, B0); PG8_BAR; PG8_SCHED;
            PG8_LDB(B1, 1, 1); PG8_STAGE(PG8_SB(1, 0), b3, voffB);
            PG8_BAR; PG8_WAIT_L(0); PG8_MMA(0, 1, At, B1); PG8_BAR;
            PG8_LDA(At, 1, 1); PG8_STAGE(PG8_SA(1, 0), a3, voffA);
            PG8_BAR; PG8_WAIT_L(0); PG8_MMA(1, 0, At, B0); PG8_BAR; PG8_SCHED;
            PG8_STAGE(PG8_SB(1, 1), b3 + hstep, voffB);
            PG8_WAIT_V(6); PG8_BAR; PG8_MMA(1, 1, At, B1); PG8_BAR;
            }
        }
        if constexpr (ALIGN_EPI) { if (wr == 0) PG8_BAR; }
        if constexpr (!Epi::AFTER_DRAIN) { unsigned* ctl = E.probe_ctl(); TSTART(51) E(acc, cur, pre, wr, wc, fr, fq); if (ctl) { TSTOP(51, ctl) } S.done(cur); }
        if (!has_next) break;
#pragma unroll
        for (int a = 0; a < 2; ++a)
#pragma unroll
            for (int b = 0; b < 2; ++b)
#pragma unroll
                for (int m = 0; m < 4; ++m)
#pragma unroll
                    for (int n = 0; n < 2; ++n) acc[a][b][m][n] = (f32x4){0.f, 0.f, 0.f, 0.f};
        cur = nxt; cA = nA; cB = nB; ++ui;
        pre = E.pre(cur, wr, wc, fr, fq);
        if constexpr (ALIGN_EPI) { if (wr == 1) PG8_BAR; }
    }
    PG8_WAIT_V(0);
    if constexpr (!ALIGN_EPI) { if (wr == 0) PG8_BAR; }
    PG8_BAR;
#undef PG8_SA
#undef PG8_SB
#undef PG8_STAGE
#undef PG8_LDA
#undef PG8_LDB
#undef PG8_MMA
#undef PG8_WAIT_V
#undef PG8_WAIT_L
#undef PG8_BAR
#undef PG8_SCHED
}
}

__device__ __forceinline__ void qk_tile(f32x16& p0, f32x16& p1, lds_cptr Kt, const bf16x8 (&qr)[4], int r32, int hi) {
    lds_cptr kb = Kt + hi * 1024 + r32 * 16;
#pragma unroll
    for (int d0 = 0; d0 < 4; ++d0) {
        const bf16x8 b0 = *(const LAS bf16x8*)(kb + d0 * 2048);
        const bf16x8 b1 = *(const LAS bf16x8*)(kb + d0 * 2048 + 512);
        p0 = __builtin_amdgcn_mfma_f32_32x32x16_bf16(b0, qr[d0], p0, 0, 0, 0);
        p1 = __builtin_amdgcn_mfma_f32_32x32x16_bf16(b1, qr[d0], p1, 0, 0, 0);
    }
}
__device__ __forceinline__ void qk_tile_rm(f32x16& p0, f32x16& p1, lds_cptr Kt, const bf16x8 (&qr)[4], int r32, int hi) {
    lds_cptr k0 = Kt + r32 * 128, k1 = Kt + (r32 + 32) * 128; const int sw = r32 & 7;
#pragma unroll
    for (int d0 = 0; d0 < 4; ++d0) {
        const int off = ((2 * d0 + hi) ^ sw) * 16;
        const bf16x8 b0 = *(const LAS bf16x8*)(k0 + off);
        const bf16x8 b1 = *(const LAS bf16x8*)(k1 + off);
        p0 = __builtin_amdgcn_mfma_f32_32x32x16_bf16(b0, qr[d0], p0, 0, 0, 0);
        p1 = __builtin_amdgcn_mfma_f32_32x32x16_bf16(b1, qr[d0], p1, 0, 0, 0);
    }
}
__device__ __forceinline__ float max3f(float a, float b, float c) { float r; asm("v_max3_f32 %0, %1, %2, %3" : "=v"(r) : "v"(a), "v"(b), "v"(c)); return r; }
__device__ __forceinline__ float max32(const f32x16& p0, const f32x16& p1) {
    float a = max3f(p0[0], p0[1], p1[0]), b = max3f(p0[2], p0[3], p1[1]); a = max3f(a, p1[2], p1[3]);
#pragma unroll
    for (int r = 4; r < 16; r += 4) { a = max3f(a, p0[r], p0[r + 1]); b = max3f(b, p0[r + 2], p0[r + 3]); a = max3f(a, p1[r], p1[r + 1]); b = max3f(b, p1[r + 2], p1[r + 3]); }
    float m; asm("v_max_f32_e32 %0, %1, %2" : "=v"(m) : "v"(a), "v"(b)); return m;
}
template <int NDB>
__device__ __forceinline__ void softmax_pv(f32x16 (&o)[NDB], float& mref, float& lrun, f32x16& p0, f32x16& p1, lds_cptr Vt, LAS float* wsf, int r32, int hi, int lane) {
    asm volatile("s_nop 15\n\ts_nop 7" : "+v"(p0), "+v"(p1));
    float rm = xhalf_max(max32(p0, p1));
    if (__any(rm > 8.f)) {
        const float dl = fmaxf(rm, 0.f); mref += dl;
#pragma unroll
        for (int r = 0; r < 16; ++r) { p0[r] -= dl; p1[r] -= dl; }
        const float f = __builtin_amdgcn_exp2f(-dl); lrun *= f;
        if (hi == 0) wsf[r32] = f;
#pragma unroll
        for (int r = 0; r < 16; ++r) { const float fr_ = wsf[crow(r, hi)];
#pragma unroll
            for (int db = 0; db < NDB; ++db) o[db][r] *= fr_; }
    }
    float s = 0.f;
#pragma unroll
    for (int r = 0; r < 16; ++r) { p0[r] = __builtin_amdgcn_exp2f(p0[r]); p1[r] = __builtin_amdgcn_exp2f(p1[r]); s += p0[r] + p1[r]; }
    lrun += s;
    u32x4 pw[4];
#pragma unroll
    for (int k = 0; k < 4; ++k) {
        pw[0][k] = cvtpk(p0[2 * k], p0[2 * k + 1]); pw[1][k] = cvtpk(p0[8 + 2 * k], p0[8 + 2 * k + 1]);
        pw[2][k] = cvtpk(p1[2 * k], p1[2 * k + 1]); pw[3][k] = cvtpk(p1[8 + 2 * k], p1[8 + 2 * k + 1]);
    }
    lds_cptr vp = Vt + ((lane >> 4) & 1) * 32 + (lane & 3) * 8 + (4 * hi + ((lane & 15) >> 2)) * 64;
#pragma unroll
    for (int db = 0; db < NDB; ++db) {
#pragma unroll
        for (int ks = 0; ks < 4; ++ks) {
            const s16x4 lo = vtr(vp + db * 4096 + ks * 1024), hh = vtr(vp + db * 4096 + ks * 1024 + 512);
            const bf16x8 vf = (bf16x8){lo[0], lo[1], lo[2], lo[3], hh[0], hh[1], hh[2], hh[3]};
            o[db] = __builtin_amdgcn_mfma_f32_32x32x16_bf16(__builtin_bit_cast(bf16x8, pw[ks]), vf, o[db], 0, 0, 0);
        }
    }
}

constexpr int AT_STAGE = 32768, AT_XCHG = 0, AT_STG = 65536, AT_WSF = 131072;
__device__ __forceinline__ void attnA_unit(const int b, const int h, const int qb, const int t0, const bf16_t* __restrict__ E, bf16_t* __restrict__ Y, const float lam, const float* __restrict__ subln, unsigned char* lds, unsigned* ctl) {
    int tid_ = threadIdx.x; asm volatile("" : "+v"(tid_));
    const int tid = tid_, lane = tid & 63, r32 = lane & 31, hi = lane >> 5; const int wid = __builtin_amdgcn_readfirstlane(tid >> 6);
    const int mm = wid >> 2, rb = wid & 3;
    const int q0w = 128 * qb + 32 * rb, iq = q0w + r32, NT = 2 * (qb + 1);
    const bf16_t* Eb = E + (size_t)b * SEQ * EP;
    const unsigned lds0 = (unsigned)(uintptr_t)(LAS unsigned char*)lds;
    lds_cptr L = (lds_cptr)(LAS unsigned char*)lds;
    LAS float* wsf = (LAS float*)((LAS unsigned char*)lds + AT_WSF) + wid * 64;
    const bf16_t* src[4]; unsigned dsto[4];
#pragma unroll
    for (int i4 = 0; i4 < 4; ++i4) {
        if (wid < 4) { const int pidx = wid * 4 + i4, m_ = pidx >> 3, rg8 = pidx & 7, rowl = lane >> 3, cg = (lane & 7) ^ rowl;
            src[i4] = Eb + (size_t)(8 * rg8 + rowl) * EP + C_AK + h * 128 + m_ * 64 + cg * 8; dsto[i4] = m_ * 8192 + rg8 * 1024; }
        else { const int pidx = (wid - 4) * 4 + i4, db = pidx >> 2, rg = pidx & 3;
            src[i4] = Eb + (size_t)(16 * rg + (lane >> 2)) * EP + C_AV + h * 128 + db * 32 + (lane & 3) * 8; dsto[i4] = 16384 + db * 4096 + rg * 1024; }
    }
#define AT_DMA(t, stg) do { _Pragma("unroll") for (int i4 = 0; i4 < 4; ++i4) glds16(src[i4] + (size_t)(t) * 64 * EP, (unsigned)__builtin_amdgcn_readfirstlane(lds0 + (stg) * AT_STAGE + dsto[i4])); } while (0)
    const int p0i = t0 >> 1, NP = NT >> 1;
    AT_DMA(2 * p0i, 0); AT_DMA(2 * p0i + 1, 1);
    bf16x8 qr[4];
    { const bf16_t* Qw = Eb + (size_t)iq * EP + C_AQ + h * 128 + mm * 64;
#pragma unroll
      for (int d0 = 0; d0 < 4; ++d0) qr[d0] = *(const bf16x8*)(Qw + d0 * 16 + hi * 8); }
    const float slope2 = __builtin_amdgcn_exp2f(-2.f * (float)(h + 1)) * LOG2E;
    f32x16 o[4];
#pragma unroll
    for (int db = 0; db < 4; ++db) o[db] = f32x16{};
    float mref = 0.f, lrun = 0.f;
    for (int pp = p0i; pp < NP; ++pp) {
        WAITV_BAR();
        if (pp + 1 < NP) { const int sb = 2 * ((pp + 1 - p0i) & 1); AT_DMA(2 * pp + 2, sb); AT_DMA(2 * pp + 3, sb + 1); }
#pragma unroll 1
        for (int tt = 0; tt < 2; ++tt) {
        const int t = 2 * pp + tt;
        if (64 * t <= q0w + 31) {
            lds_cptr st = L + (2 * ((pp - p0i) & 1) + tt) * AT_STAGE;
            const float tbm = slope2 * (float)(64 * t - iq) - mref;
            f32x16 p0, p1;
#pragma unroll
            for (int r = 0; r < 16; ++r) { p0[r] = tbm + slope2 * (float)crow(r, hi); p1[r] = p0[r] + 32.f * slope2; }
            qk_tile_rm(p0, p1, st + mm * 8192, qr, r32, hi);
            if (64 * t + 63 > q0w) {
                const int kb = 64 * t + 4 * hi;
#pragma unroll
                for (int r = 0; r < 16; ++r) { const int kv = kb + (r & 3) + 8 * (r >> 2); if (kv > iq) p0[r] = -1e30f; if (kv + 32 > iq) p1[r] = -1e30f; }
            }
            softmax_pv<4>(o, mref, lrun, p0, p1, st + 16384, wsf, r32, hi, lane);
        }
        }
    }
#undef AT_DMA
    lrun = xhalf_sum(lrun);
    if (hi == 0) wsf[r32] = lrun;
    float rli[16];
#pragma unroll
    for (int r = 0; r < 16; ++r) rli[r] = __builtin_amdgcn_rcpf(wsf[crow(r, hi)]);
    LAS float* xb = (LAS float*)((LAS unsigned char*)lds + AT_XCHG) + rb * 4096;
    WAITL_BAR();
    if (mm == 1) {
#pragma unroll
        for (int db = 0; db < 4; ++db)
#pragma unroll
            for (int r = 0; r < 16; ++r) xb[(db * 16 + r) * 64 + lane] = o[db][r] * rli[r] * lam;
    }
    WAITL_BAR();
    if (mm == 0) {
        float ss[16];
#pragma unroll
        for (int r = 0; r < 16; ++r) ss[r] = 0.f;
#pragma unroll
        for (int db = 0; db < 4; ++db)
#pragma unroll
            for (int r = 0; r < 16; ++r) { const float dv = o[db][r] * rli[r] - xb[(db * 16 + r) * 64 + lane]; o[db][r] = dv; ss[r] += dv * dv; }
        LAS float* prt = (LAS float*)((LAS unsigned char*)lds + AT_STG + 32768) + rb * 1152;
#pragma unroll
        for (int r = 0; r < 16; ++r) prt[crow(r, hi) * 36 + r32] = ss[r];
        if (hi == 0) { float tot = 0.f;
#pragma unroll
            for (int k4 = 0; k4 < 8; ++k4) { const f32x4 pv = *(const LAS f32x4*)(prt + r32 * 36 + 4 * k4); tot += (pv[0] + pv[1]) + (pv[2] + pv[3]); }
            wsf[r32] = __builtin_amdgcn_rsqf(tot * (1.f / 128.f) + EPS) * 0.8f; }
#pragma unroll
        for (int r = 0; r < 16; ++r) ss[r] = wsf[crow(r, hi)];
        LAS bf16_t* stg = (LAS bf16_t*)((LAS unsigned char*)lds + AT_STG) + rb * 4096;
#pragma unroll
        for (int db = 0; db < 4; ++db) { const float gsub = subln[db * 32 + r32];
#pragma unroll
            for (int r = 0; r < 16; ++r) stg[crow(r, hi) * 128 + db * 32 + r32] = f2bf(o[db][r] * ss[r] * gsub); }
        bf16_t* Yw = Y + (size_t)(b * SEQ + q0w) * D + h * 128;
#pragma unroll
        for (int i8 = 0; i8 < 8; ++i8) { const int row = i8 * 4 + (lane >> 4), ch = lane & 15; const u32x4 v = *(const LAS u32x4*)(stg + row * 128 + ch * 8);
            *(u32x4*)(Yw + (size_t)row * D + ch * 8) = v; }
    }
    WAITL_BAR();
}

constexpr int SW_V = 32768, SW_OST = 65536;
__device__ __forceinline__ void swa_unit(const int b, const int kvh, const int nb, const bf16_t* __restrict__ E1, bf16_t* __restrict__ Y, const float* __restrict__ qn_c, const float* __restrict__ kn_c,
                                         const float* __restrict__ sinks, unsigned char* lds, unsigned* ctl) {
    TSTART(41)
    int tid_ = threadIdx.x; asm volatile("" : "+v"(tid_));
    const int tid = tid_, lane = tid & 63, r32 = lane & 31, hi = lane >> 5; const int wid = __builtin_amdgcn_readfirstlane(tid >> 6);
    const bf16_t* Eb = E1 + (size_t)b * SEQ * OP;
    LAS unsigned char* l3 = (LAS unsigned char*)lds;
    lds_cptr L = (lds_cptr)l3;
    LAS float* wsf = (LAS float*)(l3 + AT_WSF) + wid * 64;
    const int kt0 = (nb == 0) ? 2 : 0;
    {
        const int sub = lane & 7, rowi = tid >> 3;
        float kg[8];
#pragma unroll
        for (int i = 0; i < 8; ++i) kg[i] = kn_c[sub * 8 + i];
        for (int kt = kt0; kt < 4; ++kt) {
            const int key = 128 * (nb - 1) + 64 * kt + rowi;
            const u32x4 kr = *(const u32x4*)(Eb + (size_t)key * OP + C1_K + kvh * 64 + sub * 8);
            const u32x4 vr = *(const u32x4*)(Eb + (size_t)key * OP + C1_V + kvh * 64 + sub * 8);
            float v[8];
            v[0] = __uint_as_float(kr.x << 16); v[1] = __uint_as_float(kr.x & 0xffff0000u); v[2] = __uint_as_float(kr.y << 16); v[3] = __uint_as_float(kr.y & 0xffff0000u);
            v[4] = __uint_as_float(kr.z << 16); v[5] = __uint_as_float(kr.z & 0xffff0000u); v[6] = __uint_as_float(kr.w << 16); v[7] = __uint_as_float(kr.w & 0xffff0000u);
            float ss = 0.f;
#pragma unroll
            for (int i = 0; i < 8; ++i) ss += v[i] * v[i];
            ss += __shfl_xor(ss, 1); ss += __shfl_xor(ss, 2); ss += __shfl_xor(ss, 4);
            const float rr = __builtin_amdgcn_rsqf(ss * (1.f / 64.f) + EPS);
            u32x4 kw;
            kw.x = cvtpk(v[0] * rr * kg[0], v[1] * rr * kg[1]); kw.y = cvtpk(v[2] * rr * kg[2], v[3] * rr * kg[3]);
            kw.z = cvtpk(v[4] * rr * kg[4], v[5] * rr * kg[5]); kw.w = cvtpk(v[6] * rr * kg[6], v[7] * rr * kg[7]);
            *(LAS u32x4*)(l3 + kt * 8192 + sub * 1024 + rowi * 16) = kw;
            *(LAS u32x4*)(l3 + SW_V + kt * 8192 + (sub >> 2) * 4096 + (rowi >> 4) * 1024 + (rowi & 15) * 64 + (sub & 3) * 16) = vr;
        }
    }
    WAITL_BAR();
    TSTOP(41, ctl)
    TSTART(42)
    const int g = wid >> 1, head = kvh * 4 + g;
    const float slope2 = __builtin_amdgcn_exp2f(-0.5f * (float)(head + 1)) * LOG2E;
    const float sink2 = sinks[head] * LOG2E;
    float qg[4][8];
#pragma unroll
    for (int d0 = 0; d0 < 4; ++d0)
#pragma unroll
        for (int i = 0; i < 8; ++i) qg[d0][i] = qn_c[d0 * 16 + hi * 8 + i] * QS;
    for (int rbi = 0; rbi < 2; ++rbi) {
        const int rb = 2 * (wid & 1) + rbi, rloc = 32 * rb + r32;
        const int tok = b * SEQ + 128 * nb + rloc;
        bf16x8 qr[4];
        { const bf16_t* Qw = E1 + (size_t)tok * OP + C1_Q + head * 64; u32x4 raw[4]; float ss = 0.f;
#pragma unroll
          for (int d0 = 0; d0 < 4; ++d0) { raw[d0] = *(const u32x4*)(Qw + d0 * 16 + hi * 8);
#pragma unroll
              for (int k = 0; k < 4; ++k) { const float a = __uint_as_float(raw[d0][k] << 16), c = __uint_as_float(raw[d0][k] & 0xffff0000u); ss += a * a + c * c; } }
          ss = xhalf_sum(ss);
          const float rr = __builtin_amdgcn_rsqf(ss * (1.f / 64.f) + EPS);
#pragma unroll
          for (int d0 = 0; d0 < 4; ++d0) { u32x4 w;
#pragma unroll
              for (int k = 0; k < 4; ++k) { const float a = __uint_as_float(raw[d0][k] << 16), c = __uint_as_float(raw[d0][k] & 0xffff0000u);
                  w[k] = cvtpk(a * rr * qg[d0][2 * k], c * rr * qg[d0][2 * k + 1]); }
              qr[d0] = __builtin_bit_cast(bf16x8, w); } }
        f32x16 o[2]; o[0] = f32x16{}; o[1] = f32x16{};
        float mref = 0.f, lrun = 0.f;
        const int ktlo = (rb < 2) ? 0 : 1, kthi = (rb < 2) ? 2 : 3;
        for (int kt = ktlo; kt <= kthi; ++kt) {
            if (kt < kt0) continue;
            const float tbm = slope2 * (float)(64 * kt - 128 - rloc) - mref;
            f32x16 p0, p1;
#pragma unroll
            for (int r = 0; r < 16; ++r) { p0[r] = tbm + slope2 * (float)crow(r, hi); p1[r] = p0[r] + 32.f * slope2; }
            qk_tile(p0, p1, L + kt * 8192, qr, r32, hi);
            const int jb = 64 * kt + 4 * hi;
            if (!(64 * kt >= 32 * rb + 32 && 64 * kt + 63 <= 32 * rb + 128))
#pragma unroll
            for (int r = 0; r < 16; ++r) { const int jj = jb + (r & 3) + 8 * (r >> 2);
                if (jj < rloc + 1 || jj > rloc + 128) p0[r] = -1e30f;
                if (jj + 32 < rloc + 1 || jj + 32 > rloc + 128) p1[r] = -1e30f; }
            softmax_pv<2>(o, mref, lrun, p0, p1, L + SW_V + kt * 8192, wsf, r32, hi, lane);
        }
        lrun = xhalf_sum(lrun) + __builtin_amdgcn_exp2f(sink2 - mref);
        if (hi == 0) wsf[r32] = lrun;
        LAS bf16_t* stg = (LAS bf16_t*)(l3 + SW_OST) + wid * 2048;
#pragma unroll
        for (int r = 0; r < 16; ++r) { const float rl = __builtin_amdgcn_rcpf(wsf[crow(r, hi)]);
#pragma unroll
            for (int db = 0; db < 2; ++db) stg[crow(r, hi) * 64 + db * 32 + r32] = f2bf(o[db][r] * rl); }
        bf16_t* Yw = Y + (size_t)(b * SEQ + 128 * nb + 32 * rb) * D + head * 64;
#pragma unroll
        for (int i4 = 0; i4 < 4; ++i4) { const int row = i4 * 8 + (lane >> 3), ch = lane & 7; const u32x4 v = *(const LAS u32x4*)(stg + row * 64 + ch * 8);
            *(u32x4*)(Yw + (size_t)row * D + ch * 8) = v; }
    }
    TSTOP(42, ctl)
    TSTART(43)
    WAITL_BAR();
    TSTOP(43, ctl)
}

constexpr int DS_KSTR = 4096, DS_QROW = DS_KSTR * 4;
constexpr int DS_STG = 131072;
#define MFMA16(a, b, c) __builtin_amdgcn_mfma_f32_16x16x32_bf16((a), (b), (c), 0, 0, 0)
#ifndef DSA_REP1
#define DSA_REP1 1
#endif
#ifndef DSA_REP2
#define DSA_REP2 1
#endif
#ifndef DSA_REP3
#define DSA_REP3 1
#endif
__device__ __forceinline__ int pick_digit(const u32x4 hv, int& remaining, int lane) {
    const int s = (int)(hv[0] + hv[1] + hv[2] + hv[3]);
    int suf = s;
#pragma unroll
    for (int off = 1; off < 64; off <<= 1) { const int tv = __shfl_down(suf, off); if (lane + off < 64) suf += tv; }
    int cum = suf - s, found = -1, remn = 0;
#pragma unroll
    for (int d = 3; d >= 0; --d) { const int c = (int)hv[d]; if (found < 0 && cum < remaining && cum + c >= remaining) { found = 4 * lane + d; remn = remaining - cum; } cum += c; }
    const unsigned long long bal = __ballot(found >= 0);
    const int srcl = (int)__ffsll((long long)bal) - 1;
    remaining = __shfl(remn, srcl);
    return __shfl(found, srcl);
}
__device__ __forceinline__ void dsa_unit(const int b, const int i0, const bf16_t* __restrict__ E, const bf16_t* __restrict__ KC3, const unsigned* __restrict__ SGN, bf16_t* __restrict__ Y, unsigned char* lds, unsigned* ctl) {
    int tid_ = threadIdx.x; asm volatile("" : "+v"(tid_));
    const int tid = tid_, lane = tid & 63, kq = lane >> 4, c16 = lane & 15; const int wid = __builtin_amdgcn_readfirstlane(tid >> 6);
    LAS unsigned char* l3 = (LAS unsigned char*)lds;
    LAS unsigned* keys = (LAS unsigned*)l3;
    const bf16_t* Eb = E + (size_t)b * SEQ * EP;
    const int nt32 = (i0 + 8 + 31) >> 5, n16 = nt32 * 32;
    const int nblk = (n16 + 511) >> 9;
    TSTART(1)
    for (int rep1 = 0; rep1 < DSA_REP1; ++rep1)
    {
        const int r32 = lane & 31, hi = lane >> 5;
        TSTART(11)
        bf16x8 Aq[2][4];
        { const int qa = r32 >> 3, ha = r32 & 7;
#pragma unroll
          for (int rb = 0; rb < 2; ++rb)
#pragma unroll
            for (int d0 = 0; d0 < 4; ++d0) Aq[rb][d0] = *(const bf16x8*)(E + ((size_t)b * SEQ + i0 + 4 * rb + qa) * EP + C_IQ + ha * 64 + d0 * 16 + hi * 8); }
        float wq[8][4];
#pragma unroll
        for (int q = 0; q < 8; ++q) { const u32x2 wr_ = *(const u32x2*)(E + ((size_t)b * SEQ + i0 + q) * EP + C_IW + 4 * hi);
            wq[q][0] = __uint_as_float(wr_[0] << 16) * IS; wq[q][1] = __uint_as_float(wr_[0] & 0xffff0000u) * IS; wq[q][2] = __uint_as_float(wr_[1] << 16) * IS; wq[q][3] = __uint_as_float(wr_[1] & 0xffff0000u) * IS; }
        const int row8 = lane >> 3, ch8 = lane & 7;
        const char* kbase = (const char*)(KC3 + ((size_t)b * SEQ + row8) * 64 + ch8 * 8);
        LAS unsigned char* sb = l3 + DS_STG + wid * 4096;
        LAS unsigned char* sbw = sb + row8 * 128 + ((ch8 ^ row8) * 16);
        LAS const unsigned char* sbr = sb + r32 * 128;
        LAS unsigned* kout = keys + (4 * (1 - hi)) * DS_KSTR + r32;
        u32x4 nkc[4];
        { const int t = wid < nt32 ? wid : nt32 - 1; const char* kr = kbase + (unsigned)(t * (32 * 64 * 2));
#pragma unroll
          for (int i = 0; i < 4; ++i) nkc[i] = *(const u32x4*)(kr + i * 1024); }
        for (int x4 = (n16 >> 2) + tid; x4 < 128 * nblk; x4 += 512) {
#pragma unroll
            for (int qq = 0; qq < 8; ++qq) *(LAS u32x4*)(keys + qq * DS_KSTR + 4 * x4) = (u32x4){0u, 0u, 0u, 0u};
        }
        TSTOP(11, ctl)
        TSTART(12)
        for (int t = wid; t < nt32; t += 8) {
#pragma unroll
            for (int i = 0; i < 4; ++i) *(LAS u32x4*)(sbw + i * 1024) = nkc[i];
            { int tn = t + 8; tn = tn < nt32 ? tn : nt32 - 1; const char* kr = kbase + (unsigned)(tn * (32 * 64 * 2));
#pragma unroll
              for (int i = 0; i < 4; ++i) nkc[i] = *(const u32x4*)(kr + i * 1024); }
            bf16x8 bk_[4];
#pragma unroll
            for (int d0 = 0; d0 < 4; ++d0) bk_[d0] = *(const LAS bf16x8*)(sbr + (((2 * d0 + hi) ^ (r32 & 7)) * 16));
            float part[2][4];
#pragma unroll
            for (int rb = 0; rb < 2; ++rb) {
                f32x16 dacc = f32x16{};
#pragma unroll
                for (int d0 = 0; d0 < 4; ++d0) dacc = __builtin_amdgcn_mfma_f32_32x32x16_bf16(Aq[rb][d0], bk_[d0], dacc, 0, 0, 0);
#pragma unroll
                for (int qq = 0; qq < 4; ++qq) { float a = 0.f;
#pragma unroll
                    for (int j = 0; j < 4; ++j) { const float xv_ = dacc[4 * qq + j]; const int xb_ = __float_as_int(xv_); a = __builtin_fmaf(wq[4 * rb + qq][j], __int_as_float(xb_ > 0 ? xb_ : 0), a); }
                    part[rb][qq] = a; }
            }
            const int key = 32 * t + r32;
#pragma unroll
            for (int qq = 0; qq < 4; ++qq) {
                auto rr = __builtin_amdgcn_permlane32_swap(__float_as_uint(part[1][qq]), __float_as_uint(part[0][qq]), false, false);
                float sv = __uint_as_float(rr[0]) + __uint_as_float(rr[1]); sv += 0.0f;
                const unsigned u = __float_as_uint(sv); unsigned kc = u ^ ((unsigned)((int)u >> 31) | 0x80000000u);
                if (32 * t + 31 > i0) kc = (key <= i0 + 4 * (1 - hi) + qq) ? kc : 0u;
                kout[qq * DS_KSTR + 32 * t] = kc; }
        }
    }
    TSTOP(12, ctl)
    TSTART(16)
    WAITL_BAR();
    TSTOP(16, ctl)
    TSTOP(1, ctl)
    TSTART(2)
    const int qi = i0 + wid, nq = qi + 1;
    LAS unsigned short* list = (LAS unsigned short*)(l3 + DS_STG + wid * 4096);
    int cnt = 0;
    {
        TSTART(21)
        LAS unsigned* myk = keys + wid * DS_KSTR;
        unsigned kreg[64];
#pragma unroll
        for (int blk = 0; blk < 8; ++blk) {
            if (blk < nblk) {
#pragma unroll
                for (int i = 8 * blk; i < 8 * blk + 8; ++i) kreg[i] = myk[64 * i + lane];
            } else {
#pragma unroll
                for (int i = 8 * blk; i < 8 * blk + 8; ++i) kreg[i] = 0u;
            }
        }
        unsigned T = 0u; int need = 0;
        asm volatile("s_waitcnt lgkmcnt(0)" ::: "memory");
        TSTOP(21, ctl)
        if (nq > 256) {
            TSTART(22)
            constexpr int TB = 10, SH = 32 - TB;
            unsigned gmx[16];
#pragma unroll
            for (int g = 0; g < 16; ++g) { const unsigned m0 = kreg[4 * g] > kreg[4 * g + 1] ? kreg[4 * g] : kreg[4 * g + 1], m1 = kreg[4 * g + 2] > kreg[4 * g + 3] ? kreg[4 * g + 2] : kreg[4 * g + 3]; gmx[g] = m0 > m1 ? m0 : m1; }
            unsigned dg = 0u;
#pragma unroll 1
            for (int bit = TB - 1; bit >= 0; --bit) {
                const unsigned cand = dg | (1u << bit), lim = cand << SH; int c = 0;
#pragma unroll
                for (int g = 0; g < 16; ++g) c += __popcll(__ballot(gmx[g] >= lim));
                if (c >= 256) dg = cand;
            }
            const unsigned Lb = dg << SH;
            TSTOP(22, ctl)
            TSTART(23)
            int ncand = 0;
#pragma unroll
            for (int blk = 0; blk < 8; ++blk) {
                if (blk < nblk) {
                    unsigned long long bm[8]; int off[8];
#pragma unroll
                    for (int j = 0; j < 8; ++j) bm[j] = __ballot(kreg[8 * blk + j] >= Lb);
                    __builtin_amdgcn_sched_barrier(0);
#pragma unroll
                    for (int j = 0; j < 8; ++j) { off[j] = ncand; ncand += __popcll(bm[j]); }
                    __builtin_amdgcn_sched_barrier(0);
#pragma unroll
                    for (int j = 0; j < 8; ++j) { const unsigned k = kreg[8 * blk + j];
                        const int pos = (int)__builtin_amdgcn_mbcnt_hi((unsigned)(bm[j] >> 32), __builtin_amdgcn_mbcnt_lo((unsigned)bm[j], (unsigned)off[j]));
                        myk[(k >= Lb) ? pos : 4095] = k; }
                    __builtin_amdgcn_sched_barrier(0);
                }
            }
            const int ncr = (ncand + 63) >> 6;
            if (ncand + lane < 64 * ncr) myk[ncand + lane] = 0u;
            asm volatile("s_waitcnt lgkmcnt(0)" ::: "memory");
            TSTOP(23, ctl)
            TSTART(24)
            unsigned prefix = 0u; int remaining = 0; bool exact = false;
            if (ncr <= 8) {
                unsigned cr[8];
#pragma unroll
                for (int r = 0; r < 8; ++r) cr[r] = (r < ncr) ? myk[64 * r + lane] : 0u;
#pragma unroll 1
                for (int bit = 31; bit >= 0; --bit) {
                    const unsigned cand = prefix | (1u << bit); int c = 0;
#pragma unroll
                    for (int r = 0; r < 8; ++r) c += __popcll(__ballot(cr[r] >= cand));
                    if (c >= 256) { prefix = cand; if (c == 256) { exact = true; break; } }
                }
                if (!exact) { int c2 = 0;
#pragma unroll
                    for (int r = 0; r < 8; ++r) c2 += __popcll(__ballot(cr[r] > prefix));
                    remaining = 256 - c2; }
            } else {
#pragma unroll 1
                for (int bit = 31; bit >= 0; --bit) {
                    const unsigned cand = prefix | (1u << bit); int c = 0;
                    for (int r = 0; r < ncr; ++r) c += __popcll(__ballot(myk[64 * r + lane] >= cand));
                    if (c >= 256) { prefix = cand; if (c == 256) { exact = true; break; } }
                }
                if (!exact) { int c2 = 0; for (int r = 0; r < ncr; ++r) c2 += __popcll(__ballot(myk[64 * r + lane] > prefix)); remaining = 256 - c2; }
            }
            if (exact) { prefix -= 1u; remaining = 0; }
            T = prefix; need = remaining;
            TSTOP(24, ctl)
        }
        TSTART(25)
        int basep = 0;
#pragma unroll
        for (int blk = 0; blk < 8; ++blk) {
            if (blk < nblk) {
                unsigned long long bs[8]; int off[8];
#pragma unroll
                for (int j = 0; j < 8; ++j) bs[j] = __ballot(kreg[8 * blk + j] > T);
                __builtin_amdgcn_sched_barrier(0);
#pragma unroll
                for (int j = 0; j < 8; ++j) { off[j] = basep; basep += __popcll(bs[j]); }
                __builtin_amdgcn_sched_barrier(0);
#pragma unroll
                for (int j = 0; j < 8; ++j) {
                    const int pos = (int)__builtin_amdgcn_mbcnt_hi((unsigned)(bs[j] >> 32), __builtin_amdgcn_mbcnt_lo((unsigned)bs[j], (unsigned)off[j]));
                    list[(kreg[8 * blk + j] > T) ? pos : 319] = (unsigned short)(64 * (8 * blk + j) + lane); }
                __builtin_amdgcn_sched_barrier(0);
            }
        }
        if (nq > 256) {
#pragma unroll
            for (int blk = 0; blk < 8; ++blk) {
                if (blk < nblk) {
                    unsigned long long any = 0ull;
#pragma unroll
                    for (int i = 8 * blk; i < 8 * blk + 8; ++i) any |= __ballot(kreg[i] == T);
                    if (any != 0ull) {
#pragma unroll
                        for (int i = 8 * blk; i < 8 * blk + 8; ++i) {
                            const bool eq = kreg[i] == T;
                            const unsigned long long be = __ballot(eq);
                            const int rank = (int)__builtin_amdgcn_mbcnt_hi((unsigned)(be >> 32), __builtin_amdgcn_mbcnt_lo((unsigned)be, 0u));
                            const bool sel = eq && rank < need;
                            list[sel ? basep + rank : 319] = (unsigned short)(64 * i + lane);
                            int c = __popcll(be); c = c < need ? c : need;
                            basep += c; need -= c;
                        }
                    }
                }
            }
        }
        cnt = basep < 256 ? basep : 256;
        for (int s2 = cnt + lane; s2 < 256; s2 += 64) list[s2] = (unsigned short)0;
        TSTOP(25, ctl)
    }
    asm volatile("s_waitcnt lgkmcnt(0)" ::: "memory");
    TSTOP(2, ctl)
    TSTART(3)
    for (int rep3 = 0; rep3 < DSA_REP3; ++rep3)
    {
        TSTART(13)
        const size_t tok = (size_t)b * SEQ + qi; const int hd = c16 & 7;
        bf16x8 Bb[2];
#pragma unroll
        for (int ks = 0; ks < 2; ++ks) Bb[ks] = *(const bf16x8*)(E + tok * EP + C_BQ + hd * 64 + ks * 32 + kq * 8);
        const float slope2 = __builtin_amdgcn_exp2f(-(float)(hd + 1)) * LOG2E;
        LAS unsigned char* vst = l3 + wid * DS_QROW;
        const char* Ebk = (const char*)(KC3 + (size_t)M * 64 + (size_t)b * SEQ * 64) + kq * 16;
        const char* Ebv = (const char*)(KC3 + (size_t)2 * M * 64 + (size_t)b * SEQ * 64) + (lane & 7) * 16;
        u32x4 vreg[8];
#define DS_VLOAD(c4_) do { _Pragma("unroll") for (int it = 0; it < 8; ++it) { const unsigned j_ = list[64 * (c4_) + 8 * it + (lane >> 3)]; \
            vreg[it] = *(const u32x4*)(Ebv + j_ * 128u); } } while (0)
        DS_VLOAD(0);
        f32x4 lg[4][4];
#pragma unroll
        for (int hf = 0; hf < 2; ++hf) {
            bf16x8 ka0[8], ka1[8];
#pragma unroll
            for (int e = 0; e < 8; ++e) { const unsigned j = list[128 * hf + 16 * e + c16];
                const char* kr = Ebk + j * 128u; ka0[e] = *(const bf16x8*)kr; ka1[e] = *(const bf16x8*)(kr + 64); }
#pragma unroll
            for (int e = 0; e < 8; ++e) { const int c4 = 2 * hf + (e >> 2), tt = e & 3;
                f32x4 acc = MFMA16(ka0[e], Bb[0], ((f32x4){0.f, 0.f, 0.f, 0.f})); acc = MFMA16(ka1[e], Bb[1], acc);
                const int s0 = 64 * c4 + 16 * tt + 4 * kq;
                const u32x2 jl = *(const LAS u32x2*)(list + s0);
                const int j0 = jl[0] & 0xffff, j1 = jl[0] >> 16, j2 = jl[1] & 0xffff, j3 = jl[1] >> 16;
                lg[c4][tt][0] = (s0 + 0 < cnt) ? acc[0] + slope2 * (float)(j0 - qi) : -1e30f;
                lg[c4][tt][1] = (s0 + 1 < cnt) ? acc[1] + slope2 * (float)(j1 - qi) : -1e30f;
                lg[c4][tt][2] = (s0 + 2 < cnt) ? acc[2] + slope2 * (float)(j2 - qi) : -1e30f;
                lg[c4][tt][3] = (s0 + 3 < cnt) ? acc[3] + slope2 * (float)(j3 - qi) : -1e30f; }
        }
        float mx = -1e30f;
#pragma unroll
        for (int c4 = 0; c4 < 4; ++c4)
#pragma unroll
            for (int tt = 0; tt < 4; ++tt)
#pragma unroll
                for (int r = 0; r < 4; ++r) mx = fmaxf(mx, lg[c4][tt][r]);
        mx = fmaxf(mx, __shfl_xor(mx, 16)); mx = fmaxf(mx, __shfl_xor(mx, 32));
        float sum = 0.f;
#pragma unroll
        for (int c4 = 0; c4 < 4; ++c4)
#pragma unroll
            for (int tt = 0; tt < 4; ++tt)
#pragma unroll
                for (int r = 0; r < 4; ++r) { const float e = __builtin_amdgcn_exp2f(lg[c4][tt][r] - mx); lg[c4][tt][r] = e; sum += e; }
        sum += __shfl_xor(sum, 16); sum += __shfl_xor(sum, 32);
        const float inv = __builtin_amdgcn_rcpf(sum);
        TSTOP(13, ctl)
        TSTART(14)
        f32x4 oacc[4];
#pragma unroll
        for (int dt = 0; dt < 4; ++dt) oacc[dt] = (f32x4){0.f, 0.f, 0.f, 0.f};
        const int qp = c16 >> 2, pp4 = c16 & 3;
#pragma unroll
        for (int c4 = 0; c4 < 4; ++c4) {
#pragma unroll
            for (int it = 0; it < 8; ++it) { const int row = 8 * it + (lane >> 3), ch = lane & 7; *(LAS u32x4*)(vst + row * 128 + ((ch ^ (row & 7)) * 16)) = vreg[it]; }
            if (c4 < 3) DS_VLOAD(c4 + 1);
            asm volatile("" ::: "memory");
#pragma unroll
            for (int pp = 0; pp < 2; ++pp) {
                const f32x4 l0 = lg[c4][2 * pp] * inv, l1 = lg[c4][2 * pp + 1] * inv;
                u32x4 pw; pw[0] = cvtpk(l0[0], l0[1]); pw[1] = cvtpk(l0[2], l0[3]); pw[2] = cvtpk(l1[0], l1[1]); pw[3] = cvtpk(l1[2], l1[3]);
                const int rlo = 32 * pp + 4 * kq + qp, rhi = rlo + 16;
#pragma unroll
                for (int dt = 0; dt < 4; ++dt) { const int chunk = 2 * dt + (pp4 >> 1);
                    const s16x4 lo = vtr((lds_cptr)(vst + rlo * 128 + ((chunk ^ (rlo & 7)) * 16) + (pp4 & 1) * 8));
                    const s16x4 hh = vtr((lds_cptr)(vst + rhi * 128 + ((chunk ^ (rhi & 7)) * 16) + (pp4 & 1) * 8));
                    const bf16x8 vf = (bf16x8){lo[0], lo[1], lo[2], lo[3], hh[0], hh[1], hh[2], hh[3]};
                    oacc[dt] = MFMA16(vf, __builtin_bit_cast(bf16x8, pw), oacc[dt]); }
            }
            asm volatile("" ::: "memory");
        }
#undef DS_VLOAD
        if (c16 < 8) {
            bf16_t* yo = Y + tok * D + 512 + hd * 64 + 4 * kq;
#pragma unroll
            for (int dt = 0; dt < 4; ++dt) { u32x2 w; w[0] = cvtpk(oacc[dt][0], oacc[dt][1]); w[1] = cvtpk(oacc[dt][2], oacc[dt][3]); *(u32x2*)(yo + 16 * dt) = w; }
        }
    }
    TSTOP(14, ctl)
    TSTOP(3, ctl)
    TSTART(4)
    WAITL_BAR();
    TSTOP(4, ctl)
}

#define XB_TMO      128
#define XB_XCNT(j)  (256  + 64 * (j))
#define XB_XSUB(j)  (1280 + 64 * (j))
#define XB_XGEN(j)  (2304 + 64 * (j))
#define XB_TOP      3328
#define XB_TOPGEN   3392
#define XCD_BAR_WORDS 3456
#define XB_SPIN_CAP (1u << 18)
__device__ __forceinline__ unsigned xb_ld(unsigned* p)              { return __hip_atomic_load(p, __ATOMIC_RELAXED, __HIP_MEMORY_SCOPE_AGENT); }
__device__ __forceinline__ unsigned xb_add(unsigned* p, unsigned v) { return __hip_atomic_fetch_add(p, v, __ATOMIC_RELAXED, __HIP_MEMORY_SCOPE_AGENT); }
__device__ __forceinline__ unsigned xb_xcc_id() { return (unsigned)__builtin_amdgcn_s_getreg((3 << 11) | 20) & 0xFu; }
#define XB_SPIN(cond, bar) do { unsigned _sp = 0; while (cond) { __builtin_amdgcn_s_sleep(1); \
    if ((++_sp & 255u) == 0u) { if (xb_ld(&(bar)[XB_TMO])) break; if (_sp > XB_SPIN_CAP) { atomicAdd(&(bar)[XB_TMO], 1u); break; } } } } while (0)
struct XcdBarrier { unsigned* bar; unsigned x; volatile LAS unsigned* st; };
__device__ __forceinline__ XcdBarrier xcd_barrier_post(unsigned* bar, volatile LAS unsigned* st) {
    XcdBarrier b; b.bar = bar; b.x = xb_xcc_id(); b.st = st;
    if (threadIdx.x == 0) (void)xb_add(&bar[XB_XCNT(b.x)], 1u);
    return b;
}
__device__ __forceinline__ void xcd_barrier_complete(unsigned* bar, unsigned x, unsigned& nloc, unsigned& nx) {
    const unsigned G = gridDim.x * gridDim.y * gridDim.z;
    unsigned sum, cnt, mine, sp = 0u;
    for (;;) {
        sum = 0u; cnt = 0u; mine = 0u;
#pragma unroll
        for (unsigned j = 0; j < 16; ++j) { const unsigned c = xb_ld(&bar[XB_XCNT(j)]); sum += c; cnt += (c > 0u) ? 1u : 0u; mine = (j == x) ? c : mine; }
        if (sum == G) break;
        __builtin_amdgcn_s_sleep(1);
        if ((++sp & 255u) == 0u) { if (xb_ld(&bar[XB_TMO])) break; if (sp > XB_SPIN_CAP) { atomicAdd(&bar[XB_TMO], 1u); break; } }
    }
    nloc = mine > 0u ? mine : 1u; nx = cnt > 0u ? cnt : 1u;
}
__device__ __forceinline__ void xcd_barrier(const XcdBarrier& b) {
    asm volatile("s_waitcnt vmcnt(0)" ::: "memory");
    __syncthreads();
    if (threadIdx.x == 0) {
        unsigned* bar = b.bar;
        __builtin_amdgcn_s_waitcnt(0);
        unsigned nloc = b.st[0], nx = b.st[1];
        if (nloc == 0u) { xcd_barrier_complete(bar, b.x, nloc, nx); b.st[0] = nloc; b.st[1] = nx; }
        const unsigned old = xb_add(&bar[XB_XSUB(b.x)], 1u);
        const unsigned gen = old / nloc;
        if (old + 1u == (gen + 1u) * nloc) {
            __builtin_amdgcn_fence(__ATOMIC_RELEASE, "agent");
            asm volatile("s_waitcnt vmcnt(0)" ::: "memory");
            const unsigned og = xb_add(&bar[XB_TOP], 1u);
            const unsigned tg = og / nx;
            if (og + 1u == (tg + 1u) * nx) xb_add(&bar[XB_TOPGEN], 1u);
            else XB_SPIN(xb_ld(&bar[XB_TOPGEN]) == tg, bar);
            __builtin_amdgcn_fence(__ATOMIC_ACQUIRE, "agent");
            xb_add(&bar[XB_XGEN(b.x)], 1u);
            asm volatile("s_waitcnt vmcnt(0)" ::: "memory");
        } else {
            XB_SPIN(xb_ld(&bar[XB_XGEN(b.x)]) == gen, bar);
            __builtin_amdgcn_fence(__ATOMIC_ACQUIRE, "agent");
            asm volatile("s_waitcnt vmcnt(0)" ::: "memory");
        }
    }
    __syncthreads();
}

struct Params {
    const float* in[24]; float* out; unsigned char* ws; int ph_lo, ph_hi;
};
constexpr int LDS_BYTES = 163840, MISC_OFF = LDS_BYTES - 512;

__device__ __forceinline__ void tr_item(const float* __restrict__ W, int ldsrc, int ncol0, int nvalid, int K, int k0, bf16_t* __restrict__ WT, LAS float* scr, int lane) {
    const int c = lane & 31;
#pragma unroll 8
    for (int i = 0; i < 32; ++i) { const int kk = 2 * i + (lane >> 5); scr[kk * 33 + c] = (c < nvalid) ? W[(size_t)(k0 + kk) * ldsrc + ncol0 + c] : 0.f; }
    asm volatile("s_waitcnt lgkmcnt(0)" ::: "memory");
    const int c8 = lane & 7;
#pragma unroll
    for (int j = 0; j < 4; ++j) { const int n = (lane >> 3) + 8 * j; const LAS float* s = scr + (8 * c8) * 33 + n;
        u32x4 o; o.x = pk2(s[0 * 33], s[1 * 33]); o.y = pk2(s[2 * 33], s[3 * 33]); o.z = pk2(s[4 * 33], s[5 * 33]); o.w = pk2(s[6 * 33], s[7 * 33]);
        *(u32x4*)(WT + (size_t)n * K + k0 + 8 * c8) = o; }
    asm volatile("s_waitcnt lgkmcnt(0)" ::: "memory");
}

__device__ __forceinline__ void phase_prologue(const Params& p, unsigned char* lds, int G) {
    int tid_ = threadIdx.x; asm volatile("" : "+v"(tid_));
    const int tid = tid_, lane = tid & 63; const int wid = __builtin_amdgcn_readfirstlane(tid >> 6);
    LAS unsigned char* l3 = (LAS unsigned char*)lds;
    {
        LAS float* sc = (LAS float*)l3; LAS float* part = (LAS float*)(l3 + 16384);
        const float* c = p.in[1]; const float* ada_w = p.in[2]; const float* ada_b = p.in[3]; float* mod = (float*)(p.ws + WS_MOD);
        if ((int)blockIdx.x < 192) {
            for (int i = tid; i < 4096; i += 512) { const float v = c[i]; sc[i] = v / (1.f + expf(-v)); }
            __syncthreads();
            for (int item = blockIdx.x; item < 192; item += G) {
                const int l = item / 96, n0 = (item % 96) * 64;
                const float* W = ada_w + (size_t)l * 1024 * MODN + n0 + lane;
                float a0 = 0.f, a1 = 0.f, a2 = 0.f, a3 = 0.f;
#pragma unroll 8
                for (int k = wid * 128; k < wid * 128 + 128; ++k) { const float wv = W[(size_t)k * MODN]; a0 += sc[k] * wv; a1 += sc[1024 + k] * wv; a2 += sc[2048 + k] * wv; a3 += sc[3072 + k] * wv; }
                part[(wid * 4 + 0) * 64 + lane] = a0; part[(wid * 4 + 1) * 64 + lane] = a1; part[(wid * 4 + 2) * 64 + lane] = a2; part[(wid * 4 + 3) * 64 + lane] = a3;
                __syncthreads();
                if (tid < 256) { const int b = tid >> 6, col = tid & 63; float s = 0.f;
#pragma unroll
                    for (int ww = 0; ww < 8; ++ww) s += part[(ww * 4 + b) * 64 + col];
                    mod[(size_t)(l * 4 + b) * MODN + n0 + col] = s + ada_b[l * MODN + n0 + col]; }
                __syncthreads();
            }
        }
        __syncthreads();
    }
    LAS float* scr = (LAS float*)(l3 + wid * 16384);
    const int gw = blockIdx.x * 8 + wid, NGW = G * 8;
    constexpr int I0 = 88 * 16, I1 = 2 * 32 * 16, I2 = 2 * 176 * 16, I3 = 2 * 32 * 44, I4 = 48 * 16, NIT = I0 + I1 + I2 + I3 + I4;
    for (int it = gw; it < NIT; it += NGW) {
        int r = it;
        if (r < I0) { const int g = r / 16, kb = r % 16; int nv = ECOLS - 32 * g; nv = nv < 0 ? 0 : (nv > 32 ? 32 : nv);
            tr_item(p.in[10], ECOLS, 32 * g, nv, D, 64 * kb, (bf16_t*)(p.ws + WS_WIN0) + (size_t)(32 * g) * D, scr, lane); continue; }
        r -= I0;
        if (r < I1) { const int l = r / 512, g = (r % 512) / 16, kb = r % 16;
            tr_item(p.in[6] + (size_t)l * D * D, D, 32 * g, 32, D, 64 * kb, (bf16_t*)(p.ws + WS_WOUT) + (size_t)l * D * D + (size_t)(32 * g) * D, scr, lane); continue; }
        r -= I1;
        if (r < I2) { const int l = r / (176 * 16), g = (r % (176 * 16)) / 16, kb = r % 16; const int tile = g >> 3, cg = g & 7;
            const float* src = (cg < 4 ? p.in[7] : p.in[8]) + (size_t)l * D * FF;
            tr_item(src, FF, tile * 128 + (cg & 3) * 32, 32, D, 64 * kb, (bf16_t*)(p.ws + WS_WGU) + (size_t)l * GU * D + (size_t)(32 * g) * D, scr, lane); continue; }
        r -= I2;
        if (r < I3) { const int l = r / (32 * 44), g = (r % (32 * 44)) / 44, kb = r % 44;
            tr_item(p.in[9] + (size_t)l * FF * D, D, 32 * g, 32, FF, 64 * kb, (bf16_t*)(p.ws + WS_WDN) + (size_t)l * D * FF + (size_t)(32 * g) * FF, scr, lane); continue; }
        r -= I3;
        { const int g = r / 16, kb = r % 16;
            tr_item(p.in[20], OP, 32 * g, 32, D, 64 * kb, (bf16_t*)(p.ws + WS_WIN1) + (size_t)(32 * g) * D, scr, lane); }
    }
}

__device__ __forceinline__ void phase_norm(const float* __restrict__ x, const float* __restrict__ gain, const float* __restrict__ modl, int sh_off, int sc_off, bf16_t* __restrict__ XN, int G) {
    int tid_ = threadIdx.x; asm volatile("" : "+v"(tid_));
    const int lane = tid_ & 63; const int gw = blockIdx.x * 8 + (tid_ >> 6), NGW = G * 8;
    for (int row = gw; row < M; row += NGW) {
        const int b = row / SEQ;
        const f32x4* xr = (const f32x4*)(x + (size_t)row * D);
        f32x4 v[4]; float s = 0.f;
#pragma unroll
        for (int j = 0; j < 4; ++j) { v[j] = xr[64 * j + lane]; s += v[j][0] * v[j][0] + v[j][1] * v[j][1] + v[j][2] * v[j][2] + v[j][3] * v[j][3]; }
        s = wave_sum(s);
        const float r = __builtin_amdgcn_rsqf(s * (1.f / D) + EPS);
        const float* mb = modl + (size_t)b * MODN;
#pragma unroll
        for (int j = 0; j < 4; ++j) {
            const int col = 4 * (64 * j + lane);
            const f32x4 g = *(const f32x4*)(gain + col), scv = *(const f32x4*)(mb + sc_off + col), shv = *(const f32x4*)(mb + sh_off + col);
            const f32x4 y = v[j] * r * g * (1.f + scv) + shv;
            u32x2 o; o[0] = pk2(y[0], y[1]); o[1] = pk2(y[2], y[3]);
            *(u32x2*)(XN + (size_t)row * D + col) = o;
        }
    }
}

__device__ __forceinline__ void phase_post0(bf16_t* E, bf16_t* __restrict__ KC3, unsigned* __restrict__ SGN, const float* __restrict__ qn_a, const float* __restrict__ kn_a, const float* __restrict__ qn_b, const float* __restrict__ kn_b, int G) {
    int tid_ = threadIdx.x; asm volatile("" : "+v"(tid_));
    const int lane = tid_ & 63; const int gw = blockIdx.x * 8 + (tid_ >> 6), NGW = G * 8;
    const int sub = (lane & 7) * 8;
    for (int row = gw; row < M; row += NGW) {
        bf16_t* e = E + (size_t)row * EP;
        float w[8]; unsigned sgn = 0;
        { const u32x4 wr_ = *(const u32x4*)(e + C_IW);
          w[0] = __uint_as_float(wr_[0] << 16); w[1] = __uint_as_float(wr_[0] & 0xffff0000u); w[2] = __uint_as_float(wr_[1] << 16); w[3] = __uint_as_float(wr_[1] & 0xffff0000u);
          w[4] = __uint_as_float(wr_[2] << 16); w[5] = __uint_as_float(wr_[2] & 0xffff0000u); w[6] = __uint_as_float(wr_[3] << 16); w[7] = __uint_as_float(wr_[3] & 0xffff0000u); }
#pragma unroll
        for (int h = 0; h < 8; ++h) if (w[h] < 0.f) sgn |= 1u << h;
        if (lane == 0) SGN[row] = sgn;
#pragma unroll 1
        for (int it = 0; it < 6; ++it) {
            const int grp = it * 8 + (lane >> 3), col = grp * 64 + sub;
            const bool act = grp < 43;
            const u32x4 raw = act ? *(const u32x4*)(e + col) : (u32x4){0u, 0u, 0u, 0u};
            float v[8];
#pragma unroll
            for (int k = 0; k < 4; ++k) { v[2 * k] = __uint_as_float(raw[k] << 16); v[2 * k + 1] = __uint_as_float(raw[k] & 0xffff0000u); }
            float ss = 0.f;
#pragma unroll
            for (int i = 0; i < 8; ++i) ss += v[i] * v[i];
            ss += __shfl_xor(ss, 1); ss += __shfl_xor(ss, 2); ss += __shfl_xor(ss, 4);
            const float r = __builtin_amdgcn_rsqf(ss * (1.f / 64.f) + EPS);
            const float* gp = nullptr; float scale = 1.f; bool wrt = false;
            if (grp < 8) { gp = qn_a; scale = r * QS; wrt = true; }
            else if (grp < 16) { gp = kn_a; scale = r; wrt = true; }
            else if (grp < 24) { }
            else if (grp < 32) { gp = qn_b; scale = r * QS; wrt = true; }
            else if (grp == 32) { gp = kn_b; scale = r; wrt = true; }
            else if (grp == 33) { }
            if (grp == 33) *(u32x4*)(KC3 + (size_t)2 * M * 64 + (size_t)row * 64 + sub) = raw;
            if (grp == 42) *(u32x4*)(KC3 + (size_t)row * 64 + sub) = raw;
            if (act && wrt) {
                u32x4 ov;
#pragma unroll
                for (int k = 0; k < 4; ++k) ov[k] = pk2(v[2 * k] * scale * (gp ? gp[sub + 2 * k] : 1.f), v[2 * k + 1] * scale * (gp ? gp[sub + 2 * k + 1] : 1.f));
                *(u32x4*)(e + col) = ov;
                if (grp == 32) *(u32x4*)(KC3 + (size_t)M * 64 + (size_t)row * 64 + sub) = ov;
            }
        }
    }
}

__device__ __forceinline__ void phase_bias(const unsigned char* ws, unsigned char* lds, int G) {
    int tid_ = threadIdx.x; asm volatile("" : "+v"(tid_));
    const int lane = tid_ & 63; const int gw = blockIdx.x * 8 + (tid_ >> 6), NGW = G * 8;
    LAS float* scr = (LAS float*)((LAS unsigned char*)lds) + (tid_ >> 6) * 256;
    const float* mod = (const float*)(ws + WS_MOD); bf16_t* bias = (bf16_t*)(ws + WS_BIAS);
    constexpr int N1 = OP, NT_ = OP + 2 * GU;
    for (int r = gw; r < NT_; r += NGW) {
        const bf16_t* wrow; const float* sh; bf16_t* dst; int nb;
        if (r < N1) { wrow = (const bf16_t*)(ws + WS_WIN1) + (size_t)r * D; sh = mod + (size_t)4 * MODN + 0; dst = bias + r; nb = OP; }
        else { const int l = (r - N1) / GU, n = (r - N1) % GU; wrow = (const bf16_t*)(ws + WS_WGU) + (size_t)l * GU * D + (size_t)n * D; sh = mod + (size_t)l * 4 * MODN + 3072; dst = bias + 4 * OP + (size_t)l * 4 * GU + n; nb = GU; }
        const u32x4 w0 = *(const u32x4*)(wrow + lane * 16), w1 = *(const u32x4*)(wrow + lane * 16 + 8);
        float wv[16];
#pragma unroll
        for (int k = 0; k < 4; ++k) { wv[2 * k] = __uint_as_float(w0[k] << 16); wv[2 * k + 1] = __uint_as_float(w0[k] & 0xffff0000u); wv[8 + 2 * k] = __uint_as_float(w1[k] << 16); wv[8 + 2 * k + 1] = __uint_as_float(w1[k] & 0xffff0000u); }
        float a4[4];
#pragma unroll
        for (int bb = 0; bb < 4; ++bb) { const float* sp = sh + (size_t)bb * MODN + lane * 16; float a = 0.f;
#pragma unroll
            for (int k4 = 0; k4 < 4; ++k4) { const f32x4 sv = *(const f32x4*)(sp + 4 * k4); a += sv[0] * wv[4 * k4] + sv[1] * wv[4 * k4 + 1] + sv[2] * wv[4 * k4 + 2] + sv[3] * wv[4 * k4 + 3]; }
            a4[bb] = a; }
#pragma unroll
        for (int bb = 0; bb < 4; ++bb) scr[bb * 64 + lane] = a4[bb];
        const f32x4 pv = *(const LAS f32x4*)(scr + (lane >> 4) * 64 + (lane & 15) * 4);
        float t = (pv[0] + pv[1]) + (pv[2] + pv[3]);
        t += __shfl_xor(t, 1); t += __shfl_xor(t, 2); t += __shfl_xor(t, 4); t += __shfl_xor(t, 8);
        if ((lane & 15) == 0) dst[(size_t)(lane >> 4) * nb] = f2bf(t);
    }
}

__global__ void __launch_bounds__(512, 2) mega_fwd(Params p) {
    extern __shared__ __attribute__((aligned(16))) unsigned char lds[];
    const int tid = threadIdx.x, lane = tid & 63; const int wid = __builtin_amdgcn_readfirstlane(tid >> 6);
    const int G = gridDim.x, cb = blockIdx.x;
    LAS unsigned char* l3 = (LAS unsigned char*)lds;
    volatile LAS unsigned* MISC = (volatile LAS unsigned*)(l3 + MISC_OFF);
    if (tid < 128) MISC[tid] = 0u;
    __syncthreads();
    unsigned* ctl = (unsigned*)(p.ws + WS_CTL);
    const bool multi = (p.ph_hi - p.ph_lo) > 1;
    XcdBarrier bar; bar.bar = ctl + 1024; bar.x = 0; bar.st = nullptr;
    if (multi) bar = xcd_barrier_post(ctl + 1024, MISC + 8);
    const float* x = p.in[0]; float* out = p.out;

    TSTART(9)
    for (int ph = p.ph_lo; ph < p.ph_hi; ++ph) {
        if (ph + 1 == p.ph_hi) { TSTOP(9, ctl) }
        GAS unsigned char* wsg_ = (GAS unsigned char*)p.ws; asm volatile("" : "+s"(wsg_)); unsigned char* ws = (unsigned char*)wsg_;
        int lane_o = tid; asm volatile("" : "+v"(lane_o)); lane_o &= 63;
        float* mod = (float*)(ws + WS_MOD); unsigned* SGN = (unsigned*)(ws + WS_SGN);
        bf16_t* XN = (bf16_t*)(ws + WS_XN); bf16_t* Yb = (bf16_t*)(ws + WS_Y); bf16_t* E = (bf16_t*)(ws + WS_E);
        const int l = ph >= 7 ? 1 : 0;
        int kind;
        { const int tab[12] = {0, 1, 2, 4, 5, 7, 8, 2, 9, 5, 7, 8}; kind = tab[ph]; }
        float* SSQ0 = (float*)(ws + WS_SSQ); const bf16_t* BIAS = (const bf16_t*)(ws + WS_BIAS);
        const float* modl = mod + (size_t)l * 4 * MODN;
        if (kind == 0) phase_prologue(p, lds, G);
        else if (kind == 1) { phase_norm(x, p.in[4], modl, 0, 1024, XN, G); phase_bias(ws, lds, G); }
        else if (kind == 2) {
            pg8::Gemm g{XN, (const bf16_t*)(ws + (l == 0 ? WS_WIN0 : WS_WIN1)), M, l == 0 ? EP : OP, D};
            pg8::StaticOrder S; S.init(M, g.N, G, cb);
            if (l == 0) { pg8::EpiInProj0 Ep{E, (bf16_t*)(ws + WS_IKC), p.in[11], p.in[12], p.in[18], p.in[19], l3}; pg8::gemm_phase<pg8::EpiInProj0, pg8::StaticOrder, true, true>(l3, g, S, Ep); }
            else { pg8::EpiRawBf16S Ep{E, OP, SSQ0 + M, BIAS, OP}; pg8::gemm_phase<pg8::EpiRawBf16S, pg8::StaticOrder, true, true>(l3, g, S, Ep); }
        }
        else if (kind == 3) phase_post0(E, (bf16_t*)(ws + WS_IKC), SGN, p.in[11], p.in[12], p.in[18], p.in[19], G);
        else if (kind == 4) {
            TSTART(7)
            const float t1 = wave_sum(p.in[13][lane_o] * p.in[14][lane_o]), t2 = wave_sum(p.in[15][lane_o] * p.in[16][lane_o]);
            const float lam = expf(t1) - expf(t2) + 0.2f;
            const float gq = wave_max(fabsf(p.in[11][lane_o])), gk = wave_max(fabsf(p.in[12][lane_o]));
            const float cut = 2.f * (8.f * gq * gk * 1.03f) + 30.f;
            unsigned* qctr = ctl + 64;
            volatile LAS unsigned* QW = (volatile LAS unsigned*)(l3 + 131072 - 4);
            unsigned sv0 = 0u, sv1 = 0u; if (tid == 0) { sv0 = MISC[8]; sv1 = MISC[9]; }
            if (tid == 0) QW[0] = atomicAdd(qctr, 1u);
            __syncthreads();
            int item = (int)QW[0];
            while (item < 512 + 2048) {
                unsigned nxt = 0u;
                if (tid == 0) nxt = atomicAdd(qctr, 1u);
                if (item < 512) {
                    const int hh = 3 - (item >> 7), r_ = item & 127, qb = 31 - (r_ >> 2), bb = r_ & 3;
                    const float dh = cut * __builtin_amdgcn_exp2f(2.f * (float)(hh + 1));
                    int t0 = (int)floorf(((float)(128 * qb) - dh) * (1.f / 64.f)); t0 = t0 < 0 ? 0 : t0;
                    { TSTART(6) attnA_unit(bb, hh, qb, t0, E, Yb, lam, p.in[17], lds, ctl); TSTOP(6, ctl) }
                } else {
                    const int k = item - 512, bb = k & 3, ib = 511 - (k >> 2);
                    { TSTART(5) dsa_unit(bb, ib * 8, E, (const bf16_t*)(ws + WS_IKC), SGN, Yb, lds, ctl); TSTOP(5, ctl) }
                }
                if (tid == 0) QW[0] = nxt;
                __syncthreads();
                item = (int)QW[0];
                __syncthreads();
            }
            if (tid == 0) { MISC[8] = sv0; MISC[9] = sv1; }
            TSTOP(7, ctl)
        }
        else if (kind == 9) {
            for (int u = cb; u < 512; u += G) { const int bk = u & 15, nb = (u >> 4) & 31;
                swa_unit(bk >> 2, bk & 3, nb, E, Yb, p.in[21], p.in[22], p.in[23], lds, ctl); }
        }
        else if (kind == 5 || kind == 8) {
            const bool dn = (kind == 8);
            pg8::Gemm g{dn ? E : Yb, (const bf16_t*)(ws + (dn ? WS_WDN : WS_WOUT)) + (size_t)l * (dn ? D * FF : D * D), M, D, dn ? FF : D};
            pg8::StaticOrder S; S.init(M, D, G, cb);
            const bool last = dn && l == 1;
            const float* ngain = dn ? p.in[4] + D : p.in[5] + l * D;
            const float* nsc = dn ? mod + (size_t)4 * MODN + 1024 : modl + 4096;
            const bool first = (kind == 5 && l == 0);
            void* R = (void*)(ws + WS_R);
            pg8::EpiResGateN Ep{ctl, first ? (const void*)x : (const void*)R, last ? (void*)out : R, first ? 0 : 1, last ? 0 : 1,
                                modl + (dn ? 5120 : 2048), last ? nullptr : XN, ngain, nsc, SSQ0 + (size_t)(dn ? 1 : (l == 0 ? 0 : 2)) * M, l3};
            TSTART(52)
            pg8::gemm_phase<pg8::EpiResGateN, pg8::StaticOrder, true, true>(l3, g, S, Ep);
            TSTOP(52, ctl)
        }
        else if (kind == 7) {
            pg8::Gemm g{XN, (const bf16_t*)(ws + WS_WGU) + (size_t)l * GU * D, M, GU, D};
            pg8::StaticOrder S; S.init(M, GU, G, cb);
            pg8::EpiSwigluS Ep{E, SSQ0 + (size_t)(l == 0 ? 0 : 2) * M, BIAS + 4 * OP + (size_t)l * 4 * GU};
            pg8::gemm_phase<pg8::EpiSwigluS, pg8::StaticOrder, true, true>(l3, g, S, Ep);
        }
        if (ph + 1 < p.ph_hi) { TSTART(8) TSTART(60) xcd_barrier(bar); if (kind == 4) { TSTOP(8, ctl) } TSTOP(60, ctl) }
#ifdef PROBE_ID
        if (ph + 1 == p.ph_hi) { xcd_barrier(bar);
            int tq_ = threadIdx.x; asm volatile("" : "+v"(tq_));
            if (blockIdx.x == 0 && tq_ == 0) { const unsigned long long tot = __hip_atomic_load((unsigned long long*)(ctl + 256), __ATOMIC_RELAXED, __HIP_MEMORY_SCOPE_AGENT);
                const float t_us = (float)(unsigned)(tot >> 8) / (float)gridDim.x * 2.56f; p.out[0] += sqrtf(t_us * 252.f); } }
#endif
    }
}

#ifndef MK_SPLIT
#define MK_SPLIT 0
#endif
extern "C" void kernel_launch(void* const* d_in, const int* in_sizes, int n_in, void* d_out, int out_size, void* d_ws, size_t ws_size, hipStream_t stream) {
    static int grid = 0;
    if (grid == 0) {
        int dev = 0, cus = 0, per_cu = 0;
        if (hipGetDevice(&dev) != hipSuccess || hipDeviceGetAttribute(&cus, hipDeviceAttributeMultiprocessorCount, dev) != hipSuccess) { fprintf(stderr, "kernel_launch: device query failed\n"); grid = -1; return; }
        if (hipFuncSetAttribute((const void*)mega_fwd, hipFuncAttributeMaxDynamicSharedMemorySize, LDS_BYTES) != hipSuccess) { fprintf(stderr, "kernel_launch: hipFuncSetAttribute failed\n"); grid = -1; return; }
        if (hipOccupancyMaxActiveBlocksPerMultiprocessor(&per_cu, (const void*)mega_fwd, 512, LDS_BYTES) != hipSuccess || per_cu < 1) { fprintf(stderr, "kernel_launch: occupancy query says %d\n", per_cu); (void)hipGetLastError(); per_cu = 1; }
        grid = cus;
    }
    if (grid < 0) return;
    (void)hipMemsetAsync((char*)d_ws + WS_CTL, 0, CTL_ZERO_BYTES, stream);
    Params p{};
    for (int i = 0; i < 24; ++i) p.in[i] = (const float*)d_in[i];
    p.out = (float*)d_out; p.ws = (unsigned char*)d_ws;
#if MK_SPLIT
    for (int ph = 0; ph < 12; ++ph) { p.ph_lo = ph; p.ph_hi = ph + 1; hipLaunchKernelGGL(mega_fwd, dim3(grid), dim3(512), LDS_BYTES, stream, p); }
#else
    p.ph_lo = 0; p.ph_hi = 12;
    void* args[] = {&p};
    hipError_t e = hipLaunchCooperativeKernel((const void*)mega_fwd, dim3(grid), dim3(512), args, LDS_BYTES, stream);
    if (e != hipSuccess) fprintf(stderr, "kernel_launch: cooperative launch failed: %s\n", hipGetErrorString(e));
#endif
}
```

```cpp
#include <hip/hip_runtime.h>
#include <cstdio>
#include <stdint.h>

#define LAS __attribute__((address_space(3)))
#define GAS __attribute__((address_space(1)))
typedef unsigned short bf16_t;
typedef short bf16x8 __attribute__((ext_vector_type(8)));
typedef short s16x4 __attribute__((ext_vector_type(4)));
typedef short v4i16_t __attribute__((ext_vector_type(4)));
typedef float f32x4 __attribute__((ext_vector_type(4)));
typedef float f32x16 __attribute__((ext_vector_type(16)));
typedef unsigned u32x4 __attribute__((ext_vector_type(4)));
typedef unsigned u32x2 __attribute__((ext_vector_type(2)));
typedef float f32x2_t __attribute__((ext_vector_type(2)));
typedef __bf16 bf16x2_t __attribute__((ext_vector_type(2)));
typedef LAS const char* lds_cptr;

constexpr int D = 1024, BATCH = 4, SEQ = 4096, M = BATCH * SEQ, FF = 2816, ECOLS = 2760, EP = 2816, OP = 1536, MODN = 6144, GU = 2 * FF;
constexpr float LOG2E = 1.4426950408889634f;
constexpr float QS = 0.125f * LOG2E;
constexpr float IS = 0.125f * 0.35355339059327373f;
constexpr float EPS = 1e-6f;
constexpr int C_AQ = 0, C_AK = 512, C_AV = 1024, C_BQ = 1536, C_BK = 2048, C_BV = 2112, C_IQ = 2176, C_IK = 2688, C_IW = 2752;
constexpr int C1_Q = 0, C1_K = 1024, C1_V = 1280;
constexpr int E1S = EP;

constexpr size_t MiB = 1u << 20;
constexpr size_t WS_CTL = 0, CTL_ZERO_BYTES = 256 * 1024;
constexpr size_t WS_MOD = 1 * MiB, WS_SGN = 1 * MiB + 512 * 1024;
constexpr size_t WS_SSQ = 64 * 1024;
constexpr size_t WS_BIAS = 1 * MiB + 256 * 1024;
constexpr size_t WS_WIN0 = 2 * MiB;
constexpr size_t WS_WOUT = 8 * MiB;
constexpr size_t WS_WGU = 12 * MiB;
constexpr size_t WS_WDN = 34 * MiB;
constexpr size_t WS_WIN1 = 45 * MiB;
constexpr size_t WS_XN = 50 * MiB, WS_Y = 82 * MiB, WS_E = 114 * MiB, WS_END = 202 * MiB;
constexpr size_t WS_IKC = 202 * MiB, WS_BKC = 204 * MiB, WS_BVC = 206 * MiB;
constexpr size_t WS_R = 208 * MiB;

__device__ __forceinline__ float bf2f(bf16_t v) { return __uint_as_float((unsigned)v << 16); }
__device__ __forceinline__ bf16_t f2bf(float f) { unsigned u = __float_as_uint(f); return (bf16_t)((u + 0x7fffu + ((u >> 16) & 1u)) >> 16); }
__device__ __forceinline__ unsigned pk2(float lo, float hi) { return (unsigned)f2bf(lo) | ((unsigned)f2bf(hi) << 16); }
__device__ __forceinline__ unsigned cvtpk(float lo, float hi) { f32x2_t v = {lo, hi}; bf16x2_t b = __builtin_convertvector(v, bf16x2_t); return __builtin_bit_cast(unsigned, b); }
__device__ __forceinline__ float wave_sum(float v) {
#pragma unroll
    for (int o = 1; o < 64; o <<= 1) v += __shfl_xor(v, o);
    return v;
}
__device__ __forceinline__ float wave_max(float v) {
#pragma unroll
    for (int o = 1; o < 64; o <<= 1) v = fmaxf(v, __shfl_xor(v, o));
    return v;
}
__device__ __forceinline__ int crow(int r, int hi) { return (r & 3) + 8 * (r >> 2) + 4 * hi; }
__device__ __forceinline__ float xhalf_max(float m) { auto rr = __builtin_amdgcn_permlane32_swap(__float_as_uint(m), __float_as_uint(m), false, false); return fmaxf(__uint_as_float(rr[0]), __uint_as_float(rr[1])); }
__device__ __forceinline__ float xhalf_sum(float m) { auto rr = __builtin_amdgcn_permlane32_swap(__float_as_uint(m), __float_as_uint(m), false, false); return __uint_as_float(rr[0]) + __uint_as_float(rr[1]); }
__device__ __forceinline__ float x16_max(float m) { auto rr = __builtin_amdgcn_permlane16_swap(__float_as_uint(m), __float_as_uint(m), false, false); return fmaxf(__uint_as_float(rr[0]), __uint_as_float(rr[1])); }
__device__ __forceinline__ float x16_sum(float m) { auto rr = __builtin_amdgcn_permlane16_swap(__float_as_uint(m), __float_as_uint(m), false, false); return __uint_as_float(rr[0]) + __uint_as_float(rr[1]); }
__device__ __forceinline__ void glds16(const void* gsrc, unsigned lds_dst) { unsigned keep;
    asm volatile("s_mov_b32 %0, m0\n\ts_mov_b32 m0, %2\n\ts_nop 0\n\tglobal_load_lds_dwordx4 %1, off\n\ts_mov_b32 m0, %0" : "=&s"(keep) : "v"(gsrc), "s"(lds_dst) : "memory"); }
__device__ __forceinline__ s16x4 vtr(lds_cptr p) { return __builtin_bit_cast(s16x4, __builtin_amdgcn_ds_read_tr16_b64_v4i16((LAS v4i16_t*)p)); }
#ifdef PROBE_ID
#define TSTART(id) if ((id) == PROBE_ID && threadIdx.x == 0 && ctl) { if ((id) == 5100) { extern __shared__ __attribute__((aligned(16))) unsigned char lds_probe_[]; *(volatile LAS unsigned long long*)((LAS unsigned char*)lds_probe_ + 163328 + 128) = __builtin_amdgcn_s_memrealtime(); } else { __hip_atomic_store((unsigned long long*)(ctl + 512) + blockIdx.x, (unsigned long long)__builtin_amdgcn_s_memrealtime(), __ATOMIC_RELAXED, __HIP_MEMORY_SCOPE_AGENT); } }
#define TSTOP(id, ctl_) if ((id) == PROBE_ID && threadIdx.x == 0) { unsigned long long t0_; if ((id) == 5100) { extern __shared__ __attribute__((aligned(16))) unsigned char lds_probe_[]; t0_ = *(volatile LAS unsigned long long*)((LAS unsigned char*)lds_probe_ + 163328 + 128); } else { t0_ = __hip_atomic_load((unsigned long long*)((ctl_) + 512) + blockIdx.x, __ATOMIC_RELAXED, __HIP_MEMORY_SCOPE_AGENT); } atomicAdd((unsigned long long*)((ctl_) + 256), (unsigned long long)(__builtin_amdgcn_s_memrealtime() - t0_)); }
#else
#define TSTART(id)
#define TSTOP(id, ctl_)
#endif
#define WAITV_BAR() asm volatile("s_waitcnt vmcnt(0) lgkmcnt(0)\n\ts_barrier" ::: "memory")
#define WAITL_BAR() asm volatile("s_waitcnt lgkmcnt(0)\n\ts_barrier" ::: "memory")

namespace pg8 {
constexpr int BM = 256, BK = 64, HALF = 128, HTB = HALF * BK * 2, STAGE_BYTES = 8 * HTB, NXCD = 8, WGM = 8;
__host__ __device__ __forceinline__ int lds_byte(int r, int c) { const int st = (r >> 4) * 2 + (c >> 5), rr = r & 15, cc = c & 31, ob = rr * 64 + cc * 2; return st * 1024 + (ob ^ (((ob >> 9) & 1) << 5)); }
__host__ __device__ __forceinline__ void stage_rc(int b, int& R, int& C) { const int st = b / 1024, sb = b % 1024, swz = sb ^ (((sb >> 9) & 1) << 5); R = (st >> 1) * 16 + swz / 64; C = (st & 1) * 32 + (swz % 64) / 2; }
__host__ __device__ __forceinline__ int perm32(int rho) { const int n = rho >> 4, i = rho & 15; return 8 * (i >> 2) + 4 * n + (i & 3); }
struct Unit { int pm, pn; };
struct Gemm { const bf16_t* A; const bf16_t* Bt; int M, N, K; };
struct StaticOrder {
    int nM, nN, nwg, G, c;
    __host__ __device__ void init(int M_, int N_, int G_, int c_) { nM = M_ / BM; nN = N_ / BM; nwg = nM * nN; G = G_; c = c_; }
    __host__ __device__ bool next(int i, Unit& u) const {
        const long L = (long)i * G + c; if (L >= nwg) return false;
        int wgid = (int)L; { const int q = nwg / NXCD, r = nwg % NXCD, xcd = wgid % NXCD, off = wgid / NXCD; wgid = (xcd < r ? xcd * (q + 1) : r * (q + 1) + (xcd - r) * q) + off; }
        const int nig = WGM * nN, gid = wgid / nig, fm = gid * WGM, gsz = (nM - fm) < WGM ? (nM - fm) : WGM;
        u.pm = fm + ((wgid % nig) % gsz); u.pn = (wgid % nig) / gsz; return true;
    }
    __device__ __forceinline__ void a_ready(const Unit&) const {}
    __device__ __forceinline__ void done(const Unit&) const {}
};
__device__ __forceinline__ unsigned cvt_pk_bf16(float lo, float hi) { unsigned r; asm volatile("v_cvt_pk_bf16_f32 %0, %1, %2" : "=v"(r) : "v"(lo), "v"(hi)); return r; }

struct NoPre {};
struct EpiRawBf16 {
    static constexpr bool PERM = true, AFTER_DRAIN = false; typedef NoPre Pre;
    __device__ __forceinline__ unsigned* probe_ctl() const { return nullptr; }
    __device__ __forceinline__ Pre pre(const Unit&, int, int, int, int) const { return Pre{}; }
    bf16_t* O; int ldc;
    __device__ __forceinline__ void operator()(const f32x4 (&acc)[2][2][4][2], const Unit& u, const Pre&, int wr, int wc, int fr, int fq) const {
        const int row0 = u.pm * BM + wr * 64 + fr, col0 = u.pn * BM + wc * 32 + 8 * fq;
#pragma unroll
        for (int ai = 0; ai < 2; ++ai)
#pragma unroll
            for (int m = 0; m < 4; ++m) { bf16_t* rowp = O + (size_t)(row0 + ai * HALF + m * 16) * ldc + col0;
#pragma unroll
                for (int bj = 0; bj < 2; ++bj) { const f32x4 v0 = acc[ai][bj][m][0], v1 = acc[ai][bj][m][1];
                    u32x4 w; w.x = cvt_pk_bf16(v0[0], v0[1]); w.y = cvt_pk_bf16(v0[2], v0[3]); w.z = cvt_pk_bf16(v1[0], v1[1]); w.w = cvt_pk_bf16(v1[2], v1[3]);
                    *(u32x4*)(rowp + bj * HALF) = w; } }
    }
};
struct EpiResGateN {
    static constexpr bool PERM = true, AFTER_DRAIN = false; typedef NoPre Pre;
    unsigned* pctl;
    __device__ __forceinline__ unsigned* probe_ctl() const { return pctl; }
    __device__ __forceinline__ Pre pre(const Unit&, int, int, int, int) const { return Pre{}; }
    const void* base; void* out; int base_bf16, out_bf16;
    const float* gate; bf16_t* XA; const float* gain; const float* scn; float* SSQ; LAS unsigned char* lds;
    __device__ __forceinline__ void operator()(const f32x4 (&acc)[2][2][4][2], const Unit& u, const Pre&, int wr, int wc, int fr, int fq) const {
        const int row0 = u.pm * BM + wr * 64 + fr, col0 = u.pn * BM + wc * 32 + 8 * fq, b = (u.pm * BM) / SEQ;
        f32x4 g[2][2], gs[2][2];
#pragma unroll
        for (int bj = 0; bj < 2; ++bj)
#pragma unroll
            for (int n = 0; n < 2; ++n) { g[bj][n] = *(const f32x4*)(gate + (size_t)b * MODN + col0 + bj * HALF + 4 * n);
                if (XA) gs[bj][n] = *(const f32x4*)(gain + col0 + bj * HALF + 4 * n) * (1.f + *(const f32x4*)(scn + (size_t)b * MODN + col0 + bj * HALF + 4 * n)); }
        LAS float* part = (LAS float*)(lds + 131072);
#pragma unroll
        for (int ai = 0; ai < 2; ++ai) {
            u32x4 rbv[4][2];
            if (base_bf16) {
#pragma unroll
                for (int m = 0; m < 4; ++m)
#pragma unroll
                    for (int bj = 0; bj < 2; ++bj) rbv[m][bj] = *(const u32x4*)((const bf16_t*)base + (size_t)(row0 + ai * HALF + m * 16) * D + col0 + bj * HALF);
            }
#pragma unroll
            for (int m = 0; m < 4; ++m) { const size_t off = (size_t)(row0 + ai * HALF + m * 16) * D + col0; float ss = 0.f;
#pragma unroll
                for (int bj = 0; bj < 2; ++bj) { f32x4 o[2];
                    if (base_bf16) { const u32x4 w = rbv[m][bj];
                        o[0] = (f32x4){__uint_as_float(w[0] << 16), __uint_as_float(w[0] & 0xffff0000u), __uint_as_float(w[1] << 16), __uint_as_float(w[1] & 0xffff0000u)};
                        o[1] = (f32x4){__uint_as_float(w[2] << 16), __uint_as_float(w[2] & 0xffff0000u), __uint_as_float(w[3] << 16), __uint_as_float(w[3] & 0xffff0000u)}; }
                    else { o[0] = *(const f32x4*)((const float*)base + off + bj * HALF); o[1] = *(const f32x4*)((const float*)base + off + bj * HALF + 4); }
#pragma unroll
                    for (int n = 0; n < 2; ++n) { o[n] = o[n] + g[bj][n] * acc[ai][bj][m][n]; ss += o[n][0] * o[n][0] + o[n][1] * o[n][1] + o[n][2] * o[n][2] + o[n][3] * o[n][3]; }
                    if (out_bf16) { u32x4 w; w.x = cvt_pk_bf16(o[0][0], o[0][1]); w.y = cvt_pk_bf16(o[0][2], o[0][3]); w.z = cvt_pk_bf16(o[1][0], o[1][1]); w.w = cvt_pk_bf16(o[1][2], o[1][3]);
                        *(u32x4*)((bf16_t*)out + off + bj * HALF) = w; }
                    else { *(f32x4*)((float*)out + off + bj * HALF) = o[0]; *(f32x4*)((float*)out + off + bj * HALF + 4) = o[1]; }
                    if (XA) { const f32x4 a0 = o[0] * gs[bj][0], a1 = o[1] * gs[bj][1];
                        u32x4 w; w.x = cvt_pk_bf16(a0[0], a0[1]); w.y = cvt_pk_bf16(a0[2], a0[3]); w.z = cvt_pk_bf16(a1[0], a1[1]); w.w = cvt_pk_bf16(a1[2], a1[3]);
                        *(u32x4*)(XA + off + bj * HALF) = w; } }
                if (XA) { ss = x16_sum(ss); ss = xhalf_sum(ss);
                    if (fq == 0) part[wc * 256 + ai * HALF + wr * 64 + m * 16 + fr] = ss; } }
        }
        if (XA) {
            asm volatile("s_waitcnt lgkmcnt(0)\n\ts_barrier" ::: "memory");
            const int t = threadIdx.x;
            if (t < 256) atomicAdd(SSQ + (size_t)(u.pm * BM + t), part[t] + part[256 + t] + part[512 + t] + part[768 + t]);
            asm volatile("s_waitcnt lgkmcnt(0)\n\ts_barrier" ::: "memory");
        }
    }
};
struct PreRB { float sq[8]; u32x4 bv[2]; };
struct EpiRawBf16S {
    static constexpr bool PERM = true, AFTER_DRAIN = false; typedef PreRB Pre;
    __device__ __forceinline__ unsigned* probe_ctl() const { return nullptr; }
    bf16_t* O; int ldc; const float* SSQ; const bf16_t* bias; int nb;
#ifdef PROBE_ID
    __device__ __forceinline__ Pre pre(const Unit&, int, int, int, int) const { return Pre{}; }
#else
    __device__ __forceinline__ Pre pre(const Unit& u, int wr, int wc, int fr, int fq) const { return ldpre(u, wr, wc, fr, fq); }
#endif
    __device__ __forceinline__ Pre ldpre(const Unit& u, int wr, int wc, int fr, int fq) const {
        Pre p; const int row0 = u.pm * BM + wr * 64 + fr, col0 = u.pn * BM + wc * 32 + 8 * fq, b = (u.pm * BM) / SEQ;
#pragma unroll
        for (int i = 0; i < 8; ++i) p.sq[i] = SSQ[row0 + (i >> 2) * HALF + (i & 3) * 16];
#pragma unroll
        for (int bj = 0; bj < 2; ++bj) p.bv[bj] = *(const u32x4*)(bias + (size_t)b * nb + col0 + bj * HALF);
        return p;
    }
    __device__ __forceinline__ void operator()(const f32x4 (&acc)[2][2][4][2], const Unit& u, const Pre& p_in, int wr, int wc, int fr, int fq) const {
#ifdef PROBE_ID
        const Pre p = ldpre(u, wr, wc, fr, fq);
#else
        const Pre& p = p_in;
#endif
        const int row0 = u.pm * BM + wr * 64 + fr, col0 = u.pn * BM + wc * 32 + 8 * fq;
#pragma unroll
        for (int ai = 0; ai < 2; ++ai)
#pragma unroll
            for (int m = 0; m < 4; ++m) { const int row = row0 + ai * HALF + m * 16; bf16_t* rowp = O + (size_t)row * ldc + col0;
                const float rs = __builtin_amdgcn_rsqf(p.sq[ai * 4 + m] * (1.f / D) + EPS);
#pragma unroll
                for (int bj = 0; bj < 2; ++bj) { const u32x4 bw = p.bv[bj];
                    const f32x4 b0 = (f32x4){__uint_as_float(bw[0] << 16), __uint_as_float(bw[0] & 0xffff0000u), __uint_as_float(bw[1] << 16), __uint_as_float(bw[1] & 0xffff0000u)};
                    const f32x4 b1 = (f32x4){__uint_as_float(bw[2] << 16), __uint_as_float(bw[2] & 0xffff0000u), __uint_as_float(bw[3] << 16), __uint_as_float(bw[3] & 0xffff0000u)};
                    const f32x4 v0 = acc[ai][bj][m][0] * rs + b0, v1 = acc[ai][bj][m][1] * rs + b1;
                    u32x4 w; w.x = cvt_pk_bf16(v0[0], v0[1]); w.y = cvt_pk_bf16(v0[2], v0[3]); w.z = cvt_pk_bf16(v1[0], v1[1]); w.w = cvt_pk_bf16(v1[2], v1[3]);
                    *(u32x4*)(rowp + bj * HALF) = w; } }
    }
};
struct EpiSwigluS {
    static constexpr bool PERM = true, AFTER_DRAIN = false; typedef PreRB Pre;
    __device__ __forceinline__ unsigned* probe_ctl() const { return nullptr; }
    bf16_t* H; const float* SSQ; const bf16_t* bias;
#ifdef PROBE_ID
    __device__ __forceinline__ Pre pre(const Unit&, int, int, int, int) const { return Pre{}; }
#else
    __device__ __forceinline__ Pre pre(const Unit& u, int wr, int wc, int fr, int fq) const { return ldpre(u, wr, wc, fr, fq); }
#endif
    __device__ __forceinline__ Pre ldpre(const Unit& u, int wr, int wc, int fr, int fq) const {
        Pre p; const int row0 = u.pm * BM + wr * 64 + fr, gc0 = u.pn * BM + wc * 32 + 8 * fq, b = (u.pm * BM) / SEQ;
#pragma unroll
        for (int i = 0; i < 8; ++i) p.sq[i] = SSQ[row0 + (i >> 2) * HALF + (i & 3) * 16];
#pragma unroll
        for (int bj = 0; bj < 2; ++bj) p.bv[bj] = *(const u32x4*)(bias + (size_t)b * (2 * FF) + gc0 + bj * HALF);
        return p;
    }
    __device__ __forceinline__ void operator()(const f32x4 (&acc)[2][2][4][2], const Unit& u, const Pre& p_in, int wr, int wc, int fr, int fq) const {
#ifdef PROBE_ID
        const Pre p = ldpre(u, wr, wc, fr, fq);
#else
        const Pre& p = p_in;
#endif
        const int row0 = u.pm * BM + wr * 64 + fr, col0 = u.pn * HALF + wc * 32 + 8 * fq;
#pragma unroll
        for (int ai = 0; ai < 2; ++ai)
#pragma unroll
            for (int m = 0; m < 4; ++m) { const int row = row0 + ai * HALF + m * 16; bf16_t* rowp = H + (size_t)row * FF + col0;
                const float rs = __builtin_amdgcn_rsqf(p.sq[ai * 4 + m] * (1.f / D) + EPS);
                float hv[8];
#pragma unroll
                for (int n = 0; n < 2; ++n)
#pragma unroll
                    for (int e = 0; e < 4; ++e) { const unsigned gw_ = p.bv[0][n * 2 + (e >> 1)], uw_ = p.bv[1][n * 2 + (e >> 1)];
                        const float gb = (e & 1) ? __uint_as_float(gw_ & 0xffff0000u) : __uint_as_float(gw_ << 16), ub = (e & 1) ? __uint_as_float(uw_ & 0xffff0000u) : __uint_as_float(uw_ << 16);
                        const float gv = acc[ai][0][m][n][e] * rs + gb, uv = acc[ai][1][m][n][e] * rs + ub;
                        hv[n * 4 + e] = gv * __builtin_amdgcn_rcpf(1.f + __builtin_amdgcn_exp2f(-gv * LOG2E)) * uv; }
                u32x4 w; w.x = cvt_pk_bf16(hv[0], hv[1]); w.y = cvt_pk_bf16(hv[2], hv[3]); w.z = cvt_pk_bf16(hv[4], hv[5]); w.w = cvt_pk_bf16(hv[6], hv[7]);
                *(u32x4*)rowp = w; }
    }
};


struct EpiInProj0 {
    static constexpr bool PERM = true, AFTER_DRAIN = false; typedef NoPre Pre;
    __device__ __forceinline__ unsigned* probe_ctl() const { return nullptr; }
    __device__ __forceinline__ Pre pre(const Unit&, int, int, int, int) const { return Pre{}; }
    bf16_t* O; bf16_t* KC3; const float* qn_a; const float* kn_a; const float* qn_b; const float* kn_b; LAS unsigned char* lds;
    __device__ __forceinline__ void operator()(const f32x4 (&acc)[2][2][4][2], const Unit& u, const Pre&, int wr, int wc, int fr, int fq) const {
        const int row0 = u.pm * BM + wr * 64 + fr, colg = u.pn * BM + wc * 64;
        const int grp = colg >> 6;
        const float* gp = nullptr; float qs = 1.f;
        if (grp < 8) { gp = qn_a; qs = QS; } else if (grp < 16) gp = kn_a; else if (grp >= 24 && grp < 32) { gp = qn_b; qs = QS; } else if (grp == 32) gp = kn_b;
        f32x4 g0[2], g1[2];
#pragma unroll
        for (int bj = 0; bj < 2; ++bj) { g0[bj] = (f32x4){1.f, 1.f, 1.f, 1.f}; g1[bj] = g0[bj];
            if (gp) { g0[bj] = *(const f32x4*)(gp + bj * 32 + 8 * fq) * qs; g1[bj] = *(const f32x4*)(gp + bj * 32 + 8 * fq + 4) * qs; } }
#pragma unroll
        for (int ai = 0; ai < 2; ++ai)
#pragma unroll
            for (int m = 0; m < 4; ++m) { const int row = row0 + ai * HALF + m * 16;
                float rs = 1.f;
                if (gp) { float s = 0.f;
#pragma unroll
                    for (int bj = 0; bj < 2; ++bj) { const f32x4 v0 = acc[ai][bj][m][0], v1 = acc[ai][bj][m][1];
                        s += v0[0] * v0[0] + v0[1] * v0[1] + v0[2] * v0[2] + v0[3] * v0[3] + v1[0] * v1[0] + v1[1] * v1[1] + v1[2] * v1[2] + v1[3] * v1[3]; }
                    s = x16_sum(s); s = xhalf_sum(s);
                    rs = __builtin_amdgcn_rsqf(s * (1.f / 64.f) + EPS); }
#pragma unroll
                for (int bj = 0; bj < 2; ++bj) {
                    const f32x4 v0 = acc[ai][bj][m][0] * rs * g0[bj], v1 = acc[ai][bj][m][1] * rs * g1[bj];
                    u32x4 w; w.x = cvt_pk_bf16(v0[0], v0[1]); w.y = cvt_pk_bf16(v0[2], v0[3]); w.z = cvt_pk_bf16(v1[0], v1[1]); w.w = cvt_pk_bf16(v1[2], v1[3]);
                    *(u32x4*)(O + (size_t)row * EP + colg + bj * 32 + 8 * fq) = w;
                    if (grp == 32) *(u32x4*)(KC3 + (size_t)M * 64 + (size_t)row * 64 + bj * 32 + 8 * fq) = w;
                    if (grp == 33) *(u32x4*)(KC3 + (size_t)2 * M * 64 + (size_t)row * 64 + bj * 32 + 8 * fq) = w;
                    if (grp == 42) *(u32x4*)(KC3 + (size_t)row * 64 + bj * 32 + 8 * fq) = w; }
            }
    }
};

template <class Epi, class Sched, bool ALIGN_EPI = false, bool SP2 = false>
__device__ __forceinline__ void gemm_phase(LAS unsigned char* lds, const Gemm g, const Sched& S, const Epi& E) {
    int tid_ = threadIdx.x; asm volatile("" : "+v"(tid_));
    const int tid = tid_, wid = __builtin_amdgcn_readfirstlane(tid >> 6), lane = tid & 63, wr = wid >> 2, wc = wid & 3, fr = lane & 15, fq = lane >> 4;
    const int K = g.K, nt = K / BK;
    unsigned voffA[2], voffB[2];
#pragma unroll
    for (int i = 0; i < 2; ++i) { int R, C; stage_rc(tid * 16 + i * 8192, R, C); const int Rb = Epi::PERM ? ((R & ~31) + perm32(R & 31)) : R;
        voffA[i] = (unsigned)(R * K + C) * 2u; voffB[i] = (unsigned)(Rb * K + C) * 2u; }
    const size_t kstep = (size_t)(BK * 2);
    const size_t hstep = (size_t)HALF * K * 2;
    const size_t tstep = 2 * hstep;
    const unsigned ldsw = (unsigned)wid * 1024u;
    const int aoff = lds_byte(wr * 64 + fr, fq * 8), boff = lds_byte(wc * 32 + fr, fq * 8);
#define PG8_SA(b, h) (((b) * 2 + (h)) * HTB)
#define PG8_SB(b, h) ((4 + (b) * 2 + (h)) * HTB)
#define PG8_STAGE(bufoff, gbase, voff) do { _Pragma("unroll") for (int _i = 0; _i < 2; ++_i) \
        __builtin_amdgcn_global_load_lds((const unsigned*)((const char*)(gbase) + (voff)[_i]), (LAS unsigned*)(lds + (bufoff) + ldsw + _i * 8192), 16, 0, 0); } while (0)
#define PG8_LDA(dst, b, h) do { _Pragma("unroll") for (int m = 0; m < 4; ++m) _Pragma("unroll") for (int k = 0; k < 2; ++k) dst[m][k] = *(const LAS bf16x8*)(lds + PG8_SA(b, h) + aoff + m * 2048 + k * 1024); } while (0)
#define PG8_LDB(dst, b, h) do { _Pragma("unroll") for (int n = 0; n < 2; ++n) _Pragma("unroll") for (int k = 0; k < 2; ++k) dst[n][k] = *(const LAS bf16x8*)(lds + PG8_SB(b, h) + boff + n * 2048 + k * 1024); } while (0)
#define PG8_MMA(ai, bj, At, Bt) do { __builtin_amdgcn_s_setprio(1); _Pragma("unroll") for (int m = 0; m < 4; ++m) _Pragma("unroll") for (int n = 0; n < 2; ++n) _Pragma("unroll") for (int k = 0; k < 2; ++k) \
        acc[ai][bj][m][n] = __builtin_amdgcn_mfma_f32_16x16x32_bf16(Bt[n][k], At[m][k], acc[ai][bj][m][n], 0, 0, 0); __builtin_amdgcn_s_setprio(0); } while (0)
#define PG8_WAIT_V(n) asm volatile("s_waitcnt vmcnt(" #n ")" ::: "memory")
#define PG8_WAIT_L(n) asm volatile("s_waitcnt lgkmcnt(" #n ")" ::: "memory")
#define PG8_BAR __builtin_amdgcn_s_barrier()
#define PG8_SCHED __builtin_amdgcn_sched_barrier(0)
    Unit cur, nxt; int ui = 0;
    if (!S.next(0, cur)) return;
    f32x4 acc[2][2][4][2];
#pragma unroll
    for (int a = 0; a < 2; ++a)
#pragma unroll
        for (int b = 0; b < 2; ++b)
#pragma unroll
            for (int m = 0; m < 4; ++m)
#pragma unroll
                for (int n = 0; n < 2; ++n) acc[a][b][m][n] = (f32x4){0.f, 0.f, 0.f, 0.f};
    bf16x8 At[4][2], B0[2][2], B1[2][2];
    const char* cA = (const char*)g.A + (size_t)cur.pm * tstep; const char* cB = (const char*)g.Bt + (size_t)cur.pn * tstep;
    S.a_ready(cur);
    typename Epi::Pre pre = E.pre(cur, wr, wc, fr, fq);
    if constexpr (SP2) {
        PG8_STAGE(PG8_SB(0, 0), cB, voffB); PG8_STAGE(PG8_SB(0, 1), cB + hstep, voffB); PG8_STAGE(PG8_SA(0, 0), cA, voffA); PG8_STAGE(PG8_SA(0, 1), cA + hstep, voffA);
        if (wr == 1) PG8_BAR;
        PG8_WAIT_V(2); PG8_BAR;
        PG8_STAGE(PG8_SB(1, 0), cB + kstep, voffB); PG8_STAGE(PG8_SA(1, 0), cA + kstep, voffA); PG8_STAGE(PG8_SB(1, 1), cB + hstep + kstep, voffB);
        PG8_WAIT_V(6); PG8_BAR;
    } else {
        PG8_STAGE(PG8_SB(0, 0), cB, voffB); PG8_STAGE(PG8_SA(0, 0), cA, voffA); PG8_STAGE(PG8_SB(0, 1), cB + hstep, voffB); PG8_STAGE(PG8_SA(0, 1), cA + hstep, voffA);
        if (wr == 1) PG8_BAR;
        PG8_WAIT_V(4); PG8_BAR;
        PG8_STAGE(PG8_SB(1, 0), cB + kstep, voffB); PG8_STAGE(PG8_SA(1, 0), cA + kstep, voffA); PG8_STAGE(PG8_SB(1, 1), cB + hstep + kstep, voffB);
        PG8_WAIT_V(6); PG8_BAR;
    }
    for (;;) {
        const bool has_next = S.next(ui + 1, nxt);
        const char* nA = has_next ? (const char*)g.A + (size_t)nxt.pm * tstep : cA; const char* nB = has_next ? (const char*)g.Bt + (size_t)nxt.pn * tstep : cB;
        for (int t = 0; t < nt; t += 2) {
            const bool last = (t == nt - 2);
            const char* a1 = cA + (size_t)(t + 1) * kstep;
            const char* a2 = last ? nA : cA + (size_t)(t + 2) * kstep; const char* b2 = last ? nB : cB + (size_t)(t + 2) * kstep;
            const char* a3 = a2 + kstep; const char* b3 = b2 + kstep;
            if (last && has_next) S.a_ready(nxt);
            if constexpr (SP2) {
            PG8_LDB(B0, 0, 0); PG8_LDB(B1, 0, 1); PG8_SCHED; PG8_LDA(At, 0, 0); PG8_STAGE(PG8_SA(1, 1), a1 + hstep, voffA);
            PG8_WAIT_V(8); PG8_WAIT_L(0); PG8_BAR; PG8_MMA(0, 0, At, B0); PG8_MMA(0, 1, At, B1); PG8_BAR; PG8_SCHED;
            PG8_LDA(At, 0, 1); PG8_STAGE(PG8_SB(0, 0), b2, voffB); PG8_STAGE(PG8_SB(0, 1), b2 + hstep, voffB); PG8_STAGE(PG8_SA(0, 0), a2, voffA);
            PG8_WAIT_V(8); PG8_WAIT_L(0); PG8_BAR; PG8_MMA(1, 0, At, B0); PG8_MMA(1, 1, At, B1); PG8_BAR; PG8_SCHED;
            PG8_LDB(B0, 1, 0); PG8_LDB(B1, 1, 1); PG8_SCHED; PG8_LDA(At, 1, 0); PG8_STAGE(PG8_SA(0, 1), a2 + hstep, voffA);
            PG8_WAIT_V(8); PG8_WAIT_L(0); PG8_BAR; PG8_MMA(0, 0, At, B0); PG8_MMA(0, 1, At, B1); PG8_BAR; PG8_SCHED;
            PG8_LDA(At, 1, 1); PG8_STAGE(PG8_SB(1, 0), b3, voffB); PG8_STAGE(PG8_SB(1, 1), b3 + hstep, voffB); PG8_STAGE(PG8_SA(1, 0), a3, voffA);
            PG8_WAIT_V(8); PG8_WAIT_L(0); PG8_BAR; PG8_MMA(1, 0, At, B0); PG8_MMA(1, 1, At, B1); PG8_BAR; PG8_SCHED;
            } else {
            PG8_LDB(B0, 0, 0); PG8_SCHED; PG8_LDA(At, 0, 0); PG8_STAGE(PG8_SA(1, 1), a1 + hstep, voffA);
            PG8_WAIT_L(8); PG8_BAR; PG8_WAIT_L(0); PG8_MMA(0, 0, At, B0); PG8_BAR; PG8_SCHED;
            PG8_LDB(B1, 0, 1); PG8_STAGE(PG8_SB(0, 0), b2, voffB);
            PG8_BAR; PG8_WAIT_L(0); PG8_MMA(0, 1, At, B1); PG8_BAR;
            PG8_LDA(At, 0, 1); PG8_STAGE(PG8_SA(0, 0), a2, voffA);
            PG8_BAR; PG8_WAIT_L(0); PG8_MMA(1, 0, At, B0); PG8_BAR; PG8_SCHED;
            PG8_STAGE(PG8_SB(0, 1), b2 + hstep, voffB);
            PG8_WAIT_V(6); PG8_BAR; PG8_MMA(1, 1, At, B1); PG8_BAR;
            PG8_LDB(B0, 1, 0); PG8_SCHED; PG8_LDA(At, 1, 0); PG8_STAGE(PG8_SA(0, 1), a2 + hstep, voffA);
            PG8_WAIT_L(8); PG8_BAR; PG8_WAIT_L(0); PG8_MMA(0, 0, At, B0); PG8_BAR; PG8_SCHED;
            PG8_LDB(B1, 1, 1); PG8_STAGE(PG8_SB(1, 0), b3, voffB);
            PG8_BAR; PG8_WAIT_L(0); PG8_MMA(0, 1, At, B1); PG8_BAR;
            PG8_LDA(At, 1, 1); PG8_STAGE(PG8_SA(1, 0), a3, voffA);
            PG8_BAR; PG8_WAIT_L(0); PG8_MMA(1, 0, At, B0); PG8_BAR; PG8_SCHED;
            PG8_STAGE(PG8_SB(1, 1), b3 + hstep, voffB);
            PG8_WAIT_V(6); PG8_BAR; PG8_MMA(1, 1, At, B1); PG8_BAR;
            }
        }
        if constexpr (ALIGN_EPI) { if (wr == 0) PG8_BAR; }
        if constexpr (!Epi::AFTER_DRAIN) { unsigned* ctl = E.probe_ctl(); TSTART(51) E(acc, cur, pre, wr, wc, fr, fq); if (ctl) { TSTOP(51, ctl) } S.done(cur); }
        if (!has_next) break;
#pragma unroll
        for (int a = 0; a < 2; ++a)
#pragma unroll
            for (int b = 0; b < 2; ++b)
#pragma unroll
                for (int m = 0; m < 4; ++m)
#pragma unroll
                    for (int n = 0; n < 2; ++n) acc[a][b][m][n] = (f32x4){0.f, 0.f, 0.f, 0.f};
        cur = nxt; cA = nA; cB = nB; ++ui;
        pre = E.pre(cur, wr, wc, fr, fq);
        if constexpr (ALIGN_EPI) { if (wr == 1) PG8_BAR; }
    }
    PG8_WAIT_V(0);
    if constexpr (!ALIGN_EPI) { if (wr == 0) PG8_BAR; }
    PG8_BAR;
#undef PG8_SA
#undef PG8_SB
#undef PG8_STAGE
#undef PG8_LDA
#undef PG8_LDB
#undef PG8_MMA
#undef PG8_WAIT_V
#undef PG8_WAIT_L
#undef PG8_BAR
#undef PG8_SCHED
}
}

__device__ __forceinline__ void qk_tile(f32x16& p0, f32x16& p1, lds_cptr Kt, const bf16x8 (&qr)[4], int r32, int hi) {
    lds_cptr kb = Kt + hi * 1024 + r32 * 16;
#pragma unroll
    for (int d0 = 0; d0 < 4; ++d0) {
        const bf16x8 b0 = *(const LAS bf16x8*)(kb + d0 * 2048);
        const bf16x8 b1 = *(const LAS bf16x8*)(kb + d0 * 2048 + 512);
        p0 = __builtin_amdgcn_mfma_f32_32x32x16_bf16(b0, qr[d0], p0, 0, 0, 0);
        p1 = __builtin_amdgcn_mfma_f32_32x32x16_bf16(b1, qr[d0], p1, 0, 0, 0);
    }
}
__device__ __forceinline__ void qk_tile_rm(f32x16& p0, f32x16& p1, lds_cptr Kt, const bf16x8 (&qr)[4], int r32, int hi) {
    lds_cptr k0 = Kt + r32 * 128, k1 = Kt + (r32 + 32) * 128; const int sw = r32 & 7;
#pragma unroll
    for (int d0 = 0; d0 < 4; ++d0) {
        const int off = ((2 * d0 + hi) ^ sw) * 16;
        const bf16x8 b0 = *(const LAS bf16x8*)(k0 + off);
        const bf16x8 b1 = *(const LAS bf16x8*)(k1 + off);
        p0 = __builtin_amdgcn_mfma_f32_32x32x16_bf16(b0, qr[d0], p0, 0, 0, 0);
        p1 = __builtin_amdgcn_mfma_f32_32x32x16_bf16(b1, qr[d0], p1, 0, 0, 0);
    }
}
__device__ __forceinline__ float max3f(float a, float b, float c) { float r; asm("v_max3_f32 %0, %1, %2, %3" : "=v"(r) : "v"(a), "v"(b), "v"(c)); return r; }
__device__ __forceinline__ float max32(const f32x16& p0, const f32x16& p1) {
    float a = max3f(p0[0], p0[1], p1[0]), b = max3f(p0[2], p0[3], p1[1]); a = max3f(a, p1[2], p1[3]);
#pragma unroll
    for (int r = 4; r < 16; r += 4) { a = max3f(a, p0[r], p0[r + 1]); b = max3f(b, p0[r + 2], p0[r + 3]); a = max3f(a, p1[r], p1[r + 1]); b = max3f(b, p1[r + 2], p1[r + 3]); }
    float m; asm("v_max_f32_e32 %0, %1, %2" : "=v"(m) : "v"(a), "v"(b)); return m;
}
template <int NDB, bool NOMAX = false>
__device__ __forceinline__ void softmax_pv(f32x16 (&o)[NDB], float& mref, float& lrun, f32x16& p0, f32x16& p1, lds_cptr Vt, LAS float* wsf, int r32, int hi, int lane) {
    if constexpr (!NOMAX) {
    asm volatile("s_nop 15\n\ts_nop 7" : "+v"(p0), "+v"(p1));
    float rm = xhalf_max(max32(p0, p1));
    if (__any(rm > 8.f)) {
        const float dl = fmaxf(rm, 0.f); mref += dl;
#pragma unroll
        for (int r = 0; r < 16; ++r) { p0[r] -= dl; p1[r] -= dl; }
        const float f = __builtin_amdgcn_exp2f(-dl); lrun *= f;
        if (hi == 0) wsf[r32] = f;
#pragma unroll
        for (int r = 0; r < 16; ++r) { const float fr_ = wsf[crow(r, hi)];
#pragma unroll
            for (int db = 0; db < NDB; ++db) o[db][r] *= fr_; }
    }
    }
    float s = 0.f;
#pragma unroll
    for (int r = 0; r < 16; ++r) { p0[r] = __builtin_amdgcn_exp2f(p0[r]); p1[r] = __builtin_amdgcn_exp2f(p1[r]); s += p0[r] + p1[r]; }
    lrun += s;
    u32x4 pw[4];
#pragma unroll
    for (int k = 0; k < 4; ++k) {
        pw[0][k] = cvtpk(p0[2 * k], p0[2 * k + 1]); pw[1][k] = cvtpk(p0[8 + 2 * k], p0[8 + 2 * k + 1]);
        pw[2][k] = cvtpk(p1[2 * k], p1[2 * k + 1]); pw[3][k] = cvtpk(p1[8 + 2 * k], p1[8 + 2 * k + 1]);
    }
    lds_cptr vp = Vt + ((lane >> 4) & 1) * 32 + (lane & 3) * 8 + (4 * hi + ((lane & 15) >> 2)) * 64;
#pragma unroll
    for (int ks = 0; ks < 4; ++ks) {
#pragma unroll
        for (int db = 0; db < NDB; ++db) {
            const s16x4 lo = vtr(vp + db * 4096 + ks * 1024), hh = vtr(vp + db * 4096 + ks * 1024 + 512);
            const bf16x8 vf = (bf16x8){lo[0], lo[1], lo[2], lo[3], hh[0], hh[1], hh[2], hh[3]};
            o[db] = __builtin_amdgcn_mfma_f32_32x32x16_bf16(__builtin_bit_cast(bf16x8, pw[ks]), vf, o[db], 0, 0, 0);
        }
    }
}

template <int NDB>
__device__ __forceinline__ void softmax_pv2n(f32x16 (&o)[NDB], float& lrun, f32x16& a0, f32x16& a1, f32x16& b0, f32x16& b1, lds_cptr VtA, lds_cptr VtB, int hi, int lane) {
    float s = 0.f;
#pragma unroll
    for (int r = 0; r < 16; ++r) { a0[r] = __builtin_amdgcn_exp2f(a0[r]); a1[r] = __builtin_amdgcn_exp2f(a1[r]); s += a0[r] + a1[r]; }
    const int voff = ((lane >> 4) & 1) * 32 + (lane & 3) * 8 + (4 * hi + ((lane & 15) >> 2)) * 64;
    {
        u32x4 pw[4];
#pragma unroll
        for (int k = 0; k < 4; ++k) {
            pw[0][k] = cvtpk(a0[2 * k], a0[2 * k + 1]); pw[1][k] = cvtpk(a0[8 + 2 * k], a0[8 + 2 * k + 1]);
            pw[2][k] = cvtpk(a1[2 * k], a1[2 * k + 1]); pw[3][k] = cvtpk(a1[8 + 2 * k], a1[8 + 2 * k + 1]);
        }
        lds_cptr vp = VtA + voff;
#pragma unroll
        for (int ks = 0; ks < 4; ++ks)
#pragma unroll
            for (int db = 0; db < NDB; ++db) {
                const s16x4 lo = vtr(vp + db * 4096 + ks * 1024), hh = vtr(vp + db * 4096 + ks * 1024 + 512);
                const bf16x8 vf = (bf16x8){lo[0], lo[1], lo[2], lo[3], hh[0], hh[1], hh[2], hh[3]};
                o[db] = __builtin_amdgcn_mfma_f32_32x32x16_bf16(__builtin_bit_cast(bf16x8, pw[ks]), vf, o[db], 0, 0, 0);
            }
    }
#pragma unroll
    for (int r = 0; r < 16; ++r) { b0[r] = __builtin_amdgcn_exp2f(b0[r]); b1[r] = __builtin_amdgcn_exp2f(b1[r]); s += b0[r] + b1[r]; }
    lrun += s;
    {
        u32x4 pw[4];
#pragma unroll
        for (int k = 0; k < 4; ++k) {
            pw[0][k] = cvtpk(b0[2 * k], b0[2 * k + 1]); pw[1][k] = cvtpk(b0[8 + 2 * k], b0[8 + 2 * k + 1]);
            pw[2][k] = cvtpk(b1[2 * k], b1[2 * k + 1]); pw[3][k] = cvtpk(b1[8 + 2 * k], b1[8 + 2 * k + 1]);
        }
        lds_cptr vp = VtB + voff;
#pragma unroll
        for (int ks = 0; ks < 4; ++ks)
#pragma unroll
            for (int db = 0; db < NDB; ++db) {
                const s16x4 lo = vtr(vp + db * 4096 + ks * 1024), hh = vtr(vp + db * 4096 + ks * 1024 + 512);
                const bf16x8 vf = (bf16x8){lo[0], lo[1], lo[2], lo[3], hh[0], hh[1], hh[2], hh[3]};
                o[db] = __builtin_amdgcn_mfma_f32_32x32x16_bf16(__builtin_bit_cast(bf16x8, pw[ks]), vf, o[db], 0, 0, 0);
            }
    }
}

constexpr int AT_STAGE = 32768, AT_XCHG = 0, AT_STG = 65536, AT_WSF = 131072;
template <bool NOMAX>
__device__ __forceinline__ void attnA_unit(const int b, const int h, const int qb, const int t0, const bf16_t* __restrict__ E, bf16_t* __restrict__ Y, const float lam, const float* __restrict__ subln, unsigned char* lds, unsigned* ctl) {
    int tid_ = threadIdx.x; asm volatile("" : "+v"(tid_));
    const int tid = tid_, lane = tid & 63, r32 = lane & 31, hi = lane >> 5; const int wid = __builtin_amdgcn_readfirstlane(tid >> 6);
    const int mm = wid >> 2, rb = wid & 3;
    const int q0w = 128 * qb + 32 * rb, iq = q0w + r32, NT = 2 * (qb + 1);
    const bf16_t* Eb = E + (size_t)b * SEQ * EP;
    const unsigned lds0 = (unsigned)(uintptr_t)(LAS unsigned char*)lds;
    lds_cptr L = (lds_cptr)(LAS unsigned char*)lds;
    LAS float* wsf = (LAS float*)((LAS unsigned char*)lds + AT_WSF) + wid * 64;
    const bf16_t* src[4]; unsigned dsto[4];
#pragma unroll
    for (int i4 = 0; i4 < 4; ++i4) {
        if (wid < 4) { const int pidx = wid * 4 + i4, m_ = pidx >> 3, rg8 = pidx & 7, rowl = lane >> 3, cg = (lane & 7) ^ rowl;
            src[i4] = Eb + (size_t)(8 * rg8 + rowl) * EP + C_AK + h * 128 + m_ * 64 + cg * 8; dsto[i4] = m_ * 8192 + rg8 * 1024; }
        else { const int pidx = (wid - 4) * 4 + i4, db = pidx >> 2, rg = pidx & 3;
            src[i4] = Eb + (size_t)(16 * rg + (lane >> 2)) * EP + C_AV + h * 128 + db * 32 + (lane & 3) * 8; dsto[i4] = 16384 + db * 4096 + rg * 1024; }
    }
#define AT_DMA(t, stg) do { _Pragma("unroll") for (int i4 = 0; i4 < 4; ++i4) glds16(src[i4] + (size_t)(t) * 64 * EP, (unsigned)__builtin_amdgcn_readfirstlane(lds0 + (stg) * AT_STAGE + dsto[i4])); } while (0)
    const int p0i = t0 >> 1, NP = NT >> 1;
    AT_DMA(2 * p0i, 0); AT_DMA(2 * p0i + 1, 1);
    bf16x8 qr[4];
    { const bf16_t* Qw = Eb + (size_t)iq * EP + C_AQ + h * 128 + mm * 64;
#pragma unroll
      for (int d0 = 0; d0 < 4; ++d0) qr[d0] = *(const bf16x8*)(Qw + d0 * 16 + hi * 8); }
    const float slope2 = __builtin_amdgcn_exp2f(-2.f * (float)(h + 1)) * LOG2E;
    f32x16 o[4];
#pragma unroll
    for (int db = 0; db < 4; ++db) o[db] = f32x16{};
    float mref = 0.f, lrun = 0.f;
    for (int pp = p0i; pp < NP; ++pp) {
        WAITV_BAR();
        if (pp + 1 < NP) { const int sb = 2 * ((pp + 1 - p0i) & 1); AT_DMA(2 * pp + 2, sb); AT_DMA(2 * pp + 3, sb + 1); }
        if (NOMAX && 128 * pp + 127 <= q0w) {
            lds_cptr stA = L + (2 * ((pp - p0i) & 1)) * AT_STAGE, stB = stA + AT_STAGE;
            const float tbA = slope2 * (float)(128 * pp - iq), tbB = tbA + 64.f * slope2;
            f32x16 a0, a1, b0, b1;
#pragma unroll
            for (int r = 0; r < 16; ++r) { a0[r] = tbA + slope2 * (float)crow(r, hi); a1[r] = a0[r] + 32.f * slope2; b0[r] = tbB + slope2 * (float)crow(r, hi); b1[r] = b0[r] + 32.f * slope2; }
            qk_tile_rm(a0, a1, stA + mm * 8192, qr, r32, hi);
            qk_tile_rm(b0, b1, stB + mm * 8192, qr, r32, hi);
            softmax_pv2n<4>(o, lrun, a0, a1, b0, b1, stA + 16384, stB + 16384, hi, lane);
        } else
#pragma unroll 1
        for (int tt = 0; tt < 2; ++tt) {
        const int t = 2 * pp + tt;
        if (64 * t <= q0w + 31) {
            lds_cptr st = L + (2 * ((pp - p0i) & 1) + tt) * AT_STAGE;
            const float tbm = slope2 * (float)(64 * t - iq) - mref;
            f32x16 p0, p1;
#pragma unroll
            for (int r = 0; r < 16; ++r) { p0[r] = tbm + slope2 * (float)crow(r, hi); p1[r] = p0[r] + 32.f * slope2; }
            qk_tile_rm(p0, p1, st + mm * 8192, qr, r32, hi);
            if (64 * t + 63 > q0w) {
                const int kb = 64 * t + 4 * hi;
#pragma unroll
                for (int r = 0; r < 16; ++r) { const int kv = kb + (r & 3) + 8 * (r >> 2); if (kv > iq) p0[r] = -1e30f; if (kv + 32 > iq) p1[r] = -1e30f; }
            }
            softmax_pv<4, NOMAX>(o, mref, lrun, p0, p1, st + 16384, wsf, r32, hi, lane);
        }
        }
    }
#undef AT_DMA
    lrun = xhalf_sum(lrun);
    if (hi == 0) wsf[r32] = lrun;
    float rli[16];
#pragma unroll
    for (int r = 0; r < 16; ++r) rli[r] = __builtin_amdgcn_rcpf(wsf[crow(r, hi)]);
    LAS float* xb = (LAS float*)((LAS unsigned char*)lds + AT_XCHG) + rb * 4096;
    WAITL_BAR();
    if (mm == 1) {
#pragma unroll
        for (int db = 0; db < 4; ++db)
#pragma unroll
            for (int r = 0; r < 16; ++r) xb[(db * 16 + r) * 64 + lane] = o[db][r] * rli[r] * lam;
    }
    WAITL_BAR();
    if (mm == 0) {
        float ss[16];
#pragma unroll
        for (int r = 0; r < 16; ++r) ss[r] = 0.f;
#pragma unroll
        for (int db = 0; db < 4; ++db)
#pragma unroll
            for (int r = 0; r < 16; ++r) { const float dv = o[db][r] * rli[r] - xb[(db * 16 + r) * 64 + lane]; o[db][r] = dv; ss[r] += dv * dv; }
        LAS float* prt = (LAS float*)((LAS unsigned char*)lds + AT_STG + 32768) + rb * 1152;
#pragma unroll
        for (int r = 0; r < 16; ++r) prt[crow(r, hi) * 36 + r32] = ss[r];
        if (hi == 0) { float tot = 0.f;
#pragma unroll
            for (int k4 = 0; k4 < 8; ++k4) { const f32x4 pv = *(const LAS f32x4*)(prt + r32 * 36 + 4 * k4); tot += (pv[0] + pv[1]) + (pv[2] + pv[3]); }
            wsf[r32] = __builtin_amdgcn_rsqf(tot * (1.f / 128.f) + EPS) * 0.8f; }
#pragma unroll
        for (int r = 0; r < 16; ++r) ss[r] = wsf[crow(r, hi)];
        LAS bf16_t* stg = (LAS bf16_t*)((LAS unsigned char*)lds + AT_STG) + rb * 4096;
#pragma unroll
        for (int db = 0; db < 4; ++db) { const float gsub = subln[db * 32 + r32];
#pragma unroll
            for (int r = 0; r < 16; ++r) stg[crow(r, hi) * 128 + db * 32 + r32] = f2bf(o[db][r] * ss[r] * gsub); }
        bf16_t* Yw = Y + (size_t)(b * SEQ + q0w) * D + h * 128;
#pragma unroll
        for (int i8 = 0; i8 < 8; ++i8) { const int row = i8 * 4 + (lane >> 4), ch = lane & 15; const u32x4 v = *(const LAS u32x4*)(stg + row * 128 + ch * 8);
            *(u32x4*)(Yw + (size_t)row * D + ch * 8) = v; }
    }
    WAITL_BAR();
}

constexpr int SW_V = 32768, SW_OST = 65536;
__device__ __forceinline__ void swa_unit(const int b, const int kvh, const int nb, const bf16_t* __restrict__ E1, bf16_t* __restrict__ Y, const float* __restrict__ qn_c, const float* __restrict__ kn_c,
                                         const float* __restrict__ sinks, unsigned char* lds, unsigned* ctl) {
    TSTART(41)
    int tid_ = threadIdx.x; asm volatile("" : "+v"(tid_));
    const int tid = tid_, lane = tid & 63, r32 = lane & 31, hi = lane >> 5; const int wid = __builtin_amdgcn_readfirstlane(tid >> 6);
    const bf16_t* Eb = E1 + (size_t)b * SEQ * E1S;
    LAS unsigned char* l3 = (LAS unsigned char*)lds;
    lds_cptr L = (lds_cptr)l3;
    LAS float* wsf = (LAS float*)(l3 + AT_WSF) + wid * 64;
    const int kt0 = (nb == 0) ? 2 : 0;
    {
        const int sub = lane & 7, rowi = tid >> 3;
        float kg[8];
#pragma unroll
        for (int i = 0; i < 8; ++i) kg[i] = kn_c[sub * 8 + i];
        for (int kt = kt0; kt < 4; ++kt) {
            const int key = 128 * (nb - 1) + 64 * kt + rowi;
            const u32x4 kr = *(const u32x4*)(Eb + (size_t)key * E1S + C1_K + kvh * 64 + sub * 8);
            const u32x4 vr = *(const u32x4*)(Eb + (size_t)key * E1S + C1_V + kvh * 64 + sub * 8);
            float v[8];
            v[0] = __uint_as_float(kr.x << 16); v[1] = __uint_as_float(kr.x & 0xffff0000u); v[2] = __uint_as_float(kr.y << 16); v[3] = __uint_as_float(kr.y & 0xffff0000u);
            v[4] = __uint_as_float(kr.z << 16); v[5] = __uint_as_float(kr.z & 0xffff0000u); v[6] = __uint_as_float(kr.w << 16); v[7] = __uint_as_float(kr.w & 0xffff0000u);
            float ss = 0.f;
#pragma unroll
            for (int i = 0; i < 8; ++i) ss += v[i] * v[i];
            ss += __shfl_xor(ss, 1); ss += __shfl_xor(ss, 2); ss += __shfl_xor(ss, 4);
            const float rr = __builtin_amdgcn_rsqf(ss * (1.f / 64.f) + EPS);
            u32x4 kw;
            kw.x = cvtpk(v[0] * rr * kg[0], v[1] * rr * kg[1]); kw.y = cvtpk(v[2] * rr * kg[2], v[3] * rr * kg[3]);
            kw.z = cvtpk(v[4] * rr * kg[4], v[5] * rr * kg[5]); kw.w = cvtpk(v[6] * rr * kg[6], v[7] * rr * kg[7]);
            *(LAS u32x4*)(l3 + kt * 8192 + sub * 1024 + rowi * 16) = kw;
            *(LAS u32x4*)(l3 + SW_V + kt * 8192 + (sub >> 2) * 4096 + (rowi >> 4) * 1024 + (rowi & 15) * 64 + (sub & 3) * 16) = vr;
        }
    }
    WAITL_BAR();
    TSTOP(41, ctl)
    TSTART(42)
    const int g = wid >> 1, head = kvh * 4 + g;
    const float slope2 = __builtin_amdgcn_exp2f(-0.5f * (float)(head + 1)) * LOG2E;
    const float sink2 = sinks[head] * LOG2E;
    float qg[4][8];
#pragma unroll
    for (int d0 = 0; d0 < 4; ++d0)
#pragma unroll
        for (int i = 0; i < 8; ++i) qg[d0][i] = qn_c[d0 * 16 + hi * 8 + i] * QS;
    for (int rbi = 0; rbi < 2; ++rbi) {
        const int rb = 2 * (wid & 1) + rbi, rloc = 32 * rb + r32;
        const int tok = b * SEQ + 128 * nb + rloc;
        bf16x8 qr[4];
        { const bf16_t* Qw = E1 + (size_t)tok * E1S + C1_Q + head * 64; u32x4 raw[4]; float ss = 0.f;
#pragma unroll
          for (int d0 = 0; d0 < 4; ++d0) { raw[d0] = *(const u32x4*)(Qw + d0 * 16 + hi * 8);
#pragma unroll
              for (int k = 0; k < 4; ++k) { const float a = __uint_as_float(raw[d0][k] << 16), c = __uint_as_float(raw[d0][k] & 0xffff0000u); ss += a * a + c * c; } }
          ss = xhalf_sum(ss);
          const float rr = __builtin_amdgcn_rsqf(ss * (1.f / 64.f) + EPS);
#pragma unroll
          for (int d0 = 0; d0 < 4; ++d0) { u32x4 w;
#pragma unroll
              for (int k = 0; k < 4; ++k) { const float a = __uint_as_float(raw[d0][k] << 16), c = __uint_as_float(raw[d0][k] & 0xffff0000u);
                  w[k] = cvtpk(a * rr * qg[d0][2 * k], c * rr * qg[d0][2 * k + 1]); }
              qr[d0] = __builtin_bit_cast(bf16x8, w); } }
        f32x16 o[2]; o[0] = f32x16{}; o[1] = f32x16{};
        float mref = 0.f, lrun = 0.f;
        const int ktlo = (rb < 2) ? 0 : 1, kthi = (rb < 2) ? 2 : 3;
        for (int kt = ktlo; kt <= kthi; ++kt) {
            if (kt < kt0) continue;
            const float tbm = slope2 * (float)(64 * kt - 128 - rloc) - mref;
            f32x16 p0, p1;
#pragma unroll
            for (int r = 0; r < 16; ++r) { p0[r] = tbm + slope2 * (float)crow(r, hi); p1[r] = p0[r] + 32.f * slope2; }
            qk_tile(p0, p1, L + kt * 8192, qr, r32, hi);
            const int jb = 64 * kt + 4 * hi;
            if (!(64 * kt >= 32 * rb + 32 && 64 * kt + 63 <= 32 * rb + 128))
#pragma unroll
            for (int r = 0; r < 16; ++r) { const int jj = jb + (r & 3) + 8 * (r >> 2);
                if (jj < rloc + 1 || jj > rloc + 128) p0[r] = -1e30f;
                if (jj + 32 < rloc + 1 || jj + 32 > rloc + 128) p1[r] = -1e30f; }
            softmax_pv<2>(o, mref, lrun, p0, p1, L + SW_V + kt * 8192, wsf, r32, hi, lane);
        }
        lrun = xhalf_sum(lrun) + __builtin_amdgcn_exp2f(sink2 - mref);
        if (hi == 0) wsf[r32] = lrun;
        LAS bf16_t* stg = (LAS bf16_t*)(l3 + SW_OST) + wid * 2048;
#pragma unroll
        for (int r = 0; r < 16; ++r) { const float rl = __builtin_amdgcn_rcpf(wsf[crow(r, hi)]);
#pragma unroll
            for (int db = 0; db < 2; ++db) stg[crow(r, hi) * 64 + db * 32 + r32] = f2bf(o[db][r] * rl); }
        bf16_t* Yw = Y + (size_t)(b * SEQ + 128 * nb + 32 * rb) * D + head * 64;
#pragma unroll
        for (int i4 = 0; i4 < 4; ++i4) { const int row = i4 * 8 + (lane >> 3), ch = lane & 7; const u32x4 v = *(const LAS u32x4*)(stg + row * 64 + ch * 8);
            *(u32x4*)(Yw + (size_t)row * D + ch * 8) = v; }
    }
    TSTOP(42, ctl)
    TSTART(43)
    WAITL_BAR();
    TSTOP(43, ctl)
}

constexpr int DS_KSTR = 4096, DS_QROW = DS_KSTR * 4;
constexpr int DS_STG = 131072;
#define MFMA16(a, b, c) __builtin_amdgcn_mfma_f32_16x16x32_bf16((a), (b), (c), 0, 0, 0)
#ifndef DSA_REP1
#define DSA_REP1 1
#endif
#ifndef DSA_REP2
#define DSA_REP2 1
#endif
#ifndef DSA_REP3
#define DSA_REP3 1
#endif
__device__ __forceinline__ int pick_digit(const u32x4 hv, int& remaining, int lane) {
    const int s = (int)(hv[0] + hv[1] + hv[2] + hv[3]);
    int suf = s;
#pragma unroll
    for (int off = 1; off < 64; off <<= 1) { const int tv = __shfl_down(suf, off); if (lane + off < 64) suf += tv; }
    int cum = suf - s, found = -1, remn = 0;
#pragma unroll
    for (int d = 3; d >= 0; --d) { const int c = (int)hv[d]; if (found < 0 && cum < remaining && cum + c >= remaining) { found = 4 * lane + d; remn = remaining - cum; } cum += c; }
    const unsigned long long bal = __ballot(found >= 0);
    const int srcl = (int)__ffsll((long long)bal) - 1;
    remaining = __shfl(remn, srcl);
    return __shfl(found, srcl);
}
template <int NR, bool REGS>
__device__ __forceinline__ int select_from_candidates(LAS const u32x2* pk, const unsigned (&kreg)[64], const int ncr, const int lane, const unsigned Lb, const unsigned step, LAS unsigned short* list) {
    unsigned cr[NR], ci[NR];
    if constexpr (REGS) {
#pragma unroll
        for (int r = 0; r < NR; ++r) { cr[r] = kreg[r]; ci[r] = (unsigned)(64 * r + lane); }
    } else {
#pragma unroll
        for (int r = 0; r < NR; ++r) { u32x2 v = (u32x2){0u, 0u}; if (r < ncr) v = pk[64 * r + lane]; cr[r] = v[0]; ci[r] = v[1]; }
    }
    unsigned prefix = 0u, mbit = 0x80000000u; bool exact = false; int need = 0;
    if (Lb != 0u && Lb + step != 0u) { const unsigned up = Lb + step; int c = 0;
#pragma unroll
        for (int r8 = 0; r8 < NR; r8 += 8) {
            unsigned long long bm[8];
#pragma unroll
            for (int r = 0; r < 8; ++r) bm[r] = __ballot(cr[r8 + r] >= up);
            __builtin_amdgcn_sched_barrier(0);
#pragma unroll
            for (int r = 0; r < 8; ++r) c += __popcll(bm[r]);
            __builtin_amdgcn_sched_barrier(0);
        }
        if (c < 256) { prefix = Lb; mbit = step >> 1; } }
#pragma unroll 1
    for (;;) {
        asm volatile("" : "+s"(mbit), "+s"(prefix));
        const unsigned cand = prefix | mbit; int c = 0;
#pragma unroll
        for (int r8 = 0; r8 < NR; r8 += 8) {
            unsigned long long bm[8];
#pragma unroll
            for (int r = 0; r < 8; ++r) bm[r] = __ballot(cr[r8 + r] >= cand);
            __builtin_amdgcn_sched_barrier(0);
#pragma unroll
            for (int r = 0; r < 8; ++r) c += __popcll(bm[r]);
            __builtin_amdgcn_sched_barrier(0);
        }
        if (c >= 256) { prefix = cand; if (c == 256) { exact = true; break; } }
        mbit >>= 1; if (mbit == 0u) break;
    }
    if (exact) prefix -= 1u;
    const unsigned T = prefix;
    int basep = 0;
#pragma unroll
    for (int r8 = 0; r8 < NR; r8 += 8) {
        unsigned long long bs[8]; int off[8];
#pragma unroll
        for (int j = 0; j < 8; ++j) bs[j] = __ballot(cr[r8 + j] > T);
        __builtin_amdgcn_sched_barrier(0);
#pragma unroll
        for (int j = 0; j < 8; ++j) { off[j] = basep; basep += __popcll(bs[j]); }
        __builtin_amdgcn_sched_barrier(0);
#pragma unroll
        for (int j = 0; j < 8; ++j) {
            const int pos = (int)__builtin_amdgcn_mbcnt_hi((unsigned)(bs[j] >> 32), __builtin_amdgcn_mbcnt_lo((unsigned)bs[j], (unsigned)off[j]));
            list[(cr[r8 + j] > T) ? pos : 319] = (unsigned short)ci[r8 + j]; }
        __builtin_amdgcn_sched_barrier(0);
    }
    if (!exact) {
        need = 256 - basep;
#pragma unroll
        for (int r = 0; r < NR; ++r) {
            const bool eq = cr[r] == T;
            const unsigned long long be = __ballot(eq);
            const int rank = (int)__builtin_amdgcn_mbcnt_hi((unsigned)(be >> 32), __builtin_amdgcn_mbcnt_lo((unsigned)be, 0u));
            const bool sel = eq && rank < need;
            list[sel ? basep + rank : 319] = (unsigned short)ci[r];
            int c = __popcll(be); c = c < need ? c : need;
            basep += c; need -= c;
        }
    }
    return basep;
}
struct DsaPre { bf16x8 Aq[2][4]; u32x2 wr[8]; u32x4 nkc[4]; int tag; };
__device__ __forceinline__ void dsa_preload(DsaPre& pre, const int item, const int b, const bf16_t* __restrict__ E, const bf16_t* __restrict__ KC3, const int lane, const int wid) {
    const int k = item - 128, i0 = (511 - k) * 8;
    const int r32 = lane & 31, hi = lane >> 5, qa = r32 >> 3, ha = r32 & 7;
#pragma unroll
    for (int rb = 0; rb < 2; ++rb)
#pragma unroll
        for (int d0 = 0; d0 < 4; ++d0) pre.Aq[rb][d0] = *(const bf16x8*)(E + ((size_t)b * SEQ + i0 + 4 * rb + qa) * EP + C_IQ + ha * 64 + d0 * 16 + hi * 8);
#pragma unroll
    for (int q = 0; q < 8; ++q) pre.wr[q] = *(const u32x2*)(E + ((size_t)b * SEQ + i0 + q) * EP + C_IW + 4 * hi);
    const int nt32 = (i0 + 8 + 31) >> 5, t = wid < nt32 ? wid : nt32 - 1;
    const char* kr = (const char*)(KC3 + ((size_t)b * SEQ + (lane >> 3)) * 64 + (lane & 7) * 8) + (unsigned)(t * (32 * 64 * 2));
#pragma unroll
    for (int i = 0; i < 4; ++i) pre.nkc[i] = *(const u32x4*)(kr + i * 1024);
    pre.tag = item;
}
__device__ __forceinline__ void dsa_unit(const int b, const int i0, const bf16_t* __restrict__ E, const bf16_t* __restrict__ KC3, const unsigned* __restrict__ SGN, bf16_t* __restrict__ Y, unsigned char* lds, unsigned* ctl, DsaPre& pre, const int item, const unsigned nxt) {
    int tid_ = threadIdx.x; asm volatile("" : "+v"(tid_));
    const int tid = tid_, lane = tid & 63, kq = lane >> 4, c16 = lane & 15; const int wid = __builtin_amdgcn_readfirstlane(tid >> 6);
    LAS unsigned char* l3 = (LAS unsigned char*)lds;
    LAS unsigned* keys = (LAS unsigned*)l3;
    const bf16_t* Eb = E + (size_t)b * SEQ * EP;
    const int nt32 = (i0 + 8 + 31) >> 5, n16 = nt32 * 32;
    const int nblk = (n16 + 511) >> 9;
    TSTART(1)
    for (int rep1 = 0; rep1 < DSA_REP1; ++rep1)
    {
        const int r32 = lane & 31, hi = lane >> 5;
        TSTART(11)
        if (pre.tag != item) dsa_preload(pre, item, b, E, KC3, lane, wid);
        bf16x8 Aq[2][4];
#pragma unroll
        for (int rb = 0; rb < 2; ++rb)
#pragma unroll
            for (int d0 = 0; d0 < 4; ++d0) Aq[rb][d0] = pre.Aq[rb][d0];
        float wq[8][4];
#pragma unroll
        for (int q = 0; q < 8; ++q) { const u32x2 wr_ = pre.wr[q];
            wq[q][0] = __uint_as_float(wr_[0] << 16) * IS; wq[q][1] = __uint_as_float(wr_[0] & 0xffff0000u) * IS; wq[q][2] = __uint_as_float(wr_[1] << 16) * IS; wq[q][3] = __uint_as_float(wr_[1] & 0xffff0000u) * IS; }
        const int row8 = lane >> 3, ch8 = lane & 7;
        const char* kbase = (const char*)(KC3 + ((size_t)b * SEQ + row8) * 64 + ch8 * 8);
        LAS unsigned char* sb = l3 + DS_STG + wid * 4096;
        LAS unsigned char* sbw = sb + row8 * 128 + ((ch8 ^ row8) * 16);
        LAS const unsigned char* sbr = sb + r32 * 128;
        LAS unsigned* kout = keys + (4 * (1 - hi)) * DS_KSTR + r32;
        u32x4 nkc[4];
#pragma unroll
        for (int i = 0; i < 4; ++i) nkc[i] = pre.nkc[i];
        for (int x4 = (n16 >> 2) + tid; x4 < 128 * nblk; x4 += 512) {
#pragma unroll
            for (int qq = 0; qq < 8; ++qq) *(LAS u32x4*)(keys + qq * DS_KSTR + 4 * x4) = (u32x4){0u, 0u, 0u, 0u};
        }
        TSTOP(11, ctl)
        TSTART(12)
        for (int t = wid; t < nt32; t += 8) {
#pragma unroll
            for (int i = 0; i < 4; ++i) *(LAS u32x4*)(sbw + i * 1024) = nkc[i];
            { int tn = t + 8; tn = tn < nt32 ? tn : nt32 - 1; const char* kr = kbase + (unsigned)(tn * (32 * 64 * 2));
#pragma unroll
              for (int i = 0; i < 4; ++i) nkc[i] = *(const u32x4*)(kr + i * 1024); }
            bf16x8 bk_[4];
#pragma unroll
            for (int d0 = 0; d0 < 4; ++d0) bk_[d0] = *(const LAS bf16x8*)(sbr + (((2 * d0 + hi) ^ (r32 & 7)) * 16));
            float part[2][4];
#pragma unroll
            for (int rb = 0; rb < 2; ++rb) {
                f32x16 dacc = f32x16{};
#pragma unroll
                for (int d0 = 0; d0 < 4; ++d0) dacc = __builtin_amdgcn_mfma_f32_32x32x16_bf16(Aq[rb][d0], bk_[d0], dacc, 0, 0, 0);
#pragma unroll
                for (int qq = 0; qq < 4; ++qq) { float a = 0.f;
#pragma unroll
                    for (int j = 0; j < 4; ++j) { const float xv_ = dacc[4 * qq + j]; const int xb_ = __float_as_int(xv_); a = __builtin_fmaf(wq[4 * rb + qq][j], __int_as_float(xb_ > 0 ? xb_ : 0), a); }
                    part[rb][qq] = a; }
            }
            const int key = 32 * t + r32;
#pragma unroll
            for (int qq = 0; qq < 4; ++qq) {
                auto rr = __builtin_amdgcn_permlane32_swap(__float_as_uint(part[1][qq]), __float_as_uint(part[0][qq]), false, false);
                float sv = __uint_as_float(rr[0]) + __uint_as_float(rr[1]); sv += 0.0f;
                const unsigned u = __float_as_uint(sv); unsigned kc = u ^ ((unsigned)((int)u >> 31) | 0x80000000u);
                if (32 * t + 31 > i0) kc = (key <= i0 + 4 * (1 - hi) + qq) ? kc : 0u;
                kout[qq * DS_KSTR + 32 * t] = kc; }
        }
    }
    TSTOP(12, ctl)
    TSTART(16)
    if (tid == 0) *(volatile LAS unsigned*)(l3 + DS_STG + 2048) = nxt;
    WAITL_BAR();
    TSTOP(16, ctl)
    TSTOP(1, ctl)
    TSTART(2)
    const int qi = i0 + wid, nq = qi + 1;
    LAS unsigned short* list = (LAS unsigned short*)(l3 + DS_STG + wid * 4096);
    int cnt = 0;
    {
        TSTART(21)
        LAS unsigned* myk = keys + wid * DS_KSTR;
        unsigned kreg[64];
#pragma unroll
        for (int blk = 0; blk < 8; ++blk) {
            if (blk < nblk) {
#pragma unroll
                for (int i = 8 * blk; i < 8 * blk + 8; ++i) kreg[i] = myk[64 * i + lane];
            } else {
#pragma unroll
                for (int i = 8 * blk; i < 8 * blk + 8; ++i) kreg[i] = 0u;
            }
        }
        unsigned T = 0u; int need = 0, basep = 0; bool from_keys = true;
        asm volatile("s_waitcnt lgkmcnt(0)" ::: "memory");
        TSTOP(21, ctl)
        if (nq > 256 && nq <= 1024) {
            LAS const u32x2* pk0 = (LAS const u32x2*)myk;
            if (nq <= 512) basep = select_from_candidates<8, true>(pk0, kreg, 8, lane, 0u, 0u, list);
            else basep = select_from_candidates<16, true>(pk0, kreg, 16, lane, 0u, 0u, list);
            from_keys = false;
        } else
        if (nq > 256) {
            TSTART(22)
            constexpr int TB = 10, SH = 32 - TB;
            unsigned gmx[16];
#pragma unroll
            for (int g = 0; g < 16; ++g) { const unsigned m0 = kreg[4 * g] > kreg[4 * g + 1] ? kreg[4 * g] : kreg[4 * g + 1], m1 = kreg[4 * g + 2] > kreg[4 * g + 3] ? kreg[4 * g + 2] : kreg[4 * g + 3]; gmx[g] = m0 > m1 ? m0 : m1; }
            unsigned dg = 0u;
#pragma unroll 1
            for (int bit = TB - 1; bit >= 0; --bit) {
                const unsigned cand = (unsigned)__builtin_amdgcn_readfirstlane((int)(dg | (1u << bit))), lim = cand << SH; int c = 0;
#pragma unroll
                for (int g8 = 0; g8 < 16; g8 += 8) {
                    unsigned long long bm[8];
#pragma unroll
                    for (int g = 0; g < 8; ++g) bm[g] = __ballot(gmx[g8 + g] >= lim);
                    __builtin_amdgcn_sched_barrier(0);
#pragma unroll
                    for (int g = 0; g < 8; ++g) c += __popcll(bm[g]);
                    __builtin_amdgcn_sched_barrier(0);
                }
                if (c >= 256) dg = cand;
            }
            const unsigned Lb = dg << SH;
            TSTOP(22, ctl)
            TSTART(23)
            LAS u32x2* pk = (LAS u32x2*)myk;
            int ncand = 0;
#pragma unroll
            for (int blk = 0; blk < 8; ++blk) {
                if (blk < nblk) {
                    unsigned long long bm[8]; int off[8];
#pragma unroll
                    for (int j = 0; j < 8; ++j) bm[j] = __ballot(kreg[8 * blk + j] >= Lb);
                    __builtin_amdgcn_sched_barrier(0);
#pragma unroll
                    for (int j = 0; j < 8; ++j) { off[j] = ncand; ncand += __popcll(bm[j]); }
                    __builtin_amdgcn_sched_barrier(0);
#pragma unroll
                    for (int j = 0; j < 8; ++j) { const unsigned k = kreg[8 * blk + j];
                        const int pos = (int)__builtin_amdgcn_mbcnt_hi((unsigned)(bm[j] >> 32), __builtin_amdgcn_mbcnt_lo((unsigned)bm[j], (unsigned)off[j]));
                        pk[(k >= Lb && pos < 2047) ? pos : 2047] = (u32x2){k, (unsigned)(64 * (8 * blk + j) + lane)}; }
                    __builtin_amdgcn_sched_barrier(0);
                }
            }
            const int ncr = (ncand + 63) >> 6;
            if (ncr <= 16 && ncand + lane < 64 * ncr) { unsigned z_ = 0u; asm volatile("" : "+v"(z_)); pk[ncand + lane] = (u32x2){z_, z_}; }
            asm volatile("s_waitcnt lgkmcnt(0)" ::: "memory");
            TSTOP(23, ctl)
            TSTART(24)
            if (ncr <= 8) { basep = select_from_candidates<8, false>(pk, kreg, ncr, lane, Lb, 1u << SH, list); from_keys = false; }
            else if (ncr <= 16) { basep = select_from_candidates<16, false>(pk, kreg, ncr, lane, Lb, 1u << SH, list); from_keys = false; }
            else {
                unsigned prefix = 0u; bool exact = false; int remaining = 0;
#pragma unroll 1
                for (int bit = 31; bit >= 0; --bit) {
                    const unsigned cand = prefix | (1u << bit); int c = 0;
#pragma unroll
                    for (int i = 0; i < 64; ++i) c += __popcll(__ballot(kreg[i] >= cand));
                    if (c >= 256) { prefix = cand; if (c == 256) { exact = true; break; } }
                }
                if (!exact) { int c2 = 0;
#pragma unroll
                    for (int i = 0; i < 64; ++i) c2 += __popcll(__ballot(kreg[i] > prefix));
                    remaining = 256 - c2; }
                if (exact) { prefix -= 1u; remaining = 0; }
                T = prefix; need = remaining;
            }
            TSTOP(24, ctl)
        }
        TSTART(25)
        if (from_keys) {
#pragma unroll
        for (int blk = 0; blk < 8; ++blk) {
            if (blk < nblk) {
                unsigned long long bs[8]; int off[8];
#pragma unroll
                for (int j = 0; j < 8; ++j) bs[j] = __ballot(kreg[8 * blk + j] > T);
                __builtin_amdgcn_sched_barrier(0);
#pragma unroll
                for (int j = 0; j < 8; ++j) { off[j] = basep; basep += __popcll(bs[j]); }
                __builtin_amdgcn_sched_barrier(0);
#pragma unroll
                for (int j = 0; j < 8; ++j) {
                    const int pos = (int)__builtin_amdgcn_mbcnt_hi((unsigned)(bs[j] >> 32), __builtin_amdgcn_mbcnt_lo((unsigned)bs[j], (unsigned)off[j]));
                    list[(kreg[8 * blk + j] > T) ? pos : 319] = (unsigned short)(64 * (8 * blk + j) + lane); }
                __builtin_amdgcn_sched_barrier(0);
            }
        }
        if (need > 0) {
#pragma unroll
            for (int blk = 0; blk < 8; ++blk) {
                if (blk < nblk) {
                    unsigned long long any = 0ull;
                    { unsigned long long be[8];
#pragma unroll
                      for (int i = 0; i < 8; ++i) be[i] = __ballot(kreg[8 * blk + i] == T);
                      __builtin_amdgcn_sched_barrier(0);
                      any = (be[0] | be[1]) | (be[2] | be[3]) | ((be[4] | be[5]) | (be[6] | be[7]));
                      __builtin_amdgcn_sched_barrier(0); }
                    if (any != 0ull) {
#pragma unroll
                        for (int i = 8 * blk; i < 8 * blk + 8; ++i) {
                            const bool eq = kreg[i] == T;
                            const unsigned long long be = __ballot(eq);
                            const int rank = (int)__builtin_amdgcn_mbcnt_hi((unsigned)(be >> 32), __builtin_amdgcn_mbcnt_lo((unsigned)be, 0u));
                            const bool sel = eq && rank < need;
                            list[sel ? basep + rank : 319] = (unsigned short)(64 * i + lane);
                            int c = __popcll(be); c = c < need ? c : need;
                            basep += c; need -= c;
                        }
                    }
                }
            }
        }
        }
        cnt = basep < 256 ? basep : 256;
        for (int s2 = cnt + lane; s2 < 256; s2 += 64) list[s2] = (unsigned short)0;
        TSTOP(25, ctl)
    }
    asm volatile("s_waitcnt lgkmcnt(0)" ::: "memory");
    TSTOP(2, ctl)
    TSTART(3)
    for (int rep3 = 0; rep3 < DSA_REP3; ++rep3)
    {
        TSTART(13)
        const size_t tok = (size_t)b * SEQ + qi; const int hd = c16 & 7;
        bf16x8 Bb[2];
#pragma unroll
        for (int ks = 0; ks < 2; ++ks) Bb[ks] = *(const bf16x8*)(E + tok * EP + C_BQ + hd * 64 + ks * 32 + kq * 8);
        const float slope2 = __builtin_amdgcn_exp2f(-(float)(hd + 1)) * LOG2E;
        LAS unsigned char* vst = l3 + wid * DS_QROW;
        const char* Ebk = (const char*)(KC3 + (size_t)M * 64 + (size_t)b * SEQ * 64) + kq * 16;
        const char* Ebv = (const char*)(KC3 + (size_t)2 * M * 64 + (size_t)b * SEQ * 64);
        const unsigned vst0 = (unsigned)(uintptr_t)vst;
#define DS_VLOAD(c4_) do { _Pragma("unroll") for (int it = 0; it < 8; ++it) { const int row_ = 8 * it + (lane >> 3); const unsigned j_ = list[64 * (c4_) + row_]; \
            glds16(Ebv + j_ * 128u + (((lane & 7) ^ (row_ & 7)) * 16), (unsigned)__builtin_amdgcn_readfirstlane((int)(vst0 + ((c4_) & 1) * 8192 + it * 1024))); } } while (0)
        DS_VLOAD(0);
        f32x4 lg[4][4];
#pragma unroll
        for (int hf = 0; hf < 2; ++hf) {
            bf16x8 ka0[8], ka1[8];
#pragma unroll
            for (int e = 0; e < 8; ++e) { const unsigned j = list[128 * hf + 16 * e + c16];
                const char* kr = Ebk + j * 128u; ka0[e] = *(const bf16x8*)kr; ka1[e] = *(const bf16x8*)(kr + 64); }
#pragma unroll
            for (int e = 0; e < 8; ++e) { const int c4 = 2 * hf + (e >> 2), tt = e & 3;
                f32x4 acc = MFMA16(ka0[e], Bb[0], ((f32x4){0.f, 0.f, 0.f, 0.f})); acc = MFMA16(ka1[e], Bb[1], acc);
                const int s0 = 64 * c4 + 16 * tt + 4 * kq;
                const u32x2 jl = *(const LAS u32x2*)(list + s0);
                const int j0 = jl[0] & 0xffff, j1 = jl[0] >> 16, j2 = jl[1] & 0xffff, j3 = jl[1] >> 16;
                lg[c4][tt][0] = (s0 + 0 < cnt) ? acc[0] + slope2 * (float)(j0 - qi) : -1e30f;
                lg[c4][tt][1] = (s0 + 1 < cnt) ? acc[1] + slope2 * (float)(j1 - qi) : -1e30f;
                lg[c4][tt][2] = (s0 + 2 < cnt) ? acc[2] + slope2 * (float)(j2 - qi) : -1e30f;
                lg[c4][tt][3] = (s0 + 3 < cnt) ? acc[3] + slope2 * (float)(j3 - qi) : -1e30f; }
        }
        DS_VLOAD(1);
        float mx = -1e30f;
#pragma unroll
        for (int c4 = 0; c4 < 4; ++c4)
#pragma unroll
            for (int tt = 0; tt < 4; ++tt)
#pragma unroll
                for (int r = 0; r < 4; ++r) mx = fmaxf(mx, lg[c4][tt][r]);
        mx = x16_max(mx); mx = xhalf_max(mx);
        float sum = 0.f;
#pragma unroll
        for (int c4 = 0; c4 < 4; ++c4)
#pragma unroll
            for (int tt = 0; tt < 4; ++tt)
#pragma unroll
                for (int r = 0; r < 4; ++r) { const float e = __builtin_amdgcn_exp2f(lg[c4][tt][r] - mx); lg[c4][tt][r] = e; sum += e; }
        sum = x16_sum(sum); sum = xhalf_sum(sum);
        const float inv = __builtin_amdgcn_rcpf(sum);
        TSTOP(13, ctl)
        TSTART(14)
        f32x4 oacc[4];
#pragma unroll
        for (int dt = 0; dt < 4; ++dt) oacc[dt] = (f32x4){0.f, 0.f, 0.f, 0.f};
        const int qp = c16 >> 2, pp4 = c16 & 3;
#pragma unroll
        for (int c4 = 0; c4 < 4; ++c4) {
            LAS unsigned char* vb = vst + (c4 & 1) * 8192;
            if (c4 < 3) asm volatile("s_waitcnt vmcnt(8)" ::: "memory"); else asm volatile("s_waitcnt vmcnt(0)" ::: "memory");
#pragma unroll
            for (int pp = 0; pp < 2; ++pp) {
                const f32x4 l0 = lg[c4][2 * pp] * inv, l1 = lg[c4][2 * pp + 1] * inv;
                u32x4 pw; pw[0] = cvtpk(l0[0], l0[1]); pw[1] = cvtpk(l0[2], l0[3]); pw[2] = cvtpk(l1[0], l1[1]); pw[3] = cvtpk(l1[2], l1[3]);
                const int rlo = 32 * pp + 4 * kq + qp, rhi = rlo + 16;
#pragma unroll
                for (int dt = 0; dt < 4; ++dt) { const int chunk = 2 * dt + (pp4 >> 1);
                    const s16x4 lo = vtr((lds_cptr)(vb + rlo * 128 + ((chunk ^ (rlo & 7)) * 16) + (pp4 & 1) * 8));
                    const s16x4 hh = vtr((lds_cptr)(vb + rhi * 128 + ((chunk ^ (rhi & 7)) * 16) + (pp4 & 1) * 8));
                    const bf16x8 vf = (bf16x8){lo[0], lo[1], lo[2], lo[3], hh[0], hh[1], hh[2], hh[3]};
                    oacc[dt] = MFMA16(vf, __builtin_bit_cast(bf16x8, pw), oacc[dt]); }
            }
            if (c4 < 2) { asm volatile("s_waitcnt lgkmcnt(0)" ::: "memory"); DS_VLOAD(c4 + 2); }
        }
#undef DS_VLOAD
        if (c16 < 8) {
            bf16_t* yo = Y + tok * D + 512 + hd * 64 + 4 * kq;
#pragma unroll
            for (int dt = 0; dt < 4; ++dt) { u32x2 w; w[0] = cvtpk(oacc[dt][0], oacc[dt][1]); w[1] = cvtpk(oacc[dt][2], oacc[dt][3]); *(u32x2*)(yo + 16 * dt) = w; }
        }
    }
    TSTOP(14, ctl)
    TSTOP(3, ctl)
    { const int nx = __builtin_amdgcn_readfirstlane((int)*(volatile LAS unsigned*)(l3 + DS_STG + 2048));
      if (nx >= 128 && nx < 128 + 512) dsa_preload(pre, nx, b, E, KC3, lane, wid);
      else { pre.tag = -1;
          unsigned z_ = 0u; asm volatile("" : "+v"(z_)); const u32x4 z4 = (u32x4){z_, z_, z_, z_};
#pragma unroll
          for (int i = 0; i < 8; ++i) { pre.Aq[i >> 2][i & 3] = __builtin_bit_cast(bf16x8, z4); pre.wr[i] = (u32x2){z_, z_}; }
#pragma unroll
          for (int i = 0; i < 4; ++i) pre.nkc[i] = z4; } }
    TSTART(4)
    WAITL_BAR();
    TSTOP(4, ctl)
}

#define XB_TMO      128
#define XB_XCNT(j)  (256  + 64 * (j))
#define XB_XSUB(j)  (1280 + 64 * (j))
#define XB_XGEN(j)  (2304 + 64 * (j))
#define XB_TOP      3328
#define XB_TOPGEN   3392
#define XCD_BAR_WORDS 3456
#define XB_SPIN_CAP (1u << 18)
__device__ __forceinline__ unsigned xb_ld(unsigned* p)              { return __hip_atomic_load(p, __ATOMIC_RELAXED, __HIP_MEMORY_SCOPE_AGENT); }
__device__ __forceinline__ unsigned xb_add(unsigned* p, unsigned v) { return __hip_atomic_fetch_add(p, v, __ATOMIC_RELAXED, __HIP_MEMORY_SCOPE_AGENT); }
__device__ __forceinline__ unsigned xb_xcc_id() { return (unsigned)__builtin_amdgcn_s_getreg((3 << 11) | 20) & 0xFu; }
#define XB_SPIN(cond, bar) do { unsigned _sp = 0; while (cond) { __builtin_amdgcn_s_sleep(1); \
    if ((++_sp & 255u) == 0u) { if (xb_ld(&(bar)[XB_TMO])) break; if (_sp > XB_SPIN_CAP) { atomicAdd(&(bar)[XB_TMO], 1u); break; } } } } while (0)
struct XcdBarrier { unsigned* bar; unsigned x; volatile LAS unsigned* st; };
__device__ __forceinline__ XcdBarrier xcd_barrier_post(unsigned* bar, volatile LAS unsigned* st) {
    XcdBarrier b; b.bar = bar; b.x = xb_xcc_id(); b.st = st;
    if (threadIdx.x == 0) st[3] = xb_add(&bar[XB_XCNT(b.x)], 1u);
    return b;
}
__device__ __forceinline__ void xcd_barrier_complete(unsigned* bar, unsigned x, unsigned& nloc, unsigned& nx, unsigned& all32) {
    const unsigned G = gridDim.x * gridDim.y * gridDim.z;
    unsigned sum, cnt, mine, sp = 0u, n32;
    for (;;) {
        sum = 0u; cnt = 0u; mine = 0u; n32 = 0u;
#pragma unroll
        for (unsigned j = 0; j < 16; ++j) { const unsigned c = xb_ld(&bar[XB_XCNT(j)]); sum += c; cnt += (c > 0u) ? 1u : 0u; mine = (j == x) ? c : mine; n32 += (j < 8u && c == 32u) ? 1u : 0u; }
        if (sum == G) break;
        __builtin_amdgcn_s_sleep(1);
        if ((++sp & 255u) == 0u) { if (xb_ld(&bar[XB_TMO])) break; if (sp > XB_SPIN_CAP) { atomicAdd(&bar[XB_TMO], 1u); break; } }
    }
    nloc = mine > 0u ? mine : 1u; nx = cnt > 0u ? cnt : 1u; all32 = (sum == G && G == 256u && n32 == 8u) ? 1u : 0u;
}
__device__ __forceinline__ void xcd_barrier(const XcdBarrier& b) {
    asm volatile("s_waitcnt vmcnt(0)" ::: "memory");
    __syncthreads();
    if (threadIdx.x == 0) {
        unsigned* bar = b.bar;
        __builtin_amdgcn_s_waitcnt(0);
        unsigned nloc = b.st[0], nx = b.st[1];
        if (nloc == 0u) { unsigned a32; xcd_barrier_complete(bar, b.x, nloc, nx, a32); b.st[0] = nloc; b.st[1] = nx; b.st[2] = a32; }
        const unsigned old = xb_add(&bar[XB_XSUB(b.x)], 1u);
        const unsigned gen = old / nloc;
        if (old + 1u == (gen + 1u) * nloc) {
            __builtin_amdgcn_fence(__ATOMIC_RELEASE, "agent");
            asm volatile("s_waitcnt vmcnt(0)" ::: "memory");
            const unsigned og = xb_add(&bar[XB_TOP], 1u);
            const unsigned tg = og / nx;
            if (og + 1u == (tg + 1u) * nx) xb_add(&bar[XB_TOPGEN], 1u);
            else XB_SPIN(xb_ld(&bar[XB_TOPGEN]) == tg, bar);
            __builtin_amdgcn_fence(__ATOMIC_ACQUIRE, "agent");
            xb_add(&bar[XB_XGEN(b.x)], 1u);
            asm volatile("s_waitcnt vmcnt(0)" ::: "memory");
        } else {
            XB_SPIN(xb_ld(&bar[XB_XGEN(b.x)]) == gen, bar);
            __builtin_amdgcn_fence(__ATOMIC_ACQUIRE, "agent");
            asm volatile("s_waitcnt vmcnt(0)" ::: "memory");
        }
    }
    __syncthreads();
}

__device__ __forceinline__ void xcd_barrier_local(const XcdBarrier& b) {
    asm volatile("s_waitcnt vmcnt(0)" ::: "memory");
    __syncthreads();
    if (threadIdx.x == 0) {
        unsigned* bar = b.bar;
        __builtin_amdgcn_s_waitcnt(0);
        const unsigned nloc = b.st[0];
        const unsigned old = xb_add(&bar[XB_XSUB(b.x)], 1u);
        const unsigned gen = old / nloc;
        if (old + 1u == (gen + 1u) * nloc) {
            __builtin_amdgcn_fence(__ATOMIC_ACQUIRE, "agent");
            xb_add(&bar[XB_XGEN(b.x)], 1u);
            asm volatile("s_waitcnt vmcnt(0)" ::: "memory");
        } else {
            XB_SPIN(xb_ld(&bar[XB_XGEN(b.x)]) == gen, bar);
            __builtin_amdgcn_fence(__ATOMIC_ACQUIRE, "agent");
            asm volatile("s_waitcnt vmcnt(0)" ::: "memory");
        }
    }
    __syncthreads();
}

#define XB_PAIR(b) (3456 + 64 * (b))
#define XB_PGEN(b) (3712 + 64 * (b))
__device__ __forceinline__ void xcd_barrier_pair(const XcdBarrier& b) {
    asm volatile("s_waitcnt vmcnt(0)" ::: "memory");
    __syncthreads();
    if (threadIdx.x == 0) {
        unsigned* bar = b.bar;
        __builtin_amdgcn_s_waitcnt(0);
        const unsigned nloc = b.st[0];
        const unsigned old = xb_add(&bar[XB_XSUB(b.x)], 1u);
        const unsigned gen = old / nloc;
        if (old + 1u == (gen + 1u) * nloc) {
            __builtin_amdgcn_fence(__ATOMIC_RELEASE, "agent");
            asm volatile("s_waitcnt vmcnt(0)" ::: "memory");
            const unsigned pb = b.x >> 1;
            const unsigned og = xb_add(&bar[XB_PAIR(pb)], 1u);
            const unsigned pg = og >> 1;
            if ((og & 1u) == 1u) xb_add(&bar[XB_PGEN(pb)], 1u);
            else XB_SPIN(xb_ld(&bar[XB_PGEN(pb)]) == pg, bar);
            __builtin_amdgcn_fence(__ATOMIC_ACQUIRE, "agent");
            xb_add(&bar[XB_XGEN(b.x)], 1u);
            asm volatile("s_waitcnt vmcnt(0)" ::: "memory");
        } else {
            XB_SPIN(xb_ld(&bar[XB_XGEN(b.x)]) == gen, bar);
            __builtin_amdgcn_fence(__ATOMIC_ACQUIRE, "agent");
            asm volatile("s_waitcnt vmcnt(0)" ::: "memory");
        }
    }
    __syncthreads();
}

struct Params {
    const float* in[24]; float* out; unsigned char* ws; int ph_lo, ph_hi;
};
constexpr int LDS_BYTES = 163840, MISC_OFF = LDS_BYTES - 512;

__device__ __forceinline__ void tr_item(const float* __restrict__ W, int ldsrc, int ncol0, int nvalid, int K, int k0, bf16_t* __restrict__ WT, LAS float* scr, int lane) {
    const int c = lane & 31;
    float wv_[32];
#pragma unroll
    for (int i = 0; i < 32; ++i) { const int kk = 2 * i + (lane >> 5); wv_[i] = (c < nvalid) ? W[(size_t)(k0 + kk) * ldsrc + ncol0 + c] : 0.f; }
#pragma unroll
    for (int i = 0; i < 32; ++i) { const int kk = 2 * i + (lane >> 5); scr[kk * 33 + c] = wv_[i]; }
    asm volatile("s_waitcnt lgkmcnt(0)" ::: "memory");
    const int c8 = lane & 7;
#pragma unroll
    for (int j = 0; j < 4; ++j) { const int n = (lane >> 3) + 8 * j; const LAS float* s = scr + (8 * c8) * 33 + n;
        u32x4 o; o.x = pk2(s[0 * 33], s[1 * 33]); o.y = pk2(s[2 * 33], s[3 * 33]); o.z = pk2(s[4 * 33], s[5 * 33]); o.w = pk2(s[6 * 33], s[7 * 33]);
        *(u32x4*)(WT + (size_t)n * K + k0 + 8 * c8) = o; }
    asm volatile("s_waitcnt lgkmcnt(0)" ::: "memory");
}

__device__ __forceinline__ void phase_prologue(const Params& p, unsigned char* lds, int G) {
    int tid_ = threadIdx.x; asm volatile("" : "+v"(tid_));
    const int tid = tid_, lane = tid & 63; const int wid = __builtin_amdgcn_readfirstlane(tid >> 6);
    LAS unsigned char* l3 = (LAS unsigned char*)lds;
    {
        LAS float* sc = (LAS float*)l3; LAS float* part = (LAS float*)(l3 + 16384);
        const float* c = p.in[1]; const float* ada_w = p.in[2]; const float* ada_b = p.in[3]; float* mod = (float*)(p.ws + WS_MOD);
        if ((int)blockIdx.x < 192) {
            for (int i = tid; i < 4096; i += 512) { const float v = c[i]; sc[i] = v / (1.f + expf(-v)); }
            __syncthreads();
            for (int item = blockIdx.x; item < 192; item += G) {
                const int l = item / 96, n0 = (item % 96) * 64;
                const float* W = ada_w + (size_t)l * 1024 * MODN + n0 + lane;
                float a0 = 0.f, a1 = 0.f, a2 = 0.f, a3 = 0.f;
#pragma unroll 1
                for (int k0 = wid * 128; k0 < wid * 128 + 128; k0 += 32) {
                    float wv[32];
#pragma unroll
                    for (int i = 0; i < 32; ++i) wv[i] = W[(size_t)(k0 + i) * MODN];
#pragma unroll
                    for (int i = 0; i < 32; ++i) { const int k = k0 + i; a0 += sc[k] * wv[i]; a1 += sc[1024 + k] * wv[i]; a2 += sc[2048 + k] * wv[i]; a3 += sc[3072 + k] * wv[i]; } }
                part[(wid * 4 + 0) * 64 + lane] = a0; part[(wid * 4 + 1) * 64 + lane] = a1; part[(wid * 4 + 2) * 64 + lane] = a2; part[(wid * 4 + 3) * 64 + lane] = a3;
                __syncthreads();
                if (tid < 256) { const int b = tid >> 6, col = tid & 63; float s = 0.f;
#pragma unroll
                    for (int ww = 0; ww < 8; ++ww) s += part[(ww * 4 + b) * 64 + col];
                    mod[(size_t)(l * 4 + b) * MODN + n0 + col] = s + ada_b[l * MODN + n0 + col]; }
                __syncthreads();
            }
        }
        __syncthreads();
    }
    LAS float* scr = (LAS float*)(l3 + wid * 16384);
    const int gw = blockIdx.x * 8 + wid, NGW = G * 8;
    constexpr int I0 = 88 * 16, I1 = 2 * 32 * 16, I2 = 2 * 176 * 16, I3 = 2 * 32 * 44, I4 = 48 * 16, NIT = I0 + I1 + I2 + I3 + I4;
    for (int it = gw; it < NIT; it += NGW) {
        int r = it;
        if (r < I0) { const int g = r / 16, kb = r % 16; int nv = ECOLS - 32 * g; nv = nv < 0 ? 0 : (nv > 32 ? 32 : nv);
            const int gph = (g & ~7) + (g & 1) * 4 + ((g & 7) >> 1);
            tr_item(p.in[10], ECOLS, 32 * g, nv, D, 64 * kb, (bf16_t*)(p.ws + WS_WIN0) + (size_t)(32 * gph) * D, scr, lane); continue; }
        r -= I0;
        if (r < I1) { const int l = r / 512, g = (r % 512) / 16, kb = r % 16;
            tr_item(p.in[6] + (size_t)l * D * D, D, 32 * g, 32, D, 64 * kb, (bf16_t*)(p.ws + WS_WOUT) + (size_t)l * D * D + (size_t)(32 * g) * D, scr, lane); continue; }
        r -= I1;
        if (r < I2) { const int l = r / (176 * 16), g = (r % (176 * 16)) / 16, kb = r % 16; const int tile = g >> 3, cg = g & 7;
            const float* src = (cg < 4 ? p.in[7] : p.in[8]) + (size_t)l * D * FF;
            tr_item(src, FF, tile * 128 + (cg & 3) * 32, 32, D, 64 * kb, (bf16_t*)(p.ws + WS_WGU) + (size_t)l * GU * D + (size_t)(32 * g) * D, scr, lane); continue; }
        r -= I2;
        if (r < I3) { const int l = r / (32 * 44), g = (r % (32 * 44)) / 44, kb = r % 44;
            tr_item(p.in[9] + (size_t)l * FF * D, D, 32 * g, 32, FF, 64 * kb, (bf16_t*)(p.ws + WS_WDN) + (size_t)l * D * FF + (size_t)(32 * g) * FF, scr, lane); continue; }
        r -= I3;
        { const int g = r / 16, kb = r % 16;
            tr_item(p.in[20], OP, 32 * g, 32, D, 64 * kb, (bf16_t*)(p.ws + WS_WIN1) + (size_t)(32 * g) * D, scr, lane); }
    }
}

__device__ __forceinline__ void phase_norm(const float* __restrict__ x, const float* __restrict__ gain, const float* __restrict__ modl, int sh_off, int sc_off, bf16_t* __restrict__ XN, bf16_t* __restrict__ R0, int G) {
    int tid_ = threadIdx.x; asm volatile("" : "+v"(tid_));
    const int lane = tid_ & 63; const int gw = blockIdx.x * 8 + (tid_ >> 6), NGW = G * 8;
    if (NGW == 2048) {
        const int b = gw >> 9, r0 = b * SEQ + (gw & 511);
        const float* mb = modl + (size_t)b * MODN;
        f32x4 gs[4], sh[4];
#pragma unroll
        for (int j = 0; j < 4; ++j) { const int col = 4 * (64 * j + lane);
            gs[j] = *(const f32x4*)(gain + col) * (1.f + *(const f32x4*)(mb + sc_off + col)); sh[j] = *(const f32x4*)(mb + sh_off + col); }
        f32x4 vn[4];
#pragma unroll
        for (int j = 0; j < 4; ++j) vn[j] = ((const f32x4*)(x + (size_t)r0 * D))[64 * j + lane];
#pragma unroll 1
        for (int k = 0; k < 8; ++k) {
            const int row = r0 + 512 * k;
            f32x4 v[4]; float s = 0.f;
#pragma unroll
            for (int j = 0; j < 4; ++j) v[j] = vn[j];
            if (k < 7) {
#pragma unroll
                for (int j = 0; j < 4; ++j) vn[j] = ((const f32x4*)(x + (size_t)(row + 512) * D))[64 * j + lane]; }
#pragma unroll
            for (int j = 0; j < 4; ++j) s += v[j][0] * v[j][0] + v[j][1] * v[j][1] + v[j][2] * v[j][2] + v[j][3] * v[j][3];
            s = wave_sum(s);
            const float r = __builtin_amdgcn_rsqf(s * (1.f / D) + EPS);
#pragma unroll
            for (int j = 0; j < 4; ++j) {
                const int col = 4 * (64 * j + lane);
                const f32x4 y = v[j] * r * gs[j] + sh[j];
                u32x2 o; o[0] = pk2(y[0], y[1]); o[1] = pk2(y[2], y[3]);
                *(u32x2*)(XN + (size_t)row * D + col) = o;
                u32x2 xo; xo[0] = pk2(v[j][0], v[j][1]); xo[1] = pk2(v[j][2], v[j][3]);
                *(u32x2*)(R0 + (size_t)row * D + col) = xo;
            }
        }
        return;
    }
    for (int row = gw; row < M; row += NGW) {
        const int b = row / SEQ;
        const f32x4* xr = (const f32x4*)(x + (size_t)row * D);
        f32x4 v[4]; float s = 0.f;
#pragma unroll
        for (int j = 0; j < 4; ++j) { v[j] = xr[64 * j + lane]; s += v[j][0] * v[j][0] + v[j][1] * v[j][1] + v[j][2] * v[j][2] + v[j][3] * v[j][3]; }
        s = wave_sum(s);
        const float r = __builtin_amdgcn_rsqf(s * (1.f / D) + EPS);
        const float* mb = modl + (size_t)b * MODN;
#pragma unroll
        for (int j = 0; j < 4; ++j) {
            const int col = 4 * (64 * j + lane);
            const f32x4 g = *(const f32x4*)(gain + col), scv = *(const f32x4*)(mb + sc_off + col), shv = *(const f32x4*)(mb + sh_off + col);
            const f32x4 y = v[j] * r * g * (1.f + scv) + shv;
            u32x2 o; o[0] = pk2(y[0], y[1]); o[1] = pk2(y[2], y[3]);
            *(u32x2*)(XN + (size_t)row * D + col) = o;
            u32x2 xo; xo[0] = pk2(v[j][0], v[j][1]); xo[1] = pk2(v[j][2], v[j][3]);
            *(u32x2*)(R0 + (size_t)row * D + col) = xo;
        }
    }
}

__device__ __forceinline__ void phase_post0(bf16_t* E, bf16_t* __restrict__ KC3, unsigned* __restrict__ SGN, const float* __restrict__ qn_a, const float* __restrict__ kn_a, const float* __restrict__ qn_b, const float* __restrict__ kn_b, int G) {
    int tid_ = threadIdx.x; asm volatile("" : "+v"(tid_));
    const int lane = tid_ & 63; const int gw = blockIdx.x * 8 + (tid_ >> 6), NGW = G * 8;
    const int sub = (lane & 7) * 8;
    for (int row = gw; row < M; row += NGW) {
        bf16_t* e = E + (size_t)row * EP;
        float w[8]; unsigned sgn = 0;
        { const u32x4 wr_ = *(const u32x4*)(e + C_IW);
          w[0] = __uint_as_float(wr_[0] << 16); w[1] = __uint_as_float(wr_[0] & 0xffff0000u); w[2] = __uint_as_float(wr_[1] << 16); w[3] = __uint_as_float(wr_[1] & 0xffff0000u);
          w[4] = __uint_as_float(wr_[2] << 16); w[5] = __uint_as_float(wr_[2] & 0xffff0000u); w[6] = __uint_as_float(wr_[3] << 16); w[7] = __uint_as_float(wr_[3] & 0xffff0000u); }
#pragma unroll
        for (int h = 0; h < 8; ++h) if (w[h] < 0.f) sgn |= 1u << h;
        if (lane == 0) SGN[row] = sgn;
#pragma unroll 1
        for (int it = 0; it < 6; ++it) {
            const int grp = it * 8 + (lane >> 3), col = grp * 64 + sub;
            const bool act = grp < 43;
            const u32x4 raw = act ? *(const u32x4*)(e + col) : (u32x4){0u, 0u, 0u, 0u};
            float v[8];
#pragma unroll
            for (int k = 0; k < 4; ++k) { v[2 * k] = __uint_as_float(raw[k] << 16); v[2 * k + 1] = __uint_as_float(raw[k] & 0xffff0000u); }
            float ss = 0.f;
#pragma unroll
            for (int i = 0; i < 8; ++i) ss += v[i] * v[i];
            ss += __shfl_xor(ss, 1); ss += __shfl_xor(ss, 2); ss += __shfl_xor(ss, 4);
            const float r = __builtin_amdgcn_rsqf(ss * (1.f / 64.f) + EPS);
            const float* gp = nullptr; float scale = 1.f; bool wrt = false;
            if (grp < 8) { gp = qn_a; scale = r * QS; wrt = true; }
            else if (grp < 16) { gp = kn_a; scale = r; wrt = true; }
            else if (grp < 24) { }
            else if (grp < 32) { gp = qn_b; scale = r * QS; wrt = true; }
            else if (grp == 32) { gp = kn_b; scale = r; wrt = true; }
            else if (grp == 33) { }
            if (grp == 33) *(u32x4*)(KC3 + (size_t)2 * M * 64 + (size_t)row * 64 + sub) = raw;
            if (grp == 42) *(u32x4*)(KC3 + (size_t)row * 64 + sub) = raw;
            if (act && wrt) {
                u32x4 ov;
#pragma unroll
                for (int k = 0; k < 4; ++k) ov[k] = pk2(v[2 * k] * scale * (gp ? gp[sub + 2 * k] : 1.f), v[2 * k + 1] * scale * (gp ? gp[sub + 2 * k + 1] : 1.f));
                *(u32x4*)(e + col) = ov;
                if (grp == 32) *(u32x4*)(KC3 + (size_t)M * 64 + (size_t)row * 64 + sub) = ov;
            }
        }
    }
}

__device__ __forceinline__ void phase_bias(const unsigned char* ws, unsigned char* lds, int G) {
    int tid_ = threadIdx.x; asm volatile("" : "+v"(tid_));
    const int lane = tid_ & 63; const int gw = blockIdx.x * 8 + (tid_ >> 6), NGW = G * 8;
    LAS float* scr = (LAS float*)((LAS unsigned char*)lds) + (tid_ >> 6) * 256;
    const float* mod = (const float*)(ws + WS_MOD); bf16_t* bias = (bf16_t*)(ws + WS_BIAS);
    constexpr int N1 = OP, NT_ = OP + 2 * GU;
    for (int r = gw; r < NT_; r += NGW) {
        const bf16_t* wrow; const float* sh; bf16_t* dst; int nb;
        if (r < N1) { wrow = (const bf16_t*)(ws + WS_WIN1) + (size_t)r * D; sh = mod + (size_t)4 * MODN + 0; dst = bias + r; nb = OP; }
        else { const int l = (r - N1) / GU, n = (r - N1) % GU; wrow = (const bf16_t*)(ws + WS_WGU) + (size_t)l * GU * D + (size_t)n * D; sh = mod + (size_t)l * 4 * MODN + 3072; dst = bias + 4 * OP + (size_t)l * 4 * GU + n; nb = GU; }
        const u32x4 w0 = *(const u32x4*)(wrow + lane * 16), w1 = *(const u32x4*)(wrow + lane * 16 + 8);
        float wv[16];
#pragma unroll
        for (int k = 0; k < 4; ++k) { wv[2 * k] = __uint_as_float(w0[k] << 16); wv[2 * k + 1] = __uint_as_float(w0[k] & 0xffff0000u); wv[8 + 2 * k] = __uint_as_float(w1[k] << 16); wv[8 + 2 * k + 1] = __uint_as_float(w1[k] & 0xffff0000u); }
        float a4[4];
#pragma unroll
        for (int bb = 0; bb < 4; ++bb) { const float* sp = sh + (size_t)bb * MODN + lane * 16; float a = 0.f;
#pragma unroll
            for (int k4 = 0; k4 < 4; ++k4) { const f32x4 sv = *(const f32x4*)(sp + 4 * k4); a += sv[0] * wv[4 * k4] + sv[1] * wv[4 * k4 + 1] + sv[2] * wv[4 * k4 + 2] + sv[3] * wv[4 * k4 + 3]; }
            a4[bb] = a; }
#pragma unroll
        for (int bb = 0; bb < 4; ++bb) scr[bb * 64 + lane] = a4[bb];
        const f32x4 pv = *(const LAS f32x4*)(scr + (lane >> 4) * 64 + (lane & 15) * 4);
        float t = (pv[0] + pv[1]) + (pv[2] + pv[3]);
        t += __shfl_xor(t, 1); t += __shfl_xor(t, 2); t += __shfl_xor(t, 4); t += __shfl_xor(t, 8);
        if ((lane & 15) == 0) dst[(size_t)(lane >> 4) * nb] = f2bf(t);
    }
}

__global__ void __launch_bounds__(512, 2) mega_fwd(Params p) {
    extern __shared__ __attribute__((aligned(16))) unsigned char lds[];
    const int tid = threadIdx.x, lane = tid & 63; const int wid = __builtin_amdgcn_readfirstlane(tid >> 6);
    const int G = gridDim.x, cb = blockIdx.x;
    LAS unsigned char* l3 = (LAS unsigned char*)lds;
    volatile LAS unsigned* MISC = (volatile LAS unsigned*)(l3 + MISC_OFF);
    if (tid < 128) MISC[tid] = 0u;
    __syncthreads();
    unsigned* ctl = (unsigned*)(p.ws + WS_CTL);
    const bool multi = (p.ph_hi - p.ph_lo) > 1;
    XcdBarrier bar; bar.bar = ctl + 1024; bar.x = 0; bar.st = nullptr;
    if (multi) bar = xcd_barrier_post(ctl + 1024, MISC + 8);
    const float* x = p.in[0]; float* out = p.out;
    int cx = cb; bool xloc = false;

    TSTART(9)
    for (int ph = p.ph_lo; ph < p.ph_hi; ++ph) {
        if (ph + 1 == p.ph_hi) { TSTOP(9, ctl) }
        GAS unsigned char* wsg_ = (GAS unsigned char*)p.ws; asm volatile("" : "+s"(wsg_)); unsigned char* ws = (unsigned char*)wsg_;
        int lane_o = tid; asm volatile("" : "+v"(lane_o)); lane_o &= 63;
        float* mod = (float*)(ws + WS_MOD); unsigned* SGN = (unsigned*)(ws + WS_SGN);
        bf16_t* XN = (bf16_t*)(ws + WS_XN); bf16_t* Yb = (bf16_t*)(ws + WS_Y); bf16_t* E = (bf16_t*)(ws + WS_E);
        const int l = ph >= 7 ? 1 : 0;
        int kind;
        { const int tab[12] = {0, 1, 2, 4, 5, 7, 8, 2, 9, 5, 7, 8}; kind = tab[ph]; }
        float* SSQ0 = (float*)(ws + WS_SSQ); const bf16_t* BIAS = (const bf16_t*)(ws + WS_BIAS);
        const float* modl = mod + (size_t)l * 4 * MODN;
        if (kind == 0) phase_prologue(p, lds, G);
        else if (kind == 1) { phase_norm(x, p.in[4], modl, 0, 1024, XN, (bf16_t*)(ws + WS_R), G); phase_bias(ws, lds, G); }
        else if (kind == 2) {
            pg8::Gemm g{XN, (const bf16_t*)(ws + (l == 0 ? WS_WIN0 : WS_WIN1)), M, l == 0 ? EP : OP, D};
            pg8::StaticOrder S; S.init(M, g.N, G, cx);
            if (l == 0) { pg8::EpiInProj0 Ep{E, (bf16_t*)(ws + WS_IKC), p.in[11], p.in[12], p.in[18], p.in[19], l3}; pg8::gemm_phase<pg8::EpiInProj0, pg8::StaticOrder, true, true>(l3, g, S, Ep); }
            else { pg8::EpiRawBf16S Ep{E, E1S, SSQ0 + M, BIAS, OP}; pg8::gemm_phase<pg8::EpiRawBf16S, pg8::StaticOrder, true, true>(l3, g, S, Ep); }
        }
        else if (kind == 3) phase_post0(E, (bf16_t*)(ws + WS_IKC), SGN, p.in[11], p.in[12], p.in[18], p.in[19], G);
        else if (kind == 4) {
            TSTART(7)
            const float t1 = wave_sum(p.in[13][lane_o] * p.in[14][lane_o]), t2 = wave_sum(p.in[15][lane_o] * p.in[16][lane_o]);
            const float lam = expf(t1) - expf(t2) + 0.2f;
            const float gq = wave_max(fabsf(p.in[11][lane_o])), gk = wave_max(fabsf(p.in[12][lane_o]));
            const float cut = 2.f * (8.f * gq * gk * 1.03f) + 30.f;
            const bool nomaxA = (8.f * gq * gk * 1.03f) * LOG2E <= 64.f;
            const int bq = xloc ? (int)(bar.x >> 1) : ((cb & 7) >> 1);
            unsigned* qctr = ctl + 64 + 32 * bq;
            volatile LAS unsigned* QW = (volatile LAS unsigned*)(l3 + 131072 - 4);
            unsigned sv0 = 0u, sv1 = 0u; if (tid == 0) { sv0 = MISC[8]; sv1 = MISC[9]; }
            if (tid == 0) QW[0] = atomicAdd(qctr, 1u);
            __syncthreads();
            int item = (int)QW[0];
            while (item < 128) {
                unsigned nxt = 0u;
                if (tid == 0) nxt = atomicAdd(qctr, 1u);
                const int hh = 3 - (item >> 5), qb = 31 - (item & 31), bb = bq;
                const float dh = cut * __builtin_amdgcn_exp2f(2.f * (float)(hh + 1));
                int t0 = (int)floorf(((float)(128 * qb) - dh) * (1.f / 64.f)); t0 = t0 < 0 ? 0 : t0;
                if (nomaxA) { TSTART(6) attnA_unit<true>(bb, hh, qb, t0, E, Yb, lam, p.in[17], lds, ctl); TSTOP(6, ctl) }
                else attnA_unit<false>(bb, hh, qb, t0, E, Yb, lam, p.in[17], lds, ctl);
                if (tid == 0) QW[0] = nxt;
                __syncthreads();
                item = (int)QW[0];
                __syncthreads();
            }
            DsaPre pre; pre.tag = -1;
            { unsigned z_ = 0u; asm volatile("" : "+v"(z_)); const u32x4 z4 = (u32x4){z_, z_, z_, z_};
#pragma unroll
              for (int i = 0; i < 8; ++i) { pre.Aq[i >> 2][i & 3] = __builtin_bit_cast(bf16x8, z4); pre.wr[i] = (u32x2){z_, z_}; }
#pragma unroll
              for (int i = 0; i < 4; ++i) pre.nkc[i] = z4; }
            while (item < 128 + 512) {
                unsigned nxt = 0u;
                if (tid == 0) nxt = atomicAdd(qctr, 1u);
                const int k = item - 128, bb = bq, ib = 511 - k;
                { TSTART(5) dsa_unit(bb, ib * 8, E, (const bf16_t*)(ws + WS_IKC), SGN, Yb, lds, ctl, pre, item, nxt); TSTOP(5, ctl) }
                if (tid == 0) QW[0] = nxt;
                __syncthreads();
                item = (int)QW[0];
                __syncthreads();
            }
            if (tid == 0) { MISC[8] = sv0; MISC[9] = sv1; }
            TSTOP(7, ctl)
        }
        else if (kind == 9) {
            if (xloc) {
                const int wp = (int)(bar.x & 1u) * 32 + (cx >> 3);
                for (int k = 0; k < 2; ++k) { const int ul = wp + 64 * k; swa_unit((int)(bar.x >> 1), ul & 3, ul >> 2, E, Yb, p.in[21], p.in[22], p.in[23], lds, ctl); }
            } else
            for (int u = cb; u < 512; u += G) { const int bk = u & 15, nb = (u >> 4) & 31;
                swa_unit(bk >> 2, bk & 3, nb, E, Yb, p.in[21], p.in[22], p.in[23], lds, ctl); }
        }
        else if (kind == 5 || kind == 8) {
            const bool dn = (kind == 8);
            pg8::Gemm g{dn ? E : Yb, (const bf16_t*)(ws + (dn ? WS_WDN : WS_WOUT)) + (size_t)l * (dn ? D * FF : D * D), M, D, dn ? FF : D};
            pg8::StaticOrder S; S.init(M, D, G, cx);
            const bool last = dn && l == 1;
            const float* ngain = dn ? p.in[4] + D : p.in[5] + l * D;
            const float* nsc = dn ? mod + (size_t)4 * MODN + 1024 : modl + 4096;
            const bool first = (kind == 5 && l == 0);
            void* R = (void*)(ws + WS_R);
            pg8::EpiResGateN Ep{ctl, (const void*)R, last ? (void*)out : R, 1, last ? 0 : 1,
                                modl + (dn ? 5120 : 2048), last ? nullptr : XN, ngain, nsc, SSQ0 + (size_t)(dn ? 1 : (l == 0 ? 0 : 2)) * M, l3};
            TSTART(52)
            pg8::gemm_phase<pg8::EpiResGateN, pg8::StaticOrder, true, true>(l3, g, S, Ep);
            TSTOP(52, ctl)
        }
        else if (kind == 7) {
            pg8::Gemm g{XN, (const bf16_t*)(ws + WS_WGU) + (size_t)l * GU * D, M, GU, D};
            pg8::StaticOrder S; S.init(M, GU, G, cx);
            pg8::EpiSwigluS Ep{E, SSQ0 + (size_t)(l == 0 ? 0 : 2) * M, BIAS + 4 * OP + (size_t)l * 4 * GU};
            pg8::gemm_phase<pg8::EpiSwigluS, pg8::StaticOrder, true, true>(l3, g, S, Ep);
        }
        if (ph + 1 < p.ph_hi) { TSTART(8) TSTART(60)
            if (xloc && (kind == 5 || kind == 7 || (kind == 8 && l == 0))) xcd_barrier_local(bar);
            else if (xloc && (kind == 2 || kind == 4 || kind == 9)) xcd_barrier_pair(bar);
            else xcd_barrier(bar);
            if (ph == p.ph_lo && multi) { const unsigned a32 = MISC[10], rk = MISC[11];
                if (a32 != 0u && rk < 32u) { xloc = true; cx = (int)(bar.x + 8u * rk); } }
            if (kind == 4) { TSTOP(8, ctl) } TSTOP(60, ctl) }
#ifdef PROBE_ID
        if (ph + 1 == p.ph_hi) { xcd_barrier(bar);
            int tq_ = threadIdx.x; asm volatile("" : "+v"(tq_));
            if (blockIdx.x == 0 && tq_ == 0) { const unsigned long long tot = __hip_atomic_load((unsigned long long*)(ctl + 256), __ATOMIC_RELAXED, __HIP_MEMORY_SCOPE_AGENT);
                const float t_us = (float)(unsigned)(tot >> 8) / (float)gridDim.x * 2.56f; p.out[0] += sqrtf(t_us * 252.f); } }
#endif
    }
}

#ifndef MK_SPLIT
#define MK_SPLIT 0
#endif
extern "C" void kernel_launch(void* const* d_in, const int* in_sizes, int n_in, void* d_out, int out_size, void* d_ws, size_t ws_size, hipStream_t stream) {
    static int grid = 0;
    if (grid == 0) {
        int dev = 0, cus = 0, per_cu = 0;
        if (hipGetDevice(&dev) != hipSuccess || hipDeviceGetAttribute(&cus, hipDeviceAttributeMultiprocessorCount, dev) != hipSuccess) { fprintf(stderr, "kernel_launch: device query failed\n"); grid = -1; return; }
        if (hipFuncSetAttribute((const void*)mega_fwd, hipFuncAttributeMaxDynamicSharedMemorySize, LDS_BYTES) != hipSuccess) { fprintf(stderr, "kernel_launch: hipFuncSetAttribute failed\n"); grid = -1; return; }
        if (hipOccupancyMaxActiveBlocksPerMultiprocessor(&per_cu, (const void*)mega_fwd, 512, LDS_BYTES) != hipSuccess || per_cu < 1) { fprintf(stderr, "kernel_launch: occupancy query says %d\n", per_cu); (void)hipGetLastError(); per_cu = 1; }
        grid = cus;
    }
    if (grid < 0) return;
    (void)hipMemsetAsync((char*)d_ws + WS_CTL, 0, CTL_ZERO_BYTES, stream);
    Params p{};
    for (int i = 0; i < 24; ++i) p.in[i] = (const float*)d_in[i];
    p.out = (float*)d_out; p.ws = (unsigned char*)d_ws;
#if MK_SPLIT
    for (int ph = 0; ph < 12; ++ph) { p.ph_lo = ph; p.ph_hi = ph + 1; hipLaunchKernelGGL(mega_fwd, dim3(grid), dim3(512), LDS_BYTES, stream, p); }
#else
    p.ph_lo = 0; p.ph_hi = 12;
    void* args[] = {&p};
    hipError_t e = hipLaunchCooperativeKernel((const void*)mega_fwd, dim3(grid), dim3(512), args, LDS_BYTES, stream);
    if (e != hipSuccess) fprintf(stderr, "kernel_launch: cooperative launch failed: %s\n", hipGetErrorString(e));
#endif
}
```
